# Optimizing an MI355X kernel written in HIP

```python
import jax
import jax.numpy as jnp
from jax import lax
import numpy as np

D_MODEL = 4096
BATCH = 1
SEQ = 8192
DEPTH = 4

POOL_WINDOWS = (2, 4, 8, 16)
POOL_GROUPS = 4
POOL_WIDTH = D_MODEL // 2
POOL_GROUP_DIM = POOL_WIDTH // POOL_GROUPS
HEAD_DIM = 128
N_Q_HEADS = D_MODEL // 256
N_KV_HEADS = N_Q_HEADS // 4
GQA_GROUP = N_Q_HEADS // N_KV_HEADS
NSA_WIDTH = N_Q_HEADS * HEAD_DIM
KV_WIDTH = N_KV_HEADS * HEAD_DIM
N_NSA_BRANCHES = 3
CMP_BLOCK = 32
CMP_STRIDE = 16
SLC_BLOCK = 64
SLC_TOPK = 16
WINDOW = 512
Q_BLOCK = 128
N_MERGE = 2
IN_WIDTHS = (POOL_WIDTH, POOL_WIDTH, NSA_WIDTH, NSA_WIDTH, KV_WIDTH, KV_WIDTH, KV_WIDTH, KV_WIDTH, KV_WIDTH, KV_WIDTH, N_NSA_BRANCHES * N_Q_HEADS, N_MERGE * D_MODEL)
IN_WIDTH = 2 * POOL_WIDTH + 2 * NSA_WIDTH + 6 * KV_WIDTH + N_NSA_BRANCHES * N_Q_HEADS + N_MERGE * D_MODEL
EPS = 1e-6
NEG_INF = -1e30
FORCED_SCORE = 1e6

kernel_name = 'hybrid_pool_nsa_gated_trunk'


def rms_norm(x, g):
    xf = x.astype(jnp.float32)
    y = xf * lax.rsqrt(jnp.mean(xf * xf, axis=-1, keepdims=True) + EPS)
    return (y * g.astype(jnp.float32)).astype(x.dtype)


def masked_softmax(s, mask):
    p = jax.nn.softmax(jnp.where(mask, s, NEG_INF), axis=-1)
    return p * mask.astype(p.dtype)


def alibi_slopes():
    h = jnp.arange(1, N_Q_HEADS + 1, dtype=jnp.float32)
    return jnp.exp2(-8.0 * h / N_Q_HEADS).reshape(N_KV_HEADS, GQA_GROUP)


def split_points():
    return np.cumsum(np.array(IN_WIDTHS))[:-1].tolist()


def pool_mixer(u, w_grp, scale):
    B, T, _ = u.shape
    uf = u.astype(jnp.float32)
    c = jnp.concatenate([jnp.zeros((B, 1, POOL_WIDTH), jnp.float32), jnp.cumsum(uf, axis=1)], axis=1)
    t = jnp.arange(T)
    outs = []
    for gi, w in enumerate(POOL_WINDOWS):
        sl = slice(gi * POOL_GROUP_DIM, (gi + 1) * POOL_GROUP_DIM)
        lo = jnp.maximum(t + 1 - w, 0)
        win_sum = c[:, 1:, sl] - c[:, lo][..., sl]
        cnt = (t + 1 - lo).astype(jnp.float32)[None, :, None]
        outs.append(win_sum / cnt - uf[..., sl])
    m = jnp.stack(outs, axis=2).astype(u.dtype)
    m = jnp.einsum('btgc,gcd->btgd', m, w_grp).reshape(B, T, POOL_WIDTH)
    return m * scale


def compress(k, pe, w1, b1, w2):
    T = k.shape[0]
    r = CMP_BLOCK // CMP_STRIDE
    n_chunks = T // CMP_STRIDE
    kr = k.reshape(n_chunks, CMP_STRIDE, N_KV_HEADS, HEAD_DIM)
    blocks = jnp.concatenate([kr[i:n_chunks - r + 1 + i] for i in range(r)], axis=1)
    blocks = blocks + pe[None, :, None, :]
    flat = jnp.transpose(blocks, (0, 2, 1, 3)).reshape(-1, N_KV_HEADS, CMP_BLOCK * HEAD_DIM)
    return jax.nn.silu(flat @ w1 + b1) @ w2


def cmp_to_slc(nc, ns):
    cs = jnp.arange(nc)[:, None] * CMP_STRIDE
    ss = jnp.arange(ns)[None, :] * SLC_BLOCK
    ov = jnp.maximum(jnp.minimum(cs + CMP_BLOCK, ss + SLC_BLOCK) - jnp.maximum(cs, ss), 0)
    return ov.astype(jnp.float32) / CMP_STRIDE


def nsa_sequence(q, kc, vc, ks, vs, kw, vw, gates):
    T = q.shape[0]
    nc = kc.shape[0]
    ns = T // SLC_BLOCK
    nb = T // Q_BLOCK
    topk = min(SLC_TOPK, ns)
    scale = HEAD_DIM ** -0.5
    slopes = alibi_slopes()
    ovl = cmp_to_slc(nc, ns)
    cmp_end = jnp.arange(nc) * CMP_STRIDE + CMP_BLOCK - 1
    ks_blk = jnp.transpose(ks.reshape(ns, SLC_BLOCK, N_KV_HEADS, HEAD_DIM), (2, 0, 1, 3))
    vs_blk = jnp.transpose(vs.reshape(ns, SLC_BLOCK, N_KV_HEADS, HEAD_DIM), (2, 0, 1, 3))
    pad = jnp.zeros((WINDOW, N_KV_HEADS, HEAD_DIM), kw.dtype)
    kw_p = jnp.concatenate([pad, kw], axis=0)
    vw_p = jnp.concatenate([pad, vw], axis=0)
    qb = q.reshape(nb, Q_BLOCK, N_KV_HEADS, GQA_GROUP, HEAD_DIM)
    gb = gates.reshape(nb, Q_BLOCK, N_KV_HEADS, GQA_GROUP, N_NSA_BRANCHES)

    def block(args):
        b, qi, gi = args
        t = b * Q_BLOCK + jnp.arange(Q_BLOCK)
        s = jnp.einsum('qhgd,nhd->qhgn', qi, kc).astype(jnp.float32) * scale
        dist = (t[:, None] - cmp_end[None, :]).astype(jnp.float32)
        s = s - slopes[None, :, :, None] * dist[:, None, None, :]
        mask_c = (cmp_end[None, :] <= t[:, None])[:, None, None, :]
        p_c = masked_softmax(s, mask_c)
        o_c = jnp.einsum('qhgn,nhd->qhgd', p_c.astype(vc.dtype), vc)
        imp = jnp.einsum('qhn,nj->qhj', p_c.sum(axis=2), ovl)
        j = jnp.arange(ns)[None, :]
        cur = (t // SLC_BLOCK)[:, None]
        valid = j <= cur
        forced = (j == 0) | (j == cur) | (j == cur - 1)
        score = jnp.where(valid[:, None, :], jnp.where(forced[:, None, :], FORCED_SCORE, imp), -1.0)
        vals, idx = lax.top_k(score, topk)
        sel_ok = vals >= 0.0
        idx_h = jnp.transpose(idx, (1, 0, 2))
        k_sel = jax.vmap(lambda kb, ib: kb[ib])(ks_blk, idx_h)
        v_sel = jax.vmap(lambda vb, ib: vb[ib])(vs_blk, idx_h)
        pos = idx[..., None] * SLC_BLOCK + jnp.arange(SLC_BLOCK)
        s = jnp.einsum('qhgd,hqnld->qhgnl', qi, k_sel).astype(jnp.float32) * scale
        dist = (t[:, None, None, None] - pos).astype(jnp.float32)
        s = s - slopes[None, :, :, None, None] * dist[:, :, None]
        mask_s = (sel_ok[..., None] & (pos <= t[:, None, None, None]))[:, :, None]
        s = s.reshape(Q_BLOCK, N_KV_HEADS, GQA_GROUP, topk * SLC_BLOCK)
        mask_s = mask_s.reshape(Q_BLOCK, N_KV_HEADS, 1, topk * SLC_BLOCK)
        p_s = masked_softmax(s, mask_s)
        v_flat = v_sel.reshape(N_KV_HEADS, Q_BLOCK, topk * SLC_BLOCK, HEAD_DIM)
        o_s = jnp.einsum('qhgm,hqmd->qhgd', p_s.astype(v_flat.dtype), v_flat)
        kwin = lax.dynamic_slice_in_dim(kw_p, b * Q_BLOCK, Q_BLOCK + WINDOW, axis=0)
        vwin = lax.dynamic_slice_in_dim(vw_p, b * Q_BLOCK, Q_BLOCK + WINDOW, axis=0)
        spos = b * Q_BLOCK - WINDOW + jnp.arange(Q_BLOCK + WINDOW)
        s = jnp.einsum('qhgd,khd->qhgk', qi, kwin).astype(jnp.float32) * scale
        dist = t[:, None] - spos[None, :]
        s = s - slopes[None, :, :, None] * dist.astype(jnp.float32)[:, None, None, :]
        mask_w = ((dist >= 0) & (dist < WINDOW) & (spos[None, :] >= 0))[:, None, None, :]
        p_w = masked_softmax(s, mask_w)
        o_w = jnp.einsum('qhgk,khd->qhgd', p_w.astype(vwin.dtype), vwin)
        g = jax.nn.sigmoid(gi.astype(jnp.float32))
        o = g[..., 0:1] * o_c + g[..., 1:2] * o_s + g[..., 2:3] * o_w
        return o.astype(q.dtype)

    out = lax.map(block, (jnp.arange(nb), qb, gb))
    return out.reshape(T, NSA_WIDTH)


def hybrid_layer(x, norm_g, w_in, merge_bias, pool_w, pool_scale, q_norm_g, k_norm_g, cmp_pe, cmp_w1, cmp_b1, cmp_w2, w_pool_up, w_nsa_up, w_out):
    B, T, _ = x.shape
    h = rms_norm(x, norm_g)
    proj = h @ w_in
    pool_u, pool_z, q, nsa_z, kc, vc, ks, vs, kw, vw, nsa_g, merge_g = jnp.split(proj, split_points(), axis=-1)
    pool_out = pool_mixer(pool_u, pool_w, pool_scale) * jax.nn.silu(pool_z)
    heads = lambda a: a.reshape(B, T, N_KV_HEADS, HEAD_DIM)
    q = rms_norm(q.reshape(B, T, N_Q_HEADS, HEAD_DIM), q_norm_g)
    comp = jax.vmap(compress, in_axes=(0, None, None, None, None))
    kc = rms_norm(comp(heads(kc), cmp_pe[0], cmp_w1[0], cmp_b1[0], cmp_w2[0]), k_norm_g[0])
    vc = comp(heads(vc), cmp_pe[1], cmp_w1[1], cmp_b1[1], cmp_w2[1])
    ks = rms_norm(heads(ks), k_norm_g[1])
    kw = rms_norm(heads(kw), k_norm_g[2])
    gates = nsa_g.reshape(B, T, N_Q_HEADS, N_NSA_BRANCHES)
    o = jax.vmap(nsa_sequence)(q, kc, vc, ks, heads(vs), kw, heads(vw), gates)
    nsa_out = o * jax.nn.silu(nsa_z)
    gm = jax.nn.sigmoid(merge_g.reshape(B, T, N_MERGE, D_MODEL) + merge_bias)
    y = gm[:, :, 0] * (pool_out @ w_pool_up) + gm[:, :, 1] * (nsa_out @ w_nsa_up)
    return x + (y.astype(x.dtype) @ w_out)


def setup_inputs(seed: int = 0) -> dict:
    key = jax.random.key(seed)
    ks = jax.random.split(key, 16)

    def nrm(k, shape, s):
        return jax.random.normal(k, shape, jnp.float32) * s

    return {
        'x': nrm(ks[0], (BATCH, SEQ, D_MODEL), 1.0),
        'norm_g': 1.0 + nrm(ks[1], (DEPTH, D_MODEL), 0.02),
        'w_in': nrm(ks[2], (DEPTH, D_MODEL, IN_WIDTH), D_MODEL ** -0.5),
        'merge_bias': nrm(ks[3], (DEPTH, N_MERGE, D_MODEL), 0.01),
        'pool_w': nrm(ks[4], (DEPTH, POOL_GROUPS, POOL_GROUP_DIM, POOL_GROUP_DIM), POOL_GROUP_DIM ** -0.5),
        'pool_scale': 1.0 + nrm(ks[5], (DEPTH, POOL_WIDTH), 0.1),
        'q_norm_g': 1.0 + nrm(ks[6], (DEPTH, HEAD_DIM), 0.02),
        'k_norm_g': 1.0 + nrm(ks[7], (DEPTH, N_NSA_BRANCHES, HEAD_DIM), 0.02),
        'cmp_pe': nrm(ks[8], (DEPTH, 2, CMP_BLOCK, HEAD_DIM), 0.1),
        'cmp_w1': nrm(ks[9], (DEPTH, 2, CMP_BLOCK * HEAD_DIM, HEAD_DIM), (CMP_BLOCK * HEAD_DIM) ** -0.5),
        'cmp_b1': nrm(ks[10], (DEPTH, 2, HEAD_DIM), 0.01),
        'cmp_w2': nrm(ks[11], (DEPTH, 2, HEAD_DIM, HEAD_DIM), HEAD_DIM ** -0.5),
        'w_pool_up': nrm(ks[12], (DEPTH, POOL_WIDTH, D_MODEL), POOL_WIDTH ** -0.5),
        'w_nsa_up': nrm(ks[13], (DEPTH, NSA_WIDTH, D_MODEL), NSA_WIDTH ** -0.5),
        'w_out': nrm(ks[14], (DEPTH, D_MODEL, D_MODEL), D_MODEL ** -0.5),
    }


def reference(x, norm_g, w_in, merge_bias, pool_w, pool_scale, q_norm_g, k_norm_g, cmp_pe, cmp_w1, cmp_b1, cmp_w2, w_pool_up, w_nsa_up, w_out):
    for l in range(DEPTH):
        x = hybrid_layer(x, norm_g[l], w_in[l], merge_bias[l], pool_w[l], pool_scale[l], q_norm_g[l], k_norm_g[l], cmp_pe[l], cmp_w1[l], cmp_b1[l], cmp_w2[l], w_pool_up[l], w_nsa_up[l], w_out[l])
    return x
```

```cpp
#include <hip/hip_runtime.h>
#include <cstdio>
#include <cstdint>

#ifndef MK_MULTI
#define MK_MULTI 0
#endif

#define DI __device__ __forceinline__
#define GAS __attribute__((address_space(1)))
#define LAS __attribute__((address_space(3)))
typedef unsigned short bf16;
typedef short bf16x8 __attribute__((ext_vector_type(8)));
typedef float f32x2 __attribute__((ext_vector_type(2)));
typedef float f32x4 __attribute__((ext_vector_type(4)));
typedef float f32x16 __attribute__((ext_vector_type(16)));
typedef unsigned u32x2 __attribute__((ext_vector_type(2)));
typedef unsigned u32x4 __attribute__((ext_vector_type(4)));
typedef __bf16 bf16x2_t __attribute__((ext_vector_type(2)));
typedef GAS unsigned gu32;

constexpr int T = 8192, DM = 4096, PW = 2048, NSAW = 2048, KVW = 512, HD = 128, NQH = 16, NKVH = 4, DEPTH = 4;
constexpr int NIN = 19504, NPAD = 19712, NINT = NPAD / 256;
constexpr int KV6W = 3072;
constexpr int NCP = 512;
constexpr float EPS = 1e-6f, NEG = -1e30f, LOG2E = 1.4426950408889634f;
constexpr int NWAVES = 8, NTHR = 512;

constexpr size_t al256(size_t x) { return (x + 255) & ~(size_t)255; }
constexpr size_t WS_CTL = 0, CTL_ZERO_BYTES = 1u << 20;
constexpr size_t SZ_WIN = (size_t)NPAD * DM * 2, SZ_POOLW = (size_t)4 * 512 * 512 * 2, SZ_WUP = (size_t)DM * PW * 2, SZ_WOUT = (size_t)DM * DM * 2;
constexpr size_t SZ_W1 = (size_t)2 * 128 * 4096 * 2, SZ_W2 = (size_t)2 * 128 * 128 * 2;
constexpr size_t WS_WIN = CTL_ZERO_BYTES;
constexpr size_t WS_POOLW = WS_WIN + DEPTH * SZ_WIN;
constexpr size_t WS_WPU = WS_POOLW + DEPTH * SZ_POOLW;
constexpr size_t WS_WNU = WS_WPU + DEPTH * SZ_WUP;
constexpr size_t WS_WOUT = WS_WNU + DEPTH * SZ_WUP;
constexpr size_t WS_W1 = WS_WOUT + DEPTH * SZ_WOUT;
constexpr size_t WS_W2 = WS_W1 + DEPTH * SZ_W1;
constexpr size_t WS_H = WS_W2 + DEPTH * SZ_W2;
constexpr size_t WS_U = WS_H + (size_t)T * DM * 2;
constexpr size_t WS_ZP = WS_U + (size_t)T * PW * 2;
constexpr size_t WS_QR = WS_ZP + (size_t)T * PW * 2;
constexpr size_t WS_ZN = WS_QR + (size_t)T * NSAW * 2;
constexpr size_t WS_KV6 = WS_ZN + (size_t)T * NSAW * 2;
constexpr size_t WS_GM = WS_KV6 + (size_t)T * KV6W * 2;
constexpr size_t WS_NG = WS_GM + (size_t)T * 8192 * 2;
constexpr size_t WS_MP = WS_NG + (size_t)T * 256 * 2;
constexpr size_t WS_QN = WS_MP + (size_t)T * PW * 2;
constexpr size_t WS_KSN = WS_QN + (size_t)T * NSAW * 2;
constexpr size_t WS_KWN = WS_KSN + (size_t)4 * T * 128 * 2;
constexpr size_t WS_VST = WS_KWN + (size_t)4 * T * 128 * 2;
constexpr size_t WS_VWT = WS_VST + (size_t)4 * T * 128 * 2;
constexpr size_t WS_KCN = WS_VWT + (size_t)4 * T * 128 * 2;
constexpr size_t WS_VCT = WS_KCN + (size_t)4 * NCP * 128 * 2;
constexpr size_t WS_PO = WS_VCT + (size_t)4 * NCP * 128 * 2;
constexpr size_t WS_NO = WS_PO + (size_t)T * PW * 2;
constexpr size_t WS_Y = WS_NO + (size_t)T * NSAW * 2;
constexpr size_t WS_END = WS_Y + (size_t)T * DM * 2;
constexpr int CW_BAR = 4096;

constexpr int RING_BYTES = 131072, LDSCTL_OFF = 140288  , MISC_OFF = LDSCTL_OFF + 320, SELW_OFF = LDSCTL_OFF + 2048, LDS_BYTES = 147456;

#define RLX_AGENT __ATOMIC_RELAXED, __HIP_MEMORY_SCOPE_AGENT
#define LDS_WAIT() asm volatile("s_waitcnt lgkmcnt(0)" ::: "memory")
DI unsigned f2bf(float f) { unsigned u = __builtin_bit_cast(unsigned, f); return (u + 0x7fffu + ((u >> 16) & 1u)) >> 16; }
DI unsigned pk2(float lo, float hi) { f32x2 v = {lo, hi}; bf16x2_t b = __builtin_convertvector(v, bf16x2_t); return __builtin_bit_cast(unsigned, b); }
DI float bflo(unsigned u) { return __builtin_bit_cast(float, u << 16); }
DI float bfhi(unsigned u) { return __builtin_bit_cast(float, u & 0xffff0000u); }
DI float ex2(float x) { return __builtin_amdgcn_exp2f(x); }
DI float rcpf(float x) { return __builtin_amdgcn_rcpf(x); }
DI float sigm(float v) { return rcpf(1.f + ex2(-v * LOG2E)); }
DI float wave_sum(float v) {
#pragma unroll
    for (int o = 1; o < 64; o <<= 1) v += __shfl_xor(v, o);
    return v;
}
DI float sum16(float v) {
#pragma unroll
    for (int o = 1; o < 16; o <<= 1) v += __shfl_xor(v, o);
    return v;
}
DI void unpack8(const u32x4 w, float (&f)[8]) {
    f[0] = bflo(w.x); f[1] = bfhi(w.x); f[2] = bflo(w.y); f[3] = bfhi(w.y); f[4] = bflo(w.z); f[5] = bfhi(w.z); f[6] = bflo(w.w); f[7] = bfhi(w.w);
}
DI u32x4 pack8(const float (&f)[8]) { u32x4 w; w.x = pk2(f[0], f[1]); w.y = pk2(f[2], f[3]); w.z = pk2(f[4], f[5]); w.w = pk2(f[6], f[7]); return w; }

namespace pg8 {
typedef unsigned short bf16_t;
constexpr int BM = 256, BK = 64, HALF = 128, HTB = HALF * BK * 2, NXCD = 8, WGM = 8;
DI int lds_byte(int r, int c) { const int st = (r >> 4) * 2 + (c >> 5), rr = r & 15, cc = c & 31, ob = rr * 64 + cc * 2; return st * 1024 + (ob ^ (((ob >> 9) & 1) << 5)); }
DI void stage_rc(int b, int& R, int& C) { const int st = b / 1024, sb = b % 1024, swz = sb ^ (((sb >> 9) & 1) << 5); R = (st >> 1) * 16 + swz / 64; C = (st & 1) * 32 + (swz % 64) / 2; }
DI int perm32(int rho) { const int n = rho >> 4, i = rho & 15; return 8 * (i >> 2) + 4 * n + (i & 3); }

struct Unit { int pm, pn, aux; const char* a; const char* b; };
struct Gemm { int lda, ldb, K; };

DI void tile_of(int L, int nM, int nN, int& pm, int& pn) {
    const int nwg = nM * nN; int wgid = L;
    { const int q = nwg / NXCD, r = nwg % NXCD, xcd = wgid % NXCD, off = wgid / NXCD; wgid = (xcd < r ? xcd * (q + 1) : r * (q + 1) + (xcd - r) * q) + off; }
    const int nig = WGM * nN, gid = wgid / nig, fm = gid * WGM, gsz = (nM - fm) < WGM ? (nM - fm) : WGM;
    pm = fm + ((wgid % nig) % gsz); pn = (wgid % nig) / gsz;
}

template <class Epi, class Sched, bool ALIGN_EPI>
DI void gemm_phase(LAS unsigned char* lds, const Gemm g, const Sched& S, const Epi& E, const int tid) {
    const int wid = __builtin_amdgcn_readfirstlane(tid >> 6), lane = tid & 63, wr = wid >> 2, wc = wid & 3, fr = lane & 15, fq = lane >> 4;
    const int K = g.K, nt = K / BK;
    unsigned voffA[2], voffB[2];
#pragma unroll
    for (int i = 0; i < 2; ++i) { int R, C; stage_rc(tid * 16 + i * 8192, R, C); const int Rb = Epi::PERM ? ((R & ~31) + perm32(R & 31)) : R;
        voffA[i] = (unsigned)(R * g.lda + C) * 2u; voffB[i] = (unsigned)(Rb * g.ldb + C) * 2u; }
    const size_t kstep = (size_t)(BK * 2);
    const size_t hsA = (size_t)HALF * g.lda * 2, hsB = (size_t)HALF * g.ldb * 2;
    const unsigned ldsw = (unsigned)wid * 1024u;
    const int aoff = lds_byte(wr * 64 + fr, fq * 8), boff = lds_byte(wc * 32 + fr, fq * 8);
#define PG8_SA(b, h) (((b) * 2 + (h)) * HTB)
#define PG8_SB(b, h) ((4 + (b) * 2 + (h)) * HTB)
#define PG8_STAGE(bufoff, gbase, voff) do { _Pragma("unroll") for (int _i = 0; _i < 2; ++_i) \
        __builtin_amdgcn_global_load_lds((const unsigned*)((const char*)(gbase) + (voff)[_i]), (LAS unsigned*)(lds + (bufoff) + ldsw + _i * 8192), 16, 0, 0); } while (0)
#define PG8_LDA(dst, b, h) do { _Pragma("unroll") for (int m = 0; m < 4; ++m) _Pragma("unroll") for (int k = 0; k < 2; ++k) dst[m][k] = *(const LAS bf16x8*)(lds + PG8_SA(b, h) + aoff + m * 2048 + k * 1024); } while (0)
#define PG8_LDB(dst, b, h) do { _Pragma("unroll") for (int n = 0; n < 2; ++n) _Pragma("unroll") for (int k = 0; k < 2; ++k) dst[n][k] = *(const LAS bf16x8*)(lds + PG8_SB(b, h) + boff + n * 2048 + k * 1024); } while (0)
#define PG8_MMA(ai, bj, At, Bt) do { __builtin_amdgcn_s_setprio(1); _Pragma("unroll") for (int m = 0; m < 4; ++m) _Pragma("unroll") for (int n = 0; n < 2; ++n) _Pragma("unroll") for (int k = 0; k < 2; ++k) \
        acc[ai][bj][m][n] = __builtin_amdgcn_mfma_f32_16x16x32_bf16(Bt[n][k], At[m][k], acc[ai][bj][m][n], 0, 0, 0); __builtin_amdgcn_s_setprio(0); } while (0)
#define PG8_WAIT_V(n) asm volatile("s_waitcnt vmcnt(" #n ")" ::: "memory")
#define PG8_WAIT_L(n) asm volatile("s_waitcnt lgkmcnt(" #n ")" ::: "memory")
#define PG8_BAR __builtin_amdgcn_s_barrier()
#define PG8_SCHED __builtin_amdgcn_sched_barrier(0)
    Unit cur, nxt; int ui = 0;
    if (!S.next(0, cur)) return;
    f32x4 acc[2][2][4][2];
#pragma unroll
    for (int a = 0; a < 2; ++a)
#pragma unroll
        for (int b = 0; b < 2; ++b)
#pragma unroll
            for (int m = 0; m < 4; ++m)
#pragma unroll
                for (int n = 0; n < 2; ++n) acc[a][b][m][n] = (f32x4){0.f, 0.f, 0.f, 0.f};
    bf16x8 At[4][2], B0[2][2], B1[2][2];
    const char* cA = cur.a; const char* cB = cur.b;
    PG8_STAGE(PG8_SB(0, 0), cB, voffB); PG8_STAGE(PG8_SB(0, 1), cB + hsB, voffB); PG8_STAGE(PG8_SA(0, 0), cA, voffA); PG8_STAGE(PG8_SA(0, 1), cA + hsA, voffA);
    if (wr == 1) PG8_BAR;
    PG8_WAIT_V(2); PG8_BAR;
    PG8_STAGE(PG8_SB(1, 0), cB + kstep, voffB); PG8_STAGE(PG8_SA(1, 0), cA + kstep, voffA); PG8_STAGE(PG8_SB(1, 1), cB + hsB + kstep, voffB);
    PG8_WAIT_V(6); PG8_BAR;
    for (;;) {
        const bool has_next = S.next(ui + 1, nxt);
        const char* nA = has_next ? nxt.a : cA; const char* nB = has_next ? nxt.b : cB;
        for (int t = 0; t < nt; t += 2) {
            const bool last = (t == nt - 2);
            const char* a1 = cA + (size_t)(t + 1) * kstep;
            const char* a2 = last ? nA : cA + (size_t)(t + 2) * kstep; const char* b2 = last ? nB : cB + (size_t)(t + 2) * kstep;
            const char* a3 = a2 + kstep; const char* b3 = b2 + kstep;
            PG8_LDB(B0, 0, 0); PG8_LDB(B1, 0, 1); PG8_SCHED; PG8_LDA(At, 0, 0); PG8_STAGE(PG8_SA(1, 1), a1 + hsA, voffA);
            PG8_WAIT_V(8); PG8_WAIT_L(0); PG8_BAR; PG8_MMA(0, 0, At, B0); PG8_MMA(0, 1, At, B1); PG8_BAR; PG8_SCHED;
            PG8_LDA(At, 0, 1); PG8_STAGE(PG8_SB(0, 0), b2, voffB); PG8_STAGE(PG8_SB(0, 1), b2 + hsB, voffB); PG8_STAGE(PG8_SA(0, 0), a2, voffA);
            PG8_WAIT_V(8); PG8_WAIT_L(0); PG8_BAR; PG8_MMA(1, 0, At, B0); PG8_MMA(1, 1, At, B1); PG8_BAR; PG8_SCHED;
            PG8_LDB(B0, 1, 0); PG8_LDB(B1, 1, 1); PG8_SCHED; PG8_LDA(At, 1, 0); PG8_STAGE(PG8_SA(0, 1), a2 + hsA, voffA);
            PG8_WAIT_V(8); PG8_WAIT_L(0); PG8_BAR; PG8_MMA(0, 0, At, B0); PG8_MMA(0, 1, At, B1); PG8_BAR; PG8_SCHED;
            PG8_LDA(At, 1, 1); PG8_STAGE(PG8_SB(1, 0), b3, voffB); PG8_STAGE(PG8_SB(1, 1), b3 + hsB, voffB); PG8_STAGE(PG8_SA(1, 0), a3, voffA);
            PG8_WAIT_V(8); PG8_WAIT_L(0); PG8_BAR; PG8_MMA(1, 0, At, B0); PG8_MMA(1, 1, At, B1); PG8_BAR; PG8_SCHED;
        }
        if constexpr (ALIGN_EPI) { if (wr == 0) PG8_BAR; }
        E(acc, cur, wr, wc, fr, fq);
        if (!has_next) break;
#pragma unroll
        for (int a = 0; a < 2; ++a)
#pragma unroll
            for (int b = 0; b < 2; ++b)
#pragma unroll
                for (int m = 0; m < 4; ++m)
#pragma unroll
                    for (int n = 0; n < 2; ++n) acc[a][b][m][n] = (f32x4){0.f, 0.f, 0.f, 0.f};
        cur = nxt; cA = nA; cB = nB; ++ui;
        if constexpr (ALIGN_EPI) { if (wr == 1) PG8_BAR; }
    }
    PG8_WAIT_V(0);
    if constexpr (!ALIGN_EPI) { if (wr == 0) PG8_BAR; }
    PG8_BAR;
#undef PG8_SA
#undef PG8_SB
#undef PG8_STAGE
#undef PG8_LDA
#undef PG8_LDB
#undef PG8_MMA
#undef PG8_WAIT_V
#undef PG8_WAIT_L
#undef PG8_BAR
#undef PG8_SCHED
}

struct SchedPlain {
    const char* A; const char* B; int nM, nN, G, c; size_t ta, tb;
    DI bool next(int i, Unit& u) const { const long L = (long)i * G + c; if (L >= (long)nM * nN) return false; tile_of((int)L, nM, nN, u.pm, u.pn); u.aux = 0; u.a = A + (size_t)u.pm * ta; u.b = B + (size_t)u.pn * tb; return true; }
};
struct SchedPool {
    const char* A; const char* B; int G, c;
    DI bool next(int i, Unit& u) const { const int L = i * G + c; if (L >= 256) return false; u.pm = L >> 3; u.pn = L & 7; u.aux = 0; const int grp = u.pn >> 1, half = u.pn & 1;
        u.a = A + ((size_t)u.pm * 256 * PW + (size_t)grp * 512) * 2; u.b = B + ((size_t)grp * 512 * 512 + (size_t)half * 256 * 512) * 2; return true; }
};
struct SchedUp {
    const char* A0; const char* A1; const char* B0; const char* B1; int G, c;
    DI bool next(int i, Unit& u) const { const long L = (long)(i >> 1) * G + c; if (L >= 32 * 16) return false; tile_of((int)L, 32, 16, u.pm, u.pn); u.aux = i & 1;
        u.a = (u.aux ? A1 : A0) + (size_t)u.pm * 256 * PW * 2; u.b = (u.aux ? B1 : B0) + (size_t)u.pn * 256 * PW * 2; return true; }
};

struct EpiIn {
    static constexpr bool PERM = true;
    bf16_t *U, *ZP, *QR, *ZN, *KV6, *GM, *NG; const float* mbias;
    DI void operator()(const f32x4 (&acc)[2][2][4][2], const Unit& u, int wr, int wc, int fr, int fq) const {
        const int pn = u.pn; bf16_t* base; int ldc, colt, mode;
        if (pn < 8) { base = U; ldc = PW; colt = pn * 256; mode = 0; }
        else if (pn < 16) { base = ZP; ldc = PW; colt = (pn - 8) * 256; mode = 1; }
        else if (pn < 24) { base = QR; ldc = NSAW; colt = (pn - 16) * 256; mode = 0; }
        else if (pn < 32) { base = ZN; ldc = NSAW; colt = (pn - 24) * 256; mode = 1; }
        else if (pn < 44) { base = KV6; ldc = KV6W; colt = (pn - 32) * 256; mode = 0; }
        else if (pn < 76) { base = GM; ldc = 8192; colt = (pn - 44) * 256; mode = 2; }
        else { base = NG; ldc = 256; colt = 0; mode = 3; }
        const int row0 = u.pm * BM + wr * 64 + fr, col0 = colt + wc * 32 + 8 * fq;
        f32x4 bv[2][2];
#pragma unroll
        for (int bj = 0; bj < 2; ++bj)
#pragma unroll
            for (int n = 0; n < 2; ++n) bv[bj][n] = (mode == 2) ? *(const f32x4*)(mbias + col0 + bj * HALF + 4 * n) : (f32x4){0.f, 0.f, 0.f, 0.f};
#pragma unroll
        for (int ai = 0; ai < 2; ++ai)
#pragma unroll
            for (int m = 0; m < 4; ++m) { bf16_t* rowp = base + (size_t)(row0 + ai * HALF + m * 16) * ldc + col0;
#pragma unroll
                for (int bj = 0; bj < 2; ++bj) { f32x4 v0 = acc[ai][bj][m][0] + bv[bj][0], v1 = acc[ai][bj][m][1] + bv[bj][1];
                    if (mode != 0) {
#pragma unroll
                        for (int e = 0; e < 4; ++e) { const float s0 = sigm(v0[e]), s1 = sigm(v1[e]); v0[e] = (mode == 1) ? v0[e] * s0 : s0; v1[e] = (mode == 1) ? v1[e] * s1 : s1; }
                    }
                    u32x4 w; w.x = pk2(v0[0], v0[1]); w.y = pk2(v0[2], v0[3]); w.z = pk2(v1[0], v1[1]); w.w = pk2(v1[2], v1[3]);
                    *(u32x4*)(rowp + bj * HALF) = w; } }
    }
};
struct EpiPool {
    static constexpr bool PERM = true;
    bf16_t* O; const bf16_t* ZP; const float* scale;
    DI void operator()(const f32x4 (&acc)[2][2][4][2], const Unit& u, int wr, int wc, int fr, int fq) const {
        const int row0 = u.pm * BM + wr * 64 + fr, col0 = u.pn * BM + wc * 32 + 8 * fq;
        f32x4 sv[2][2];
#pragma unroll
        for (int bj = 0; bj < 2; ++bj)
#pragma unroll
            for (int n = 0; n < 2; ++n) sv[bj][n] = *(const f32x4*)(scale + col0 + bj * HALF + 4 * n);
#pragma unroll
        for (int ai = 0; ai < 2; ++ai)
#pragma unroll
            for (int m = 0; m < 4; ++m) { const size_t ro = (size_t)(row0 + ai * HALF + m * 16) * PW + col0;
#pragma unroll
                for (int bj = 0; bj < 2; ++bj) { const u32x4 z = *(const u32x4*)(ZP + ro + bj * HALF); float zf[8]; unpack8(z, zf);
                    const f32x4 v0 = acc[ai][bj][m][0] * sv[bj][0], v1 = acc[ai][bj][m][1] * sv[bj][1];
                    u32x4 w; w.x = pk2(v0[0] * zf[0], v0[1] * zf[1]); w.y = pk2(v0[2] * zf[2], v0[3] * zf[3]); w.z = pk2(v1[0] * zf[4], v1[1] * zf[5]); w.w = pk2(v1[2] * zf[6], v1[3] * zf[7]);
                    *(u32x4*)(O + ro + bj * HALF) = w; } }
    }
};
struct EpiUp {
    static constexpr bool PERM = true;
    bf16_t* Y; const bf16_t* GM;
    DI void operator()(const f32x4 (&acc)[2][2][4][2], const Unit& u, int wr, int wc, int fr, int fq) const {
        const int row0 = u.pm * BM + wr * 64 + fr, col0 = u.pn * BM + wc * 32 + 8 * fq; const int which = u.aux;
        if (which) asm volatile("s_waitcnt vmcnt(0)" ::: "memory");
#pragma unroll
        for (int ai = 0; ai < 2; ++ai)
#pragma unroll
            for (int m = 0; m < 4; ++m) { const int row = row0 + ai * HALF + m * 16;
#pragma unroll
                for (int bj = 0; bj < 2; ++bj) { const int col = col0 + bj * HALF;
                    const u32x4 gw = *(const u32x4*)(GM + (size_t)row * 8192 + which * DM + col); float gf[8]; unpack8(gw, gf);
                    float yo[8];
                    if (which) { const u32x4 yw = *(const u32x4*)(Y + (size_t)row * DM + col); unpack8(yw, yo); }
                    else {
#pragma unroll
                        for (int e = 0; e < 8; ++e) yo[e] = 0.f; }
                    const f32x4 v0 = acc[ai][bj][m][0], v1 = acc[ai][bj][m][1];
                    float r[8];
#pragma unroll
                    for (int e = 0; e < 4; ++e) { r[e] = yo[e] + gf[e] * v0[e]; r[4 + e] = yo[4 + e] + gf[4 + e] * v1[e]; }
                    *(u32x4*)(Y + (size_t)row * DM + col) = pack8(r); } }
    }
};
struct EpiOut {
    static constexpr bool PERM = true;
    const float* X; float* O;
    DI void operator()(const f32x4 (&acc)[2][2][4][2], const Unit& u, int wr, int wc, int fr, int fq) const {
        const int row0 = u.pm * BM + wr * 64 + fr, col0 = u.pn * BM + wc * 32 + 8 * fq;
#pragma unroll
        for (int ai = 0; ai < 2; ++ai)
#pragma unroll
            for (int m = 0; m < 4; ++m) { const size_t ro = (size_t)(row0 + ai * HALF + m * 16) * DM + col0;
#pragma unroll
                for (int bj = 0; bj < 2; ++bj)
#pragma unroll
                    for (int n = 0; n < 2; ++n) { const f32x4 xo = *(const f32x4*)(X + ro + bj * HALF + 4 * n); *(f32x4*)(O + ro + bj * HALF + 4 * n) = xo + acc[ai][bj][m][n]; } }
    }
};
}

#define XB_TMO      128
#define XB_XCNT(j)  (256  + 64 * (j))
#define XB_XSUB(j)  (1280 + 64 * (j))
#define XB_XGEN(j)  (2304 + 64 * (j))
#define XB_TOP      3328
#define XB_TOPGEN   3392
#define XCD_BAR_WORDS 3456
#define XB_SPIN_CAP (1u << 22)
DI unsigned xb_ld(unsigned* p)              { return __hip_atomic_load(p, __ATOMIC_RELAXED, __HIP_MEMORY_SCOPE_AGENT); }
DI unsigned xb_add(unsigned* p, unsigned v) { return __hip_atomic_fetch_add(p, v, __ATOMIC_RELAXED, __HIP_MEMORY_SCOPE_AGENT); }
DI unsigned xb_xcc_id() { return (unsigned)__builtin_amdgcn_s_getreg((3 << 11) | 20) & 0xFu; }
#define XB_SPIN(cond, bar) do { unsigned _sp = 0; while (cond) { __builtin_amdgcn_s_sleep(1); \
    if ((++_sp & 255u) == 0u) { if (xb_ld(&(bar)[XB_TMO])) break; if (_sp > XB_SPIN_CAP) { atomicAdd(&(bar)[XB_TMO], 1u); break; } } } } while (0)
struct XcdBarrier { unsigned* bar; unsigned x; volatile LAS unsigned* st; };
DI XcdBarrier xcd_barrier_post(unsigned* bar, volatile LAS unsigned* st) {
    XcdBarrier b; b.bar = bar; b.x = xb_xcc_id(); b.st = st;
    if (threadIdx.x == 0) (void)xb_add(&bar[XB_XCNT(b.x)], 1u);
    return b;
}
DI void xcd_barrier_complete(unsigned* bar, unsigned x, unsigned& nloc, unsigned& nx) {
    const unsigned G = gridDim.x * gridDim.y * gridDim.z;
    unsigned sum, cnt, mine, sp = 0u;
    for (;;) {
        sum = 0u; cnt = 0u; mine = 0u;
#pragma unroll
        for (unsigned j = 0; j < 16; ++j) { const unsigned c = xb_ld(&bar[XB_XCNT(j)]); sum += c; cnt += (c > 0u) ? 1u : 0u; mine = (j == x) ? c : mine; }
        if (sum == G) break;
        __builtin_amdgcn_s_sleep(1);
        if ((++sp & 255u) == 0u) { if (xb_ld(&bar[XB_TMO])) break; if (sp > XB_SPIN_CAP) { atomicAdd(&bar[XB_TMO], 1u); break; } }
    }
    nloc = mine > 0u ? mine : 1u; nx = cnt > 0u ? cnt : 1u;
}
DI void xcd_barrier(const XcdBarrier& b) {
    asm volatile("s_waitcnt vmcnt(0)" ::: "memory");
    __syncthreads();
    if (threadIdx.x == 0) {
        unsigned* bar = b.bar;
        __builtin_amdgcn_s_waitcnt(0);
        unsigned nloc = b.st[0], nx = b.st[1];
        if (nloc == 0u) { xcd_barrier_complete(bar, b.x, nloc, nx); b.st[0] = nloc; b.st[1] = nx; }
        const unsigned old = xb_add(&bar[XB_XSUB(b.x)], 1u);
        const unsigned gen = old / nloc;
        if (old + 1u == (gen + 1u) * nloc) {
            __builtin_amdgcn_fence(__ATOMIC_RELEASE, "agent");
            asm volatile("s_waitcnt vmcnt(0)" ::: "memory");
            const unsigned og = xb_add(&bar[XB_TOP], 1u);
            const unsigned tg = og / nx;
            if (og + 1u == (tg + 1u) * nx) xb_add(&bar[XB_TOPGEN], 1u);
            else XB_SPIN(xb_ld(&bar[XB_TOPGEN]) == tg, bar);
            __builtin_amdgcn_fence(__ATOMIC_ACQUIRE, "agent");
            xb_add(&bar[XB_XGEN(b.x)], 1u);
            asm volatile("s_waitcnt vmcnt(0)" ::: "memory");
        } else {
            XB_SPIN(xb_ld(&bar[XB_XGEN(b.x)]) == gen, bar);
            __builtin_amdgcn_fence(__ATOMIC_ACQUIRE, "agent");
            asm volatile("s_waitcnt vmcnt(0)" ::: "memory");
        }
    }
    __syncthreads();
}

struct Args { const float* in[15]; float* out; unsigned char* ws; int st_lo, st_hi; };

DI void tr_item(const float* src, int pitch, int scol, bf16* dst, int dpitch, LAS float* scr, int lane) {
#pragma unroll 8
    for (int i = 0; i < 32; ++i) { const int kk = 2 * i + (lane >> 5); scr[kk * 33 + (lane & 31)] = (scol >= 0) ? src[(size_t)kk * pitch + scol] : 0.f; }
    LDS_WAIT(); asm volatile("" ::: "memory");
    const int c = lane & 7;
#pragma unroll
    for (int j = 0; j < 4; ++j) { const int n = (lane >> 3) + 8 * j; const LAS float* s = scr + (8 * c) * 33 + n;
        u32x4 o; o.x = pk2(s[0 * 33], s[1 * 33]); o.y = pk2(s[2 * 33], s[3 * 33]); o.z = pk2(s[4 * 33], s[5 * 33]); o.w = pk2(s[6 * 33], s[7 * 33]);
        *(u32x4*)(dst + (size_t)n * dpitch + 8 * c) = o; }
    LDS_WAIT(); asm volatile("" ::: "memory");
}
DI void prologue(const Args& a, LAS unsigned char* lds, int gw, int NGW, int wave, int lane) {
    LAS float* scr = (LAS float*)(lds + wave * 16384);
    unsigned char* ws = a.ws;
    constexpr int I_IN = 64 * (NPAD / 32), I_POOL = 4 * 8 * 16, I_UP = 32 * 128, I_OUT = 64 * 128, I_W1 = 2 * 64 * 4, I_W2 = 2 * 2 * 4;
    constexpr int I_LAYER = I_IN + I_POOL + 2 * I_UP + I_OUT + I_W1 + I_W2;
    for (int it = gw; it < DEPTH * I_LAYER; it += NGW) {
        const int l = it / I_LAYER; int r = it % I_LAYER;
        if (r < I_IN) {
            const int nblk = NPAD / 32, kb = r / nblk, nb = r % nblk, np = nb * 32 + (lane & 31);
            int sc; if (np < 11264) sc = np; else if (np < 19456) sc = 11312 + (np - 11264); else if (np < 19504) sc = 11264 + (np - 19456); else sc = -1;
            tr_item(a.in[2] + (size_t)l * DM * NIN + (size_t)kb * 64 * NIN, NIN, sc, (bf16*)(ws + WS_WIN + l * SZ_WIN) + (size_t)nb * 32 * DM + kb * 64, DM, scr, lane); continue; }
        r -= I_IN;
        if (r < I_POOL) {
            const int g = r / 128, q = r % 128, kb = q / 16, nb = q % 16;
            tr_item(a.in[4] + ((size_t)(l * 4 + g) * 512 + kb * 64) * 512, 512, nb * 32 + (lane & 31), (bf16*)(ws + WS_POOLW + l * SZ_POOLW) + ((size_t)g * 512 + nb * 32) * 512 + kb * 64, 512, scr, lane); continue; }
        r -= I_POOL;
        if (r < 2 * I_UP) {
            const int which = r / I_UP, q = r % I_UP, kb = q / 128, nb = q % 128;
            tr_item(a.in[12 + which] + ((size_t)l * PW + kb * 64) * DM, DM, nb * 32 + (lane & 31), (bf16*)(ws + (which ? WS_WNU : WS_WPU) + l * SZ_WUP) + (size_t)nb * 32 * PW + kb * 64, PW, scr, lane); continue; }
        r -= 2 * I_UP;
        if (r < I_OUT) {
            const int kb = r / 128, nb = r % 128;
            tr_item(a.in[14] + ((size_t)l * DM + kb * 64) * DM, DM, nb * 32 + (lane & 31), (bf16*)(ws + WS_WOUT + l * SZ_WOUT) + (size_t)nb * 32 * DM + kb * 64, DM, scr, lane); continue; }
        r -= I_OUT;
        if (r < I_W1) {
            const int i = r / 256, q = r % 256, kb = q / 4, nb = q % 4;
            tr_item(a.in[9] + ((size_t)(l * 2 + i) * 4096 + kb * 64) * 128, 128, nb * 32 + (lane & 31), (bf16*)(ws + WS_W1 + l * SZ_W1) + ((size_t)i * 128 + nb * 32) * 4096 + kb * 64, 4096, scr, lane); continue; }
        r -= I_W1;
        {
            const int i = r / 8, q = r % 8, kb = q / 4, nb = q % 4;
            tr_item(a.in[11] + ((size_t)(l * 2 + i) * 128 + kb * 64) * 128, 128, nb * 32 + (lane & 31), (bf16*)(ws + WS_W2 + l * SZ_W2) + ((size_t)i * 128 + nb * 32) * 128 + kb * 64, 128, scr, lane); }
    }
}

DI void p1_rmsnorm(const float* x, const float* g, bf16* h, int gw, int NGW, int lane) {
    for (int m = gw; m < T; m += NGW) {
        const f32x4* xr = (const f32x4*)(x + (size_t)m * DM) + lane; const f32x4* gr = (const f32x4*)g + lane;
        f32x4 v[16]; float s = 0.f;
#pragma unroll
        for (int j = 0; j < 16; ++j) { v[j] = xr[64 * j]; s += (v[j].x * v[j].x + v[j].y * v[j].y) + (v[j].z * v[j].z + v[j].w * v[j].w); }
        const float rstd = 1.f / sqrtf(wave_sum(s) * (1.f / DM) + EPS);
        u32x2* o = (u32x2*)(h + (size_t)m * DM) + lane;
#pragma unroll
        for (int j = 0; j < 16; ++j) { const f32x4 gg = gr[64 * j]; u32x2 w; w.x = pk2(v[j].x * rstd * gg.x, v[j].y * rstd * gg.y); w.y = pk2(v[j].z * rstd * gg.z, v[j].w * rstd * gg.w); o[64 * j] = w; }
    }
}

struct MidP { const bf16 *U, *QR, *KV6; bf16 *MP, *QN, *KSN, *KWN, *VST, *VWT; const float *qg, *kg; };
DI void p3_mid(const MidP& P, LAS unsigned char* lds, int gw, int NGW, int wave, int lane) {
    for (int it = gw; it < T * 4; it += NGW) {
        const int t = it >> 2, g = it & 3, w = 2 << g, nwin = (t + 1 < w) ? t + 1 : w;
        const bf16* up = P.U + (size_t)t * PW + g * 512 + lane * 8;
        float s[8], u0[8];
        { const u32x4 v = *(const u32x4*)up; unpack8(v, u0);
#pragma unroll
          for (int e = 0; e < 8; ++e) s[e] = u0[e]; }
        for (int i = 1; i < nwin; ++i) { const u32x4 v = *(const u32x4*)(up - (size_t)i * PW); float f[8]; unpack8(v, f);
#pragma unroll
            for (int e = 0; e < 8; ++e) s[e] += f[e]; }
        const float inv = 1.f / (float)nwin; float o[8];
#pragma unroll
        for (int e = 0; e < 8; ++e) o[e] = s[e] * inv - u0[e];
        *(u32x4*)(P.MP + (size_t)t * PW + g * 512 + lane * 8) = pack8(o);
    }
    constexpr float C2 = 0.08838834764831845f * LOG2E;
    for (int t = gw; t < T; t += NGW) {
        float gq[8];
        { const f32x4 g0 = *(const f32x4*)(P.qg + (lane & 15) * 8), g1 = *(const f32x4*)(P.qg + (lane & 15) * 8 + 4); gq[0] = g0.x; gq[1] = g0.y; gq[2] = g0.z; gq[3] = g0.w; gq[4] = g1.x; gq[5] = g1.y; gq[6] = g1.z; gq[7] = g1.w; }
#pragma unroll
        for (int p = 0; p < 4; ++p) { const size_t off = (size_t)t * NSAW + p * 512 + lane * 8; const u32x4 v = *(const u32x4*)(P.QR + off); float f[8]; unpack8(v, f);
            float ss = 0.f;
#pragma unroll
            for (int e = 0; e < 8; ++e) ss += f[e] * f[e];
            const float rs = C2 / sqrtf(sum16(ss) * (1.f / 128.f) + EPS); float o[8];
#pragma unroll
            for (int e = 0; e < 8; ++e) o[e] = f[e] * rs * gq[e];
            *(u32x4*)(P.QN + off) = pack8(o); }
    }
    for (int it = gw; it < T * 2; it += NGW) {
        const int t = it >> 1, which = it & 1, h = lane >> 4;
        const float* kg = P.kg + (1 + which) * 128 + (lane & 15) * 8;
        const u32x4 v = *(const u32x4*)(P.KV6 + (size_t)t * KV6W + (which ? 2048 : 1024) + lane * 8); float f[8]; unpack8(v, f);
        float ss = 0.f;
#pragma unroll
        for (int e = 0; e < 8; ++e) ss += f[e] * f[e];
        const float rs = 1.f / sqrtf(sum16(ss) * (1.f / 128.f) + EPS); float o[8];
#pragma unroll
        for (int e = 0; e < 8; ++e) o[e] = f[e] * rs * kg[e];
        *(u32x4*)((which ? P.KWN : P.KSN) + ((size_t)h * T + t) * 128 + (lane & 15) * 8) = pack8(o);
    }
    LAS bf16* tl = (LAS bf16*)(lds + wave * 17408);
    for (int it = gw; it < 2 * 4 * (T / 64); it += NGW) {
        const int which = it / (4 * (T / 64)), r = it % (4 * (T / 64)), h = r / (T / 64), tb = r % (T / 64);
        const bf16* src = P.KV6 + (size_t)(tb * 64) * KV6W + (which ? 2560 : 1536) + h * 128;
#pragma unroll
        for (int i = 0; i < 16; ++i) { const int tt = i * 4 + (lane >> 4), dc = (lane & 15) * 8; const u32x4 v = *(const u32x4*)(src + (size_t)tt * KV6W + dc); *(LAS u32x4*)(tl + tt * 136 + dc) = v; }
        LDS_WAIT(); asm volatile("" ::: "memory");
        bf16* dst = (which ? P.VWT : P.VST) + (size_t)h * 128 * T + tb * 64;
#pragma unroll
        for (int i = 0; i < 16; ++i) { const int d = i * 8 + (lane >> 3), tc = (lane & 7) * 8; unsigned short e[8];
#pragma unroll
            for (int k = 0; k < 8; ++k) e[k] = tl[(tc + k) * 136 + d];
            u32x4 w; w.x = e[0] | ((unsigned)e[1] << 16); w.y = e[2] | ((unsigned)e[3] << 16); w.z = e[4] | ((unsigned)e[5] << 16); w.w = e[6] | ((unsigned)e[7] << 16);
            *(u32x4*)(dst + (size_t)d * T + tc) = w; }
        LDS_WAIT(); asm volatile("" ::: "memory");
    }
}

struct CmpP { const bf16* KV6; const float* pe; const bf16* W1T; const float* b1; const bf16* W2T; const float* kg0; bf16* KCN; bf16* VCT; };
DI void p3_compress(const CmpP& P, LAS unsigned char* lds, int G, int tid, int wave, int lane) {
    LAS float* red = (LAS float*)lds;
    LAS bf16* hid = (LAS bf16*)(lds + 65536);
    LAS float* out2 = (LAS float*)(lds + 65536 + 8192);
    for (int cu = blockIdx.x; cu < 256; cu += G) {
        const int which = cu & 1, h = (cu >> 1) & 3, n0 = (cu >> 3) * 16;
        const int i = lane & 15, kq = lane >> 4;
        const bf16* w1t = P.W1T + (size_t)which * 128 * 4096; const float* pe = P.pe + which * 4096;
        f32x4 acc[8];
#pragma unroll
        for (int ct = 0; ct < 8; ++ct) acc[ct] = (f32x4){0.f, 0.f, 0.f, 0.f};
        for (int ks = 0; ks < 16; ++ks) {
            const int kk = wave * 512 + ks * 32 + kq * 8, lt = kk >> 7, d = kk & 127, tok = 16 * (n0 + i) + lt;
            float af[8];
            if (tok < T) { const u32x4 v = *(const u32x4*)(P.KV6 + (size_t)tok * KV6W + which * 512 + h * 128 + d); unpack8(v, af); }
            else {
#pragma unroll
                for (int e = 0; e < 8; ++e) af[e] = 0.f; }
            const f32x4 p0 = *(const f32x4*)(pe + kk), p1 = *(const f32x4*)(pe + kk + 4);
            af[0] += p0.x; af[1] += p0.y; af[2] += p0.z; af[3] += p0.w; af[4] += p1.x; af[5] += p1.y; af[6] += p1.z; af[7] += p1.w;
            const bf16x8 a = __builtin_bit_cast(bf16x8, pack8(af));
#pragma unroll
            for (int ct = 0; ct < 8; ++ct) { const bf16x8 b = *(const bf16x8*)(w1t + (size_t)(ct * 16 + i) * 4096 + kk);
                acc[ct] = __builtin_amdgcn_mfma_f32_16x16x32_bf16(a, b, acc[ct], 0, 0, 0); }
        }
#pragma unroll
        for (int ct = 0; ct < 8; ++ct)
#pragma unroll
            for (int e = 0; e < 4; ++e) red[(wave * 16 + kq * 4 + e) * 128 + ct * 16 + i] = acc[ct][e];
        __syncthreads();
        {
            const int n = tid >> 5, c0 = (tid & 31) * 4; f32x4 s = *(const f32x4*)(P.b1 + which * 128 + c0);
#pragma unroll
            for (int w = 0; w < 8; ++w) { const f32x4 v = *(const LAS f32x4*)(red + (w * 16 + n) * 128 + c0); s += v; }
            u32x2 hw; hw.x = pk2(s.x * sigm(s.x), s.y * sigm(s.y)); hw.y = pk2(s.z * sigm(s.z), s.w * sigm(s.w));
            *(LAS u32x2*)(hid + n * 136 + c0) = hw;
        }
        __syncthreads();
        {
            const bf16* w2t = P.W2T + (size_t)which * 128 * 128; f32x4 c2 = (f32x4){0.f, 0.f, 0.f, 0.f};
#pragma unroll
            for (int ks = 0; ks < 4; ++ks) { const bf16x8 a = *(const LAS bf16x8*)(hid + i * 136 + ks * 32 + kq * 8); const bf16x8 b = *(const bf16x8*)(w2t + (size_t)(wave * 16 + i) * 128 + ks * 32 + kq * 8);
                c2 = __builtin_amdgcn_mfma_f32_16x16x32_bf16(a, b, c2, 0, 0, 0); }
#pragma unroll
            for (int e = 0; e < 4; ++e) out2[(kq * 4 + e) * 132 + wave * 16 + i] = c2[e];
        }
        __syncthreads();
        if (which == 0) {
            const int n = wave * 2 + (lane >> 5), c0 = (lane & 31) * 4; const f32x4 v = *(const LAS f32x4*)(out2 + n * 132 + c0);
            float ss = (v.x * v.x + v.y * v.y) + (v.z * v.z + v.w * v.w);
#pragma unroll
            for (int o = 1; o < 32; o <<= 1) ss += __shfl_xor(ss, o);
            const float rs = 1.f / sqrtf(ss * (1.f / 128.f) + EPS); const f32x4 g = *(const f32x4*)(P.kg0 + c0);
            u32x2 w; w.x = pk2(v.x * rs * g.x, v.y * rs * g.y); w.y = pk2(v.z * rs * g.z, v.w * rs * g.w);
            *(u32x2*)(P.KCN + ((size_t)h * NCP + n0 + n) * 128 + c0) = w;
        } else {
            const int c = tid >> 2, nn = (tid & 3) * 4;
            u32x2 w; w.x = pk2(out2[(nn + 0) * 132 + c], out2[(nn + 1) * 132 + c]); w.y = pk2(out2[(nn + 2) * 132 + c], out2[(nn + 3) * 132 + c]);
            *(u32x2*)(P.VCT + ((size_t)h * 128 + c) * NCP + n0 + nn) = w;
        }
        __syncthreads();
    }
}

#define MFMA32(a, b, c) __builtin_amdgcn_mfma_f32_32x32x16_bf16((a), (b), (c), 0, 0, 0)
struct AttP { const bf16 *QN, *KCN, *VCT, *KSN, *VST, *KWN, *VWT, *NG, *ZN; bf16* NO; };

template <int STRIDE, bool EDGE>
DI void qk_tile(f32x16& S, const bf16x8 (&qf)[8], const char* ku  , unsigned koff  , float sl2, int rel0, bool row_ok, int lo) {
    const bf16x8* kp = (const bf16x8*)(ku + koff);
    bf16x8 kf[8];
#pragma unroll
    for (int j = 0; j < 8; ++j) kf[j] = kp[j];
    const float sl2s = sl2 * (float)STRIDE, tb = sl2 * (float)rel0;
#pragma unroll
    for (int r = 0; r < 16; ++r) { const int cr = 16 * (r >> 3) + (r & 7);
        if (EDGE) { const int rel = rel0 + STRIDE * cr; const bool v = row_ok && rel <= 0 && rel >= lo; S[r] = v ? __builtin_fmaf(sl2s, (float)cr, tb) : NEG; }
        else S[r] = __builtin_fmaf(sl2s, (float)cr, row_ok ? tb : NEG); }
#pragma unroll
    for (int j = 0; j < 8; ++j) S = MFMA32(kf[j], qf[j], S);
}
DI float tile_max(const f32x16& S) {
    float mx = S[0];
#pragma unroll
    for (int r = 1; r < 16; ++r) mx = fmaxf(mx, S[r]);
    return fmaxf(mx, __shfl_xor(mx, 32));
}
DI float softmax_step(f32x16& S, float& m, float& l) {
    const float mn = fmaxf(m, tile_max(S)), mu = (mn < -1e29f) ? 0.f : mn, alpha = ex2(m - mu);
    float sum = 0.f;
#pragma unroll
    for (int r = 0; r < 16; ++r) { S[r] = ex2(S[r] - mu); sum += S[r]; }
    l = l * alpha + sum; m = mn; return alpha;
}
DI void pv_tile(f32x16 (&O)[4], const f32x16& Pm, const char* vu  , unsigned voff  , size_t dts  ) {
    bf16x8 vf[4][2];
#pragma unroll
    for (int dt = 0; dt < 4; ++dt) { const char* vp = vu + dt * dts + voff; vf[dt][0] = *(const bf16x8*)vp; vf[dt][1] = *(const bf16x8*)(vp + 32); }
    u32x4 p0, p1;
    p0.x = pk2(Pm[0], Pm[1]); p0.y = pk2(Pm[2], Pm[3]); p0.z = pk2(Pm[4], Pm[5]); p0.w = pk2(Pm[6], Pm[7]);
    p1.x = pk2(Pm[8], Pm[9]); p1.y = pk2(Pm[10], Pm[11]); p1.z = pk2(Pm[12], Pm[13]); p1.w = pk2(Pm[14], Pm[15]);
    const bf16x8 pb0 = __builtin_bit_cast(bf16x8, p0), pb1 = __builtin_bit_cast(bf16x8, p1);
#pragma unroll
    for (int dt = 0; dt < 4; ++dt) { O[dt] = MFMA32(vf[dt][0], pb0, O[dt]); O[dt] = MFMA32(vf[dt][1], pb1, O[dt]); }
}
DI void o_scale(f32x16 (&O)[4], float alpha) {
    if (__builtin_amdgcn_ballot_w64(alpha != 1.f) != 0ull) {
#pragma unroll
        for (int dt = 0; dt < 4; ++dt) O[dt] *= alpha; }
}
DI float dpp_xor1(float v) { return __builtin_bit_cast(float, __builtin_amdgcn_update_dpp(0, __builtin_bit_cast(int, v), 0xB1, 0xF, 0xF, true)); }
DI float dpp_xor2(float v) { return __builtin_bit_cast(float, __builtin_amdgcn_update_dpp(0, __builtin_bit_cast(int, v), 0x4E, 0xF, 0xF, true)); }

DI void attn_unit(const AttP& P, LAS unsigned char* lds, int wave, int lane, int t0, int h) {
    LAS float* pg = (LAS float*)(lds + wave * 16384);
    LAS unsigned short* selw = (LAS unsigned short*)(lds + SELW_OFF + wave * 128);
    const int n = lane & 31, hi = lane >> 5, tok = n >> 2, gq = n & 3, t = t0 + tok, hq = h * 4 + gq;
    const int pm = (n & 0x13) | ((n & 4) << 1) | ((n & 8) >> 1);
    const unsigned koff = (unsigned)(pm * 128 + 64 * hi) * 2u, voffc = (unsigned)(n * NCP + 8 * hi) * 2u, vofft = (unsigned)(n * T + 8 * hi) * 2u;
    const float sl2 = ex2(-0.5f * (float)(hq + 1)) * LOG2E;
    const int cur = t0 >> 6;
    bf16x8 qf[8];
    { const bf16x8* qp = (const bf16x8*)(P.QN + (size_t)t * NSAW + hq * 128 + 64 * hi);
#pragma unroll
      for (int j = 0; j < 8; ++j) qf[j] = qp[j]; }
    float gate[3];
    { const bf16* gp = P.NG + (size_t)t * 256 + hq * 3; gate[0] = bflo(gp[0]); gate[1] = bflo(gp[1]); gate[2] = bflo(gp[2]); }
    f32x16 O[4], S;

    {
#pragma unroll
        for (int i = 0; i < 16; ++i) *(LAS f32x4*)(pg + (i * 64 + lane) * 4) = (f32x4){0.f, 0.f, 0.f, 0.f};
    }
    const int nvalid = (t0 + 7 >= 31) ? ((t0 + 7 - 31) >> 4) + 1 : 0, ntile = (nvalid + 31) >> 5;
    const char* kc = (const char*)(P.KCN + (size_t)h * NCP * 128); const char* vct = (const char*)(P.VCT + (size_t)h * 128 * NCP);
    float m = NEG, l = 0.f;
    for (int ti = 0; ti < ntile; ++ti) {
        const int k0 = ti * 32, rel0 = 16 * (k0 + 8 * hi) + 31 - t;
        if (ti == ntile - 1) qk_tile<16, true>(S, qf, kc + (size_t)k0 * 256, koff, sl2, rel0, true, -(1 << 30)); else qk_tile<16, false>(S, qf, kc + (size_t)k0 * 256, koff, sl2, rel0, true, 0);
        (void)softmax_step(S, m, l);
    }
#pragma unroll
    for (int dt = 0; dt < 4; ++dt)
#pragma unroll
        for (int r = 0; r < 16; ++r) O[dt][r] = 0.f;
    {
        const float lt = l + __shfl_xor(l, 32); const bool have = m > -1e29f; const float rl = have ? 1.f / lt : 0.f, mu = have ? m : 0.f, gc = gate[0];
        for (int ti = 0; ti < ntile; ++ti) {
            const int k0 = ti * 32, rel0 = 16 * (k0 + 8 * hi) + 31 - t;
            if (ti == ntile - 1) qk_tile<16, true>(S, qf, kc + (size_t)k0 * 256, koff, sl2, rel0, true, -(1 << 30)); else qk_tile<16, false>(S, qf, kc + (size_t)k0 * 256, koff, sl2, rel0, true, 0);
#pragma unroll
            for (int r = 0; r < 16; ++r) S[r] = ex2(S[r] - mu) * rl;
#pragma unroll
            for (int q4 = 0; q4 < 4; ++q4) { float v[4];
#pragma unroll
                for (int e = 0; e < 4; ++e) { float x = S[4 * q4 + e]; x += dpp_xor1(x); x += dpp_xor2(x); v[e] = x; }
                if (gq == 0) *(LAS f32x4*)(pg + tok * 512 + k0 + 8 * hi + 16 * (q4 >> 1) + 4 * (q4 & 1)) = (f32x4){v[0], v[1], v[2], v[3]}; }
#pragma unroll
            for (int r = 0; r < 16; ++r) S[r] *= gc;
            pv_tile(O, S, vct + (size_t)k0 * 2, voffc, (size_t)32 * NCP * 2);
        }
    }
    LDS_WAIT(); asm volatile("" ::: "memory");

    unsigned mw[4], un[4];
    {
        const int tk = lane >> 3, sub = lane & 7; const LAS float* pb = pg + tk * 512 + sub * 64;
        unsigned key[16]; float carry = (sub > 0) ? pb[-1] : 0.f;
#pragma unroll
        for (int i = 0; i < 16; ++i) { const f32x4 q = *(const LAS f32x4*)(pb + 4 * i); const float imp = 2.f * (q.x + q.y + q.z) + q.w + carry; carry = q.w;
            const int j = sub * 16 + i; const bool valid = j <= cur, forced = (j == 0) || (j == cur) || (j == cur - 1);
            const unsigned ib = ((__builtin_bit_cast(unsigned, imp) & 0x7fffff00u) | (unsigned)(255 - j));
            key[i] = !valid ? 0u : (forced ? (0x7f000000u | (unsigned)(255 - j)) : ib); }
        const int R = (cur + 1 < 16) ? cur + 1 : 16; unsigned sel = 0u;
        for (int rd = 0; rd < R; ++rd) {
            unsigned mx = key[0];
#pragma unroll
            for (int i = 1; i < 16; ++i) mx = mx > key[i] ? mx : key[i];
#pragma unroll
            for (int o = 1; o < 8; o <<= 1) { const unsigned ot = (unsigned)__shfl_xor((int)mx, o); mx = mx > ot ? mx : ot; }
#pragma unroll
            for (int i = 0; i < 16; ++i) { const bool hit = (key[i] == mx); sel |= hit ? (1u << i) : 0u; key[i] = hit ? 0u : key[i]; }
        }
        selw[tk * 8 + sub] = (unsigned short)sel;
        LDS_WAIT(); asm volatile("" ::: "memory");
        const LAS u32x4* sw = (const LAS u32x4*)selw;
        const u32x4 mine = sw[tok]; mw[0] = mine.x; mw[1] = mine.y; mw[2] = mine.z; mw[3] = mine.w;
        u32x4 uu = sw[0];
#pragma unroll
        for (int k = 1; k < 8; ++k) { const u32x4 o = sw[k]; uu.x |= o.x; uu.y |= o.y; uu.z |= o.z; uu.w |= o.w; }
        un[0] = __builtin_amdgcn_readfirstlane(uu.x); un[1] = __builtin_amdgcn_readfirstlane(uu.y); un[2] = __builtin_amdgcn_readfirstlane(uu.z); un[3] = __builtin_amdgcn_readfirstlane(uu.w);
        LDS_WAIT(); asm volatile("" ::: "memory");
    }
#pragma unroll
    for (int q = 0; q < 16; ++q) *(LAS f32x4*)(pg + (q * 64 + lane) * 4) = (f32x4){O[q >> 2][4 * (q & 3)], O[q >> 2][4 * (q & 3) + 1], O[q >> 2][4 * (q & 3) + 2], O[q >> 2][4 * (q & 3) + 3]};
    asm volatile("" ::: "memory");

#pragma unroll
    for (int dt = 0; dt < 4; ++dt)
#pragma unroll
        for (int r = 0; r < 16; ++r) O[dt][r] = 0.f;
    m = NEG; l = 0.f;
    {
        const char* ksb = (const char*)(P.KSN + (size_t)h * T * 128); const char* vst = (const char*)(P.VST + (size_t)h * 128 * T);
        for (int wd = 3; wd >= 0; --wd) {
            unsigned bits = (wd == 0) ? un[0] : (wd == 1) ? un[1] : (wd == 2) ? un[2] : un[3];
            const unsigned mine = (wd == 0) ? mw[0] : (wd == 1) ? mw[1] : (wd == 2) ? mw[2] : mw[3];
            while (bits) {
                const int bb = 31 - __builtin_clz(bits); bits &= ~(1u << bb);
                const int b = wd * 32 + bb; const bool rok = (mine >> bb) & 1u;
#pragma unroll 1
                for (int hf = 1; hf >= 0; --hf) {
                    const int k0 = b * 64 + hf * 32, rel0 = k0 + 8 * hi - t;
                    if (b == cur) qk_tile<1, true>(S, qf, ksb + (size_t)k0 * 256, koff, sl2, rel0, rok, -(1 << 30)); else qk_tile<1, false>(S, qf, ksb + (size_t)k0 * 256, koff, sl2, rel0, rok, 0);
                    const float alpha = softmax_step(S, m, l);
                    o_scale(O, alpha);
                    pv_tile(O, S, vst + (size_t)k0 * 2, vofft, (size_t)32 * T * 2);
                }
            }
        }
        const float lt = l + __shfl_xor(l, 32), cs = gate[1] / lt;
#pragma unroll
        for (int q = 0; q < 16; ++q) { LAS f32x4* sp = (LAS f32x4*)(pg + (q * 64 + lane) * 4); f32x4 v = *sp;
            v.x += cs * O[q >> 2][4 * (q & 3)]; v.y += cs * O[q >> 2][4 * (q & 3) + 1]; v.z += cs * O[q >> 2][4 * (q & 3) + 2]; v.w += cs * O[q >> 2][4 * (q & 3) + 3]; *sp = v;
            if ((q & 3) == 3) asm volatile("" ::: "memory"); }
    }

#pragma unroll
    for (int dt = 0; dt < 4; ++dt)
#pragma unroll
        for (int r = 0; r < 16; ++r) O[dt][r] = 0.f;
    m = NEG; l = 0.f;
    {
        const char* kwb = (const char*)(P.KWN + (size_t)h * T * 128); const char* vwt = (const char*)(P.VWT + (size_t)h * 128 * T);
        int kfirst = (t0 - 511); kfirst = kfirst < 0 ? 0 : (kfirst & ~31);
        for (int k0 = t0 & ~31; k0 >= kfirst; k0 -= 32) {
            const int rel0 = k0 + 8 * hi - t; const bool edge = (k0 + 31 > t0) || (k0 + 511 < t0 + 7);
            if (edge) qk_tile<1, true>(S, qf, kwb + (size_t)k0 * 256, koff, sl2, rel0, true, -511); else qk_tile<1, false>(S, qf, kwb + (size_t)k0 * 256, koff, sl2, rel0, true, 0);
            const float alpha = softmax_step(S, m, l);
            o_scale(O, alpha);
            pv_tile(O, S, vwt + (size_t)k0 * 2, vofft, (size_t)32 * T * 2);
        }
        const float lt = l + __shfl_xor(l, 32), cw = gate[2] / lt;
        const size_t ob = (size_t)t * NSAW + hq * 128 + 4 * hi;
#pragma unroll
        for (int q = 0; q < 16; ++q) { const f32x4 sv = *(const LAS f32x4*)(pg + (q * 64 + lane) * 4); const int d0 = 32 * (q >> 2) + 8 * (q & 3);
            const u32x2 zw = *(const u32x2*)(P.ZN + ob + d0);
            const float o0 = (sv.x + cw * O[q >> 2][4 * (q & 3)]) * bflo(zw.x), o1 = (sv.y + cw * O[q >> 2][4 * (q & 3) + 1]) * bfhi(zw.x);
            const float o2 = (sv.z + cw * O[q >> 2][4 * (q & 3) + 2]) * bflo(zw.y), o3 = (sv.w + cw * O[q >> 2][4 * (q & 3) + 3]) * bfhi(zw.y);
            u32x2 w; w.x = pk2(o0, o1); w.y = pk2(o2, o3); *(u32x2*)(P.NO + ob + d0) = w;
            if ((q & 3) == 3) asm volatile("" ::: "memory"); }
    }
    LDS_WAIT(); asm volatile("" ::: "memory");
}
DI void p4_attention(const AttP& P, LAS unsigned char* lds, int G, int wave, int lane) {
    for (int w = blockIdx.x; w < 256; w += G) {
        const int h = w & 3, p = w >> 2;
#pragma unroll 1
        for (int k = 0; k < 2; ++k) attn_unit(P, lds, wave, lane, (k ? p : 127 - p) * 64 + wave * 8, h);
    }
}

__global__ void __launch_bounds__(NTHR, 2) mega_fwd(Args args) {
    extern __shared__ __attribute__((aligned(16))) unsigned char lds_raw[];
    LAS unsigned char* lds = (LAS unsigned char*)lds_raw;
    const int tid0 = threadIdx.x;
    const int G = gridDim.x, bx = blockIdx.x;
    const int vcu = (G % 8 == 0) ? (bx % 8) * (G / 8) + bx / 8 : bx;
    const int NGW = G * NWAVES;
    unsigned char* const ws0 = args.ws;
    gu32* ctl = (gu32*)(ws0 + WS_CTL);
    for (int u = tid0; u < (LDS_BYTES - LDSCTL_OFF) / 4; u += NTHR) ((LAS unsigned*)(lds + LDSCTL_OFF))[u] = 0u;
    __syncthreads();
    volatile LAS unsigned* MISC = (volatile LAS unsigned*)(lds + MISC_OFF);
    XcdBarrier bar; bar.bar = (unsigned*)(ctl + CW_BAR); bar.x = 0; bar.st = nullptr;
    if (!MK_MULTI) bar = xcd_barrier_post((unsigned*)(ctl + CW_BAR), MISC + 8);
    const int lo = args.st_lo, hi = args.st_hi;
#define IN(k) (lo <= (k) && (k) < hi)
#define LAUNDER_WS() unsigned char* ws = ws0; asm volatile("" : "+s"(ws)); int tid = tid0; asm volatile("" : "+v"(tid)); const int lane = tid & 63, wave = __builtin_amdgcn_readfirstlane(tid >> 6), gw = vcu * NWAVES + wave; (void)lane; (void)gw
#ifndef PH_MASK
#define PH_MASK 0x7f
#endif
#define PH_ON(p) ((PH_MASK >> (p)) & 1)
#define SEAM(k) do { if ((k) + 1 < hi) xcd_barrier(bar); } while (0)

    if (PH_ON(0) && IN(0)) { LAUNDER_WS(); (void)ws; prologue(args, lds, gw, NGW, wave, lane); SEAM(0); }

    for (int l = 0; l < DEPTH; ++l) {
        const int s0 = 1 + 6 * l;
        if (s0 + 6 <= lo || s0 >= hi) continue;
        const float* xin = (l == 0) ? args.in[0] : args.out;
        if (PH_ON(1) && IN(s0)) { LAUNDER_WS(); p1_rmsnorm(xin, args.in[1] + (size_t)l * DM, (bf16*)(ws + WS_H), gw, NGW, lane); SEAM(s0); }
        if (PH_ON(2) && IN(s0 + 1)) {
            LAUNDER_WS(); bf16* Hb = (bf16*)(ws + WS_H);
            pg8::Gemm g{DM, DM, DM};
            pg8::SchedPlain S{(const char*)Hb, (const char*)(ws + WS_WIN + l * SZ_WIN), 32, NINT, G, bx, (size_t)256 * DM * 2, (size_t)256 * DM * 2};
            pg8::EpiIn E{(bf16*)(ws + WS_U), (bf16*)(ws + WS_ZP), (bf16*)(ws + WS_QR), (bf16*)(ws + WS_ZN), (bf16*)(ws + WS_KV6), (bf16*)(ws + WS_GM), (bf16*)(ws + WS_NG), args.in[3] + (size_t)l * 2 * DM};
            pg8::gemm_phase<pg8::EpiIn, pg8::SchedPlain, true>(lds, g, S, E, tid);
            SEAM(s0 + 1);
        }
        if (PH_ON(3) && IN(s0 + 2)) {
            LAUNDER_WS();
            CmpP C{(const bf16*)(ws + WS_KV6), args.in[8] + (size_t)l * 2 * 4096, (const bf16*)(ws + WS_W1 + l * SZ_W1), args.in[10] + (size_t)l * 2 * 128, (const bf16*)(ws + WS_W2 + l * SZ_W2),
                   args.in[7] + (size_t)l * 3 * 128, (bf16*)(ws + WS_KCN), (bf16*)(ws + WS_VCT)};
            p3_compress(C, lds, G, tid, wave, lane);
            MidP M{(const bf16*)(ws + WS_U), (const bf16*)(ws + WS_QR), (const bf16*)(ws + WS_KV6), (bf16*)(ws + WS_MP), (bf16*)(ws + WS_QN), (bf16*)(ws + WS_KSN), (bf16*)(ws + WS_KWN),
                   (bf16*)(ws + WS_VST), (bf16*)(ws + WS_VWT), args.in[6] + (size_t)l * 128, args.in[7] + (size_t)l * 3 * 128};
            p3_mid(M, lds, gw, NGW, wave, lane);
            SEAM(s0 + 2);
        }
        if (PH_ON(4) && IN(s0 + 3)) {
            LAUNDER_WS();
            {
                pg8::Gemm g{PW, 512, 512};
                pg8::SchedPool S{(const char*)(ws + WS_MP), (const char*)(ws + WS_POOLW + l * SZ_POOLW), G, bx};
                pg8::EpiPool E{(bf16*)(ws + WS_PO), (const bf16*)(ws + WS_ZP), args.in[5] + (size_t)l * PW};
                pg8::gemm_phase<pg8::EpiPool, pg8::SchedPool, false>(lds, g, S, E, tid);
            }
            __syncthreads();
            AttP A{(const bf16*)(ws + WS_QN), (const bf16*)(ws + WS_KCN), (const bf16*)(ws + WS_VCT), (const bf16*)(ws + WS_KSN), (const bf16*)(ws + WS_VST), (const bf16*)(ws + WS_KWN), (const bf16*)(ws + WS_VWT),
                   (const bf16*)(ws + WS_NG), (const bf16*)(ws + WS_ZN), (bf16*)(ws + WS_NO)};
            p4_attention(A, lds, G, wave, lane);
            SEAM(s0 + 3);
        }
        if (PH_ON(5) && IN(s0 + 4)) {
            LAUNDER_WS();
            pg8::Gemm g{PW, PW, PW};
            pg8::SchedUp S{(const char*)(ws + WS_PO), (const char*)(ws + WS_NO), (const char*)(ws + WS_WPU + l * SZ_WUP), (const char*)(ws + WS_WNU + l * SZ_WUP), G, bx};
            pg8::EpiUp E{(bf16*)(ws + WS_Y), (const bf16*)(ws + WS_GM)};
            pg8::gemm_phase<pg8::EpiUp, pg8::SchedUp, true>(lds, g, S, E, tid);
            SEAM(s0 + 4);
        }
        if (PH_ON(6) && IN(s0 + 5)) {
            LAUNDER_WS();
            pg8::Gemm g{DM, DM, DM};
            pg8::SchedPlain S{(const char*)(ws + WS_Y), (const char*)(ws + WS_WOUT + l * SZ_WOUT), 32, 16, G, bx, (size_t)256 * DM * 2, (size_t)256 * DM * 2};
            pg8::EpiOut E{xin, args.out};
            pg8::gemm_phase<pg8::EpiOut, pg8::SchedPlain, true>(lds, g, S, E, tid);
            SEAM(s0 + 5);
        }
    }
#undef IN
#undef SEAM
}

extern "C" void kernel_launch(void* const* d_in, const int* in_sizes, int n_in, void* d_out, int out_size, void* d_ws, size_t ws_size, hipStream_t stream) {
    static int grid = 0;
    if (grid == 0) {
        if (n_in != 15 || out_size != T * DM || ws_size < WS_END) { fprintf(stderr, "kernel_launch: unexpected shapes (n_in %d out %d ws %zu need %zu)\n", n_in, out_size, ws_size, (size_t)WS_END); grid = -1; return; }
        int dev = 0, cus = 0, per_cu = 0;
        if (hipGetDevice(&dev) != hipSuccess || hipDeviceGetAttribute(&cus, hipDeviceAttributeMultiprocessorCount, dev) != hipSuccess) { grid = -1; return; }
        if (hipFuncSetAttribute((const void*)mega_fwd, hipFuncAttributeMaxDynamicSharedMemorySize, LDS_BYTES) != hipSuccess) { fprintf(stderr, "kernel_launch: hipFuncSetAttribute failed\n"); grid = -1; return; }
        if (hipOccupancyMaxActiveBlocksPerMultiprocessor(&per_cu, (const void*)mega_fwd, NTHR, LDS_BYTES) != hipSuccess || per_cu < 1) { fprintf(stderr, "kernel_launch: occupancy query says %d\n", per_cu); }
        (void)hipGetLastError();
        grid = cus;
    }
    if (grid < 0) return;
    (void)hipMemsetAsync((char*)d_ws + WS_CTL, 0, CTL_ZERO_BYTES, stream);
    Args a{};
    for (int i = 0; i < 15; ++i) a.in[i] = (const float*)d_in[i];
    a.out = (float*)d_out; a.ws = (unsigned char*)d_ws;
    constexpr int NSTEP = 1 + 6 * DEPTH;
#if MK_MULTI
    for (int s = 0; s < NSTEP; ++s) { a.st_lo = s; a.st_hi = s + 1; hipLaunchKernelGGL(mega_fwd, dim3(grid), dim3(NTHR), LDS_BYTES, stream, a); }
#else
    a.st_lo = 0; a.st_hi = NSTEP;
    hipLaunchKernelGGL(mega_fwd, dim3(grid), dim3(NTHR), LDS_BYTES, stream, a);
#endif
    const hipError_t le = hipPeekAtLastError();
    if (le != hipSuccess) fprintf(stderr, "kernel_launch: launch failed: %s\n", hipGetErrorName(le));
}
```

```cpp
#include <hip/hip_runtime.h>
#include <cstdio>
#include <cstdint>

#ifndef WGM_IN
#define WGM_IN 4
#endif
#ifndef WGM_UP
#define WGM_UP 2
#endif
#ifndef WGM_OUT
#define WGM_OUT 2
#endif
#ifndef MK_MULTI
#define MK_MULTI 0
#endif

#define DI __device__ __forceinline__
#define GAS __attribute__((address_space(1)))
#define LAS __attribute__((address_space(3)))
typedef unsigned short bf16;
typedef short bf16x8 __attribute__((ext_vector_type(8)));
typedef float f32x2 __attribute__((ext_vector_type(2)));
typedef float f32x4 __attribute__((ext_vector_type(4)));
typedef float f32x16 __attribute__((ext_vector_type(16)));
typedef unsigned u32x2 __attribute__((ext_vector_type(2)));
typedef unsigned u32x4 __attribute__((ext_vector_type(4)));
typedef __bf16 bf16x2_t __attribute__((ext_vector_type(2)));
typedef GAS unsigned gu32;

constexpr int T = 8192, DM = 4096, PW = 2048, NSAW = 2048, KVW = 512, HD = 128, NQH = 16, NKVH = 4, DEPTH = 4;
constexpr int NIN = 19504, NPAD = 19712, NINT = NPAD / 256;
constexpr int KV6W = 3072;
constexpr int NCP = 512;
constexpr float EPS = 1e-6f, NEG = -1e30f, LOG2E = 1.4426950408889634f;
constexpr int NWAVES = 8, NTHR = 512;

constexpr size_t al256(size_t x) { return (x + 255) & ~(size_t)255; }
constexpr size_t WS_CTL = 0, CTL_ZERO_BYTES = 65536;
constexpr size_t SZ_WIN = (size_t)NPAD * DM * 2, SZ_POOLW = (size_t)4 * 512 * 512 * 2, SZ_WUP = (size_t)DM * PW * 2, SZ_WOUT = (size_t)DM * DM * 2;
constexpr size_t SZ_W1 = (size_t)2 * 128 * 4096 * 2, SZ_W2 = (size_t)2 * 128 * 128 * 2;
constexpr size_t WS_WIN = 1u << 20;
constexpr size_t WS_POOLW = WS_WIN + DEPTH * SZ_WIN;
constexpr size_t WS_WPU = WS_POOLW + DEPTH * SZ_POOLW;
constexpr size_t WS_WNU = WS_WPU + DEPTH * SZ_WUP;
constexpr size_t WS_WOUT = WS_WNU + DEPTH * SZ_WUP;
constexpr size_t WS_W1 = WS_WOUT + DEPTH * SZ_WOUT;
constexpr size_t WS_W2 = WS_W1 + DEPTH * SZ_W1;
constexpr size_t WS_H = WS_W2 + DEPTH * SZ_W2;
constexpr size_t WS_U = WS_H + (size_t)T * DM * 2;
constexpr size_t WS_ZP = WS_U + (size_t)T * PW * 2;
constexpr size_t WS_QR = WS_ZP + (size_t)T * PW * 2;
constexpr size_t WS_ZN = WS_QR + (size_t)T * NSAW * 2;
constexpr size_t WS_KV6 = WS_ZN + (size_t)T * NSAW * 2;
constexpr size_t WS_GM = WS_KV6 + (size_t)T * KV6W * 2;
constexpr size_t WS_NG = WS_GM + (size_t)T * 8192 * 2;
constexpr size_t WS_MP = WS_NG + (size_t)T * 256 * 2;
constexpr size_t WS_QN = WS_MP + (size_t)T * PW * 2;
constexpr size_t WS_KSN = WS_QN + (size_t)T * NSAW * 2;
constexpr size_t WS_KWN = WS_KSN + (size_t)4 * T * 128 * 2;
constexpr size_t WS_VST = WS_KWN + (size_t)4 * T * 128 * 2;
constexpr size_t WS_VWT = WS_VST + (size_t)4 * T * 128 * 2;
constexpr size_t WS_KCN = WS_VWT + (size_t)4 * T * 128 * 2;
constexpr size_t WS_VCT = WS_KCN + (size_t)4 * NCP * 128 * 2;
constexpr size_t WS_PO = WS_VCT + (size_t)4 * NCP * 128 * 2;
constexpr size_t WS_NO = WS_PO + (size_t)T * PW * 2;
constexpr size_t WS_Y = WS_NO + (size_t)T * NSAW * 2;
constexpr size_t WS_OST = WS_Y + (size_t)T * DM * 2;
static_assert(WS_ZP == WS_U + (size_t)T * PW * 2 && WS_QR == WS_ZP + (size_t)T * PW * 2 && WS_ZN == WS_QR + (size_t)T * NSAW * 2, "U | ZP | QR | ZN consecutive");
constexpr size_t WS_SS = WS_OST + (size_t)T * NSAW * 4;
constexpr size_t WS_END = WS_SS + (size_t)T * 64 * 4;
constexpr int CW_BAR = 4096;

constexpr int RING_BYTES = 131072, LDSCTL_OFF = 140288  , MISC_OFF = LDSCTL_OFF + 320, SELW_OFF = LDSCTL_OFF + 2048, LDS_BYTES = 147456, RS_OFF = RING_BYTES  ;

#define RLX_AGENT __ATOMIC_RELAXED, __HIP_MEMORY_SCOPE_AGENT
#define LDS_WAIT() asm volatile("s_waitcnt lgkmcnt(0)" ::: "memory")
DI unsigned f2bf(float f) { unsigned u = __builtin_bit_cast(unsigned, f); return (u + 0x7fffu + ((u >> 16) & 1u)) >> 16; }
DI unsigned pk2(float lo, float hi) { f32x2 v = {lo, hi}; bf16x2_t b = __builtin_convertvector(v, bf16x2_t); return __builtin_bit_cast(unsigned, b); }
DI float bflo(unsigned u) { return __builtin_bit_cast(float, u << 16); }
DI float bfhi(unsigned u) { return __builtin_bit_cast(float, u & 0xffff0000u); }
DI float ex2(float x) { return __builtin_amdgcn_exp2f(x); }
DI float rcpf(float x) { return __builtin_amdgcn_rcpf(x); }
DI float sigm(float v) { return rcpf(1.f + ex2(-v * LOG2E)); }
DI float shx(float v, int mask) {
    int ln; asm volatile("v_mbcnt_lo_u32_b32 %0, -1, 0\n\tv_mbcnt_hi_u32_b32 %0, -1, %0" : "=v"(ln));
    return __builtin_bit_cast(float, __builtin_amdgcn_ds_bpermute((ln ^ mask) << 2, __builtin_bit_cast(int, v)));
}
DI float wave_sum(float v) {
#pragma unroll
    for (int o = 1; o < 64; o <<= 1) v += shx(v, o);
    return v;
}
DI float sum16(float v) {
#pragma unroll
    for (int o = 1; o < 16; o <<= 1) v += shx(v, o);
    return v;
}
DI void unpack8(const u32x4 w, float (&f)[8]) {
    f[0] = bflo(w.x); f[1] = bfhi(w.x); f[2] = bflo(w.y); f[3] = bfhi(w.y); f[4] = bflo(w.z); f[5] = bfhi(w.z); f[6] = bflo(w.w); f[7] = bfhi(w.w);
}
DI u32x4 pack8(const float (&f)[8]) { u32x4 w; w.x = pk2(f[0], f[1]); w.y = pk2(f[2], f[3]); w.z = pk2(f[4], f[5]); w.w = pk2(f[6], f[7]); return w; }

namespace pg8 {
typedef unsigned short bf16_t;
constexpr int BM = 256, BK = 64, HALF = 128, HTB = HALF * BK * 2, NXCD = 8;
DI int lds_byte(int r, int c) { const int st = (r >> 4) * 2 + (c >> 5), rr = r & 15, cc = c & 31, ob = rr * 64 + cc * 2; return st * 1024 + (ob ^ (((ob >> 9) & 1) << 5)); }
DI void stage_rc(int b, int& R, int& C) { const int st = b / 1024, sb = b % 1024, swz = sb ^ (((sb >> 9) & 1) << 5); R = (st >> 1) * 16 + swz / 64; C = (st & 1) * 32 + (swz % 64) / 2; }
DI int perm32(int rho) { const int n = rho >> 4, i = rho & 15; return 8 * (i >> 2) + 4 * n + (i & 3); }

struct Unit { int pm, pn, aux; const char* a; const char* b; };
struct Gemm { int lda, ldb, K; };

DI void tile_of(int L, int nM, int nN, int& pm, int& pn, const int WGM) {
    const int nwg = nM * nN; int wgid = L;
    { const int q = nwg / NXCD, r = nwg % NXCD, xcd = wgid % NXCD, off = wgid / NXCD; wgid = (xcd < r ? xcd * (q + 1) : r * (q + 1) + (xcd - r) * q) + off; }
    const int nig = WGM * nN, gid = wgid / nig, fm = gid * WGM, gsz = (nM - fm) < WGM ? (nM - fm) : WGM;
    pm = fm + ((wgid % nig) % gsz); pn = (wgid % nig) / gsz;
}

template <class Epi, class Sched, bool ALIGN_EPI>
DI void gemm_phase(LAS unsigned char* lds, const Gemm g, const Sched& S, const Epi& E, const int tid) {
    const int wid = __builtin_amdgcn_readfirstlane(tid >> 6), lane = tid & 63, wr = wid >> 2, wc = wid & 3, fr = lane & 15, fq = lane >> 4;
    const int K = g.K, nt = K / BK;
    unsigned voffA[2], voffB[2];
#pragma unroll
    for (int i = 0; i < 2; ++i) { int R, C; stage_rc(tid * 16 + i * 8192, R, C); const int Rb = Epi::PERM ? (((R >> 5) * 64) + perm32(R & 31)) : R;
        voffA[i] = (unsigned)(R * g.lda + C) * 2u; voffB[i] = (unsigned)(Rb * g.ldb + C) * 2u; }
    const size_t kstep = (size_t)(BK * 2);
    const size_t hsA = (size_t)HALF * g.lda * 2, hsB = (size_t)(Epi::PERM ? 32 : HALF) * g.ldb * 2;
    const unsigned ldsw = (unsigned)wid * 1024u;
    const int aoff = lds_byte(wr * 64 + fr, fq * 8), boff = lds_byte(wc * 32 + fr, fq * 8);
#define PG8_SA(b, h) (((b) * 2 + (h)) * HTB)
#define PG8_SB(b, h) ((4 + (b) * 2 + (h)) * HTB)
#define PG8_STAGE(bufoff, gbase, voff) do { _Pragma("unroll") for (int _i = 0; _i < 2; ++_i) \
        __builtin_amdgcn_global_load_lds((const unsigned*)((const char*)(gbase) + (voff)[_i]), (LAS unsigned*)(lds + (bufoff) + ldsw + _i * 8192), 16, 0, 0); } while (0)
#define PG8_LDA(dst, b, h) do { _Pragma("unroll") for (int m = 0; m < 4; ++m) _Pragma("unroll") for (int k = 0; k < 2; ++k) dst[m][k] = *(const LAS bf16x8*)(lds + PG8_SA(b, h) + aoff + m * 2048 + k * 1024); } while (0)
#define PG8_LDB(dst, b, h) do { _Pragma("unroll") for (int n = 0; n < 2; ++n) _Pragma("unroll") for (int k = 0; k < 2; ++k) dst[n][k] = *(const LAS bf16x8*)(lds + PG8_SB(b, h) + boff + n * 2048 + k * 1024); } while (0)
#define PG8_MMA(ai, bj, At, Bt) do { __builtin_amdgcn_s_setprio(1); _Pragma("unroll") for (int m = 0; m < 4; ++m) _Pragma("unroll") for (int n = 0; n < 2; ++n) _Pragma("unroll") for (int k = 0; k < 2; ++k) \
        acc[ai][bj][m][n] = __builtin_amdgcn_mfma_f32_16x16x32_bf16(Bt[n][k], At[m][k], acc[ai][bj][m][n], 0, 0, 0); __builtin_amdgcn_s_setprio(0); } while (0)
#define PG8_WAIT_V(n) asm volatile("s_waitcnt vmcnt(" #n ")" ::: "memory")
#define PG8_WAIT_L(n) asm volatile("s_waitcnt lgkmcnt(" #n ")" ::: "memory")
#define PG8_BAR __builtin_amdgcn_s_barrier()
#define PG8_SCHED __builtin_amdgcn_sched_barrier(0)
    Unit cur, nxt; int ui = 0;
    if (!S.next(0, cur)) return;
    f32x4 acc[2][2][4][2];
#pragma unroll
    for (int a = 0; a < 2; ++a)
#pragma unroll
        for (int b = 0; b < 2; ++b)
#pragma unroll
            for (int m = 0; m < 4; ++m)
#pragma unroll
                for (int n = 0; n < 2; ++n) acc[a][b][m][n] = (f32x4){0.f, 0.f, 0.f, 0.f};
    bf16x8 At[4][2], B0[2][2], B1[2][2];
    const char* cA = cur.a; const char* cB = cur.b;
    PG8_STAGE(PG8_SB(0, 0), cB, voffB); PG8_STAGE(PG8_SB(0, 1), cB + hsB, voffB); PG8_STAGE(PG8_SA(0, 0), cA, voffA); PG8_STAGE(PG8_SA(0, 1), cA + hsA, voffA);
    if (wr == 1) PG8_BAR;
    PG8_WAIT_V(2); PG8_BAR;
    PG8_STAGE(PG8_SB(1, 0), cB + kstep, voffB); PG8_STAGE(PG8_SA(1, 0), cA + kstep, voffA); PG8_STAGE(PG8_SB(1, 1), cB + hsB + kstep, voffB);
    PG8_WAIT_V(6); PG8_BAR;
    for (;;) {
        const bool has_next = S.next(ui + 1, nxt);
        const char* nA = has_next ? nxt.a : cA; const char* nB = has_next ? nxt.b : cB;
        for (int t = 0; t < nt; t += 2) {
            const bool last = (t == nt - 2);
            const char* a1 = cA + (size_t)(t + 1) * kstep;
            const char* a2 = last ? nA : cA + (size_t)(t + 2) * kstep; const char* b2 = last ? nB : cB + (size_t)(t + 2) * kstep;
            const char* a3 = a2 + kstep; const char* b3 = b2 + kstep;
            PG8_LDB(B0, 0, 0); PG8_LDB(B1, 0, 1); PG8_SCHED; PG8_LDA(At, 0, 0); PG8_STAGE(PG8_SA(1, 1), a1 + hsA, voffA);
            PG8_WAIT_V(8); PG8_WAIT_L(0); PG8_BAR; PG8_MMA(0, 0, At, B0); PG8_MMA(0, 1, At, B1); PG8_BAR; PG8_SCHED;
            PG8_LDA(At, 0, 1); PG8_STAGE(PG8_SB(0, 0), b2, voffB); PG8_STAGE(PG8_SB(0, 1), b2 + hsB, voffB); PG8_STAGE(PG8_SA(0, 0), a2, voffA);
            PG8_WAIT_V(8); PG8_WAIT_L(0); PG8_BAR; PG8_MMA(1, 0, At, B0); PG8_MMA(1, 1, At, B1); PG8_BAR; PG8_SCHED;
            PG8_LDB(B0, 1, 0); PG8_LDB(B1, 1, 1); PG8_SCHED; PG8_LDA(At, 1, 0); PG8_STAGE(PG8_SA(0, 1), a2 + hsA, voffA);
            PG8_WAIT_V(8); PG8_WAIT_L(0); PG8_BAR; PG8_MMA(0, 0, At, B0); PG8_MMA(0, 1, At, B1); PG8_BAR; PG8_SCHED;
            PG8_LDA(At, 1, 1); PG8_STAGE(PG8_SB(1, 0), b3, voffB); PG8_STAGE(PG8_SB(1, 1), b3 + hsB, voffB); PG8_STAGE(PG8_SA(1, 0), a3, voffA);
            PG8_WAIT_V(8); PG8_WAIT_L(0); PG8_BAR; PG8_MMA(1, 0, At, B0); PG8_MMA(1, 1, At, B1); PG8_BAR; PG8_SCHED;
        }
        if constexpr (ALIGN_EPI) { if (wr == 0) PG8_BAR; }
        E(acc, cur, wr, wc, fr, fq);
        if (!has_next) break;
        if (!(Epi::CHAIN && cur.aux == 0)) {
#pragma unroll
        for (int a = 0; a < 2; ++a)
#pragma unroll
            for (int b = 0; b < 2; ++b)
#pragma unroll
                for (int m = 0; m < 4; ++m)
#pragma unroll
                    for (int n = 0; n < 2; ++n) acc[a][b][m][n] = (f32x4){0.f, 0.f, 0.f, 0.f};
        }
        cur = nxt; cA = nA; cB = nB; ++ui;
        if constexpr (ALIGN_EPI) { if (wr == 1) PG8_BAR; }
    }
    PG8_WAIT_V(0);
    if constexpr (!ALIGN_EPI) { if (wr == 0) PG8_BAR; }
    PG8_BAR;
#undef PG8_SA
#undef PG8_SB
#undef PG8_STAGE
#undef PG8_LDA
#undef PG8_LDB
#undef PG8_MMA
#undef PG8_WAIT_V
#undef PG8_WAIT_L
#undef PG8_BAR
#undef PG8_SCHED
}

struct SchedPlain {
    const char* A; const char* B; int nM, nN, G, c; size_t ta, tb; int wgm;
    DI bool next(int i, Unit& u) const { const long L = (long)i * G + c; if (L >= (long)nM * nN) return false; tile_of((int)L, nM, nN, u.pm, u.pn, wgm); u.aux = 0; u.a = A + (size_t)u.pm * ta; u.b = B + (size_t)u.pn * tb; return true; }
};
struct SchedPool {
    const char* A; const char* B; int G, c;
    DI bool next(int i, Unit& u) const { const int L = i * G + c; if (L >= 256) return false; u.pm = L >> 3; u.pn = L & 7; u.aux = 0; const int grp = u.pn >> 1, half = u.pn & 1;
        u.a = A + ((size_t)u.pm * 256 * PW + (size_t)grp * 512) * 2; u.b = B + ((size_t)grp * 512 * 512 + (size_t)half * 256 * 512) * 2; return true; }
};
struct SchedUp {
    const char* A0; const char* A1; const char* B0; const char* B1; int G, c;
    DI bool next(int i, Unit& u) const { const long L = (long)(i >> 1) * G + c; if (L >= 32 * 16) return false; tile_of((int)L, 32, 16, u.pm, u.pn, WGM_UP); u.aux = i & 1;
        u.a = (u.aux ? A1 : A0) + (size_t)u.pm * 256 * PW * 2; u.b = (u.aux ? B1 : B0) + (size_t)u.pn * 256 * PW * 2; return true; }
};

DI size_t gate_frag_off(int pm, int pn, int wave, int bj, int lane) { return ((((size_t)pm * 16 + pn) * 8 + wave) * 16 + bj) * 512 + (size_t)lane * 8; }
struct EpiIn {
    static constexpr bool PERM = true, CHAIN = false;
    bf16_t *U, *ZP, *QR, *ZN, *KV6, *GM, *NG; const float* mbias; const LAS float* rs;
    DI void operator()(f32x4 (&acc)[2][2][4][2], const Unit& u, int wr, int wc, int fr, int fq) const {
        const int pn = u.pn; bf16_t* base; int ldc, colt, mode;
        if (pn < 32) { base = U + (size_t)(pn >> 3) * T * PW; ldc = PW; colt = (pn & 7) * 256; mode = (pn >> 3) & 1; }
        else if (pn < 44) { base = KV6; ldc = KV6W; colt = (pn - 32) * 256; mode = 0; }
        else if (pn < 76) { base = GM; ldc = DM; colt = 0; mode = 2; }
        else { base = NG; ldc = 256; colt = 0; mode = 3; }
        const int row0 = u.pm * BM + wr * 64 + fr, col0 = colt + wc * 64 + 8 * fq;
        if (mode == 2) {
            const int kt = pn - 44, ch0 = kt * 128 + wc * 32 + 8 * fq;
            bf16_t* gt = GM + gate_frag_off(u.pm, kt >> 1, wr * 4 + 2 * (kt & 1) + (wc >> 1), wc & 1, fq * 16 + fr);
            f32x4 b0[2], b1[2];
#pragma unroll
            for (int n = 0; n < 2; ++n) { b0[n] = *(const f32x4*)(mbias + ch0 + 4 * n); b1[n] = *(const f32x4*)(mbias + DM + ch0 + 4 * n); }
#pragma unroll
            for (int ai = 0; ai < 2; ++ai)
#pragma unroll
                for (int m = 0; m < 4; ++m) { const float rr = rs[wr * 64 + fr + ai * HALF + m * 16];
                    const f32x4 a00 = acc[ai][0][m][0] * rr + b0[0], a01 = acc[ai][0][m][1] * rr + b0[1], a10 = acc[ai][1][m][0] * rr + b1[0], a11 = acc[ai][1][m][1] * rr + b1[1];
                    f32x4 r0, r1, g10, g11;
#pragma unroll
                    for (int e = 0; e < 4; ++e) { const float e00 = fminf(ex2(-a00[e] * LOG2E), 1e30f), e01 = fminf(ex2(-a01[e] * LOG2E), 1e30f), e10 = fminf(ex2(-a10[e] * LOG2E), 1e30f), e11 = fminf(ex2(-a11[e] * LOG2E), 1e30f);
                        g10[e] = rcpf(1.f + e10); g11[e] = rcpf(1.f + e11); r0[e] = rcpf(1.f + e00) * (1.f + e10); r1[e] = rcpf(1.f + e01) * (1.f + e11); }
                    u32x4 rw, gw;
                    rw.x = pk2(r0.x, r0.y); rw.y = pk2(r0.z, r0.w); rw.z = pk2(r1.x, r1.y); rw.w = pk2(r1.z, r1.w);
                    gw.x = pk2(g10.x, g10.y); gw.y = pk2(g10.z, g10.w); gw.z = pk2(g11.x, g11.y); gw.w = pk2(g11.z, g11.w);
                    bf16_t* gp = gt + (size_t)(ai * 8 + m * 2) * 512; *(u32x4*)gp = rw; *(u32x4*)(gp + (size_t)T * DM) = gw; }
            return; }
#pragma unroll
        for (int ai = 0; ai < 2; ++ai)
#pragma unroll
            for (int m = 0; m < 4; ++m) { bf16_t* rowp = base + (size_t)(row0 + ai * HALF + m * 16) * ldc + col0; const float rr = rs[wr * 64 + fr + ai * HALF + m * 16];
#pragma unroll
                for (int bj = 0; bj < 2; ++bj) { f32x4 v0 = acc[ai][bj][m][0] * rr, v1 = acc[ai][bj][m][1] * rr;
                    if (mode != 0) {
#pragma unroll
                        for (int e = 0; e < 4; ++e) { const float s0 = sigm(v0[e]), s1 = sigm(v1[e]); v0[e] = (mode == 1) ? v0[e] * s0 : s0; v1[e] = (mode == 1) ? v1[e] * s1 : s1; }
                    }
                    u32x4 w; w.x = pk2(v0[0], v0[1]); w.y = pk2(v0[2], v0[3]); w.z = pk2(v1[0], v1[1]); w.w = pk2(v1[2], v1[3]);
                    *(u32x4*)(rowp + bj * 32) = w; } }
    }
};
struct EpiPool {
    static constexpr bool PERM = true, CHAIN = false;
    bf16_t* O; const bf16_t* ZP; const float* scale;
    DI void operator()(f32x4 (&acc)[2][2][4][2], const Unit& u, int wr, int wc, int fr, int fq) const {
        const int row0 = u.pm * BM + wr * 64 + fr, col0 = u.pn * BM + wc * 64 + 8 * fq;
        f32x4 sv[2][2];
#pragma unroll
        for (int bj = 0; bj < 2; ++bj)
#pragma unroll
            for (int n = 0; n < 2; ++n) sv[bj][n] = *(const f32x4*)(scale + col0 + bj * 32 + 4 * n);
#pragma unroll
        for (int ai = 0; ai < 2; ++ai)
#pragma unroll
            for (int m = 0; m < 4; ++m) { const size_t ro = (size_t)(row0 + ai * HALF + m * 16) * PW + col0;
#pragma unroll
                for (int bj = 0; bj < 2; ++bj) { const u32x4 z = *(const u32x4*)(ZP + ro + bj * 32); float zf[8]; unpack8(z, zf);
                    const f32x4 v0 = acc[ai][bj][m][0] * sv[bj][0], v1 = acc[ai][bj][m][1] * sv[bj][1];
                    u32x4 w; w.x = pk2(v0[0] * zf[0], v0[1] * zf[1]); w.y = pk2(v0[2] * zf[2], v0[3] * zf[3]); w.z = pk2(v1[0] * zf[4], v1[1] * zf[5]); w.w = pk2(v1[2] * zf[6], v1[3] * zf[7]);
                    *(u32x4*)(O + ro + bj * 32) = w; } }
    }
};
struct EpiUp {
    static constexpr bool PERM = true, CHAIN = true;
    bf16_t* Y; const bf16_t* R; const bf16_t* G1;
    DI void operator()(f32x4 (&acc)[2][2][4][2], const Unit& u, int wr, int wc, int fr, int fq) const {
        const int row0 = u.pm * BM + wr * 64 + fr, col0 = u.pn * BM + wc * 64 + 8 * fq; const int which = u.aux; const bf16_t* gsrc = (which ? G1 : R) + gate_frag_off(u.pm, u.pn, wr * 4 + wc, 0, fq * 16 + fr);
#pragma unroll
        for (int ai = 0; ai < 2; ++ai)
#pragma unroll
            for (int m = 0; m < 4; ++m) { const int row = row0 + ai * HALF + m * 16;
#pragma unroll
                for (int bj = 0; bj < 2; ++bj) { const int col = col0 + bj * 32;
                    const u32x4 gw = *(const u32x4*)(gsrc + (size_t)(ai * 8 + m * 2 + bj) * 512); float g[8]; unpack8(gw, g);
                    if (which == 0) {
#pragma unroll
                        for (int e = 0; e < 4; ++e) { acc[ai][bj][m][0][e] *= g[e]; acc[ai][bj][m][1][e] *= g[4 + e]; }
                    } else {
                        const f32x4 v0 = acc[ai][bj][m][0], v1 = acc[ai][bj][m][1];
                        u32x4 w; w.x = pk2(v0[0] * g[0], v0[1] * g[1]); w.y = pk2(v0[2] * g[2], v0[3] * g[3]); w.z = pk2(v1[0] * g[4], v1[1] * g[5]); w.w = pk2(v1[2] * g[6], v1[3] * g[7]);
                        *(u32x4*)(Y + (size_t)row * DM + col) = w; } } }
    }
};
struct EpiOut {
    static constexpr bool PERM = true, CHAIN = false;
    const float* X0; const bf16_t* XS; bf16_t* XD; float* SS; float* O; int mode;
    DI void operator()(f32x4 (&acc)[2][2][4][2], const Unit& u, int wr, int wc, int fr, int fq) const {
        const int row0 = u.pm * BM + wr * 64 + fr, col0 = u.pn * BM + wc * 64 + 8 * fq;
#pragma unroll
        for (int ai = 0; ai < 2; ++ai)
#pragma unroll
            for (int m = 0; m < 4; ++m) { const int row = row0 + ai * HALF + m * 16; const size_t ro = (size_t)row * DM + col0; float s = 0.f;
#pragma unroll
                for (int bj = 0; bj < 2; ++bj) { f32x4 v0, v1;
                    if (mode == 0) { v0 = *(const f32x4*)(X0 + ro + bj * 32); v1 = *(const f32x4*)(X0 + ro + bj * 32 + 4); }
                    else { const u32x4 xw = *(const u32x4*)(XS + ro + bj * 32); v0 = (f32x4){bflo(xw.x), bfhi(xw.x), bflo(xw.y), bfhi(xw.y)}; v1 = (f32x4){bflo(xw.z), bfhi(xw.z), bflo(xw.w), bfhi(xw.w)}; }
                    v0 += acc[ai][bj][m][0]; v1 += acc[ai][bj][m][1];
                    if (mode == 2) { *(f32x4*)(O + ro + bj * 32) = v0; *(f32x4*)(O + ro + bj * 32 + 4) = v1; }
                    else { u32x4 w; w.x = pk2(v0[0], v0[1]); w.y = pk2(v0[2], v0[3]); w.z = pk2(v1[0], v1[1]); w.w = pk2(v1[2], v1[3]); *(u32x4*)(XD + ro + bj * 32) = w;
                        s += (v0[0] * v0[0] + v0[1] * v0[1]) + (v0[2] * v0[2] + v0[3] * v0[3]) + (v1[0] * v1[0] + v1[1] * v1[1]) + (v1[2] * v1[2] + v1[3] * v1[3]); } }
                if (mode != 2) { s += shx(s, 16); s += shx(s, 32); if (fq == 0) SS[(size_t)row * 64 + u.pn * 4 + wc] = s; } }
    }
};
}

#define XB_TMO      128
#define XB_XCNT(j)  (256  + 64 * (j))
#define XB_XSUB(j)  (1280 + 64 * (j))
#define XB_XGEN(j)  (2304 + 64 * (j))
#define XB_TOP      3328
#define XB_TOPGEN   3392
#define XCD_BAR_WORDS 3456
#define XB_SPIN_CAP (1u << 22)
DI unsigned xb_ld(unsigned* p)              { return __hip_atomic_load(p, __ATOMIC_RELAXED, __HIP_MEMORY_SCOPE_AGENT); }
DI unsigned xb_add(unsigned* p, unsigned v) { return __hip_atomic_fetch_add(p, v, __ATOMIC_RELAXED, __HIP_MEMORY_SCOPE_AGENT); }
DI unsigned xb_xcc_id() { return (unsigned)__builtin_amdgcn_s_getreg((3 << 11) | 20) & 0xFu; }
#define XB_SPIN(cond, bar) do { unsigned _sp = 0; while (cond) { __builtin_amdgcn_s_sleep(1); \
    if ((++_sp & 255u) == 0u) { if (xb_ld(&(bar)[XB_TMO])) break; if (_sp > XB_SPIN_CAP) { atomicAdd(&(bar)[XB_TMO], 1u); break; } } } } while (0)
struct XcdBarrier { unsigned* bar; unsigned x; volatile LAS unsigned* st; };
DI XcdBarrier xcd_barrier_post(unsigned* bar, volatile LAS unsigned* st) {
    XcdBarrier b; b.bar = bar; b.x = xb_xcc_id(); b.st = st;
    if (threadIdx.x == 0) (void)xb_add(&bar[XB_XCNT(b.x)], 1u);
    return b;
}
DI void xcd_barrier_complete(unsigned* bar, unsigned x, unsigned& nloc, unsigned& nx) {
    const unsigned G = gridDim.x * gridDim.y * gridDim.z;
    unsigned sum, cnt, mine, sp = 0u;
    for (;;) {
        sum = 0u; cnt = 0u; mine = 0u;
#pragma unroll
        for (unsigned j = 0; j < 16; ++j) { const unsigned c = xb_ld(&bar[XB_XCNT(j)]); sum += c; cnt += (c > 0u) ? 1u : 0u; mine = (j == x) ? c : mine; }
        if (sum == G) break;
        __builtin_amdgcn_s_sleep(1);
        if ((++sp & 255u) == 0u) { if (xb_ld(&bar[XB_TMO])) break; if (sp > XB_SPIN_CAP) { atomicAdd(&bar[XB_TMO], 1u); break; } }
    }
    nloc = mine > 0u ? mine : 1u; nx = cnt > 0u ? cnt : 1u;
}
DI void xcd_barrier(const XcdBarrier& b) {
    asm volatile("s_waitcnt vmcnt(0)" ::: "memory");
    __syncthreads();
    if (threadIdx.x == 0) {
        unsigned* bar = b.bar;
        __builtin_amdgcn_s_waitcnt(0);
        unsigned nloc = b.st[0], nx = b.st[1];
        if (nloc == 0u) { xcd_barrier_complete(bar, b.x, nloc, nx); b.st[0] = nloc; b.st[1] = nx; }
        const unsigned old = xb_add(&bar[XB_XSUB(b.x)], 1u);
        const unsigned gen = old / nloc;
        if (old + 1u == (gen + 1u) * nloc) {
            __builtin_amdgcn_fence(__ATOMIC_RELEASE, "agent");
            asm volatile("s_waitcnt vmcnt(0)" ::: "memory");
            const unsigned og = xb_add(&bar[XB_TOP], 1u);
            const unsigned tg = og / nx;
            if (og + 1u == (tg + 1u) * nx) xb_add(&bar[XB_TOPGEN], 1u);
            else XB_SPIN(xb_ld(&bar[XB_TOPGEN]) == tg, bar);
            __builtin_amdgcn_fence(__ATOMIC_ACQUIRE, "agent");
            xb_add(&bar[XB_XGEN(b.x)], 1u);
            asm volatile("s_waitcnt vmcnt(0)" ::: "memory");
        } else {
            XB_SPIN(xb_ld(&bar[XB_XGEN(b.x)]) == gen, bar);
            __builtin_amdgcn_fence(__ATOMIC_ACQUIRE, "agent");
            asm volatile("s_waitcnt vmcnt(0)" ::: "memory");
        }
    }
    __syncthreads();
}

struct Args { const float* in[15]; float* out; unsigned char* ws; int st_lo, st_hi; };

template <bool NT> DI void tr_item(const float* src, size_t pitch, int scol, bf16* dst, size_t dpitch, LAS float* scr, int lane, const float* gk  , int w1c0 = -1  , int w1k0 = 0) {
    f32x4 v[16]; const int kr = lane >> 4, c4 = (lane & 15) * 4;
#pragma unroll
    for (int i = 0; i < 16; ++i) { const f32x4* p_ = (const f32x4*)(src + (size_t)(4 * i + kr) * pitch + scol); v[i] = (scol >= 0) ? (NT ? __builtin_nontemporal_load(p_) : *p_) : (f32x4){0.f, 0.f, 0.f, 0.f}; }
#pragma unroll
    for (int i = 0; i < 16; ++i) { if (gk) v[i] *= gk[4 * i + kr]; LAS float* p = scr + (4 * i + kr) * 65 + c4; p[0] = v[i].x; p[1] = v[i].y; p[2] = v[i].z; p[3] = v[i].w; }
    LDS_WAIT(); asm volatile("" ::: "memory");
    const int c = lane & 7;
#pragma unroll
    for (int j = 0; j < 8; ++j) { const int n = (lane >> 3) + 8 * j; const LAS float* s = scr + (8 * c) * 65 + n;
        u32x4 o; o.x = pk2(s[0 * 65], s[1 * 65]); o.y = pk2(s[2 * 65], s[3 * 65]); o.z = pk2(s[4 * 65], s[5 * 65]); o.w = pk2(s[6 * 65], s[7 * 65]);
        if (w1c0 < 0) { if (NT) __builtin_nontemporal_store(o, (u32x4*)(dst + (size_t)n * dpitch + 8 * c)); else *(u32x4*)(dst + (size_t)n * dpitch + 8 * c) = o; }
        else { const int cc = w1c0 + n, k = w1k0 + 8 * c; *(u32x4*)(dst + ((size_t)(((k >> 5) * 8 + (cc >> 4)) * 64 + ((k >> 3) & 3) * 16 + (cc & 15))) * 8) = o; } }
    LDS_WAIT(); asm volatile("" ::: "memory");
}
constexpr int I_IN = 64 * (NPAD / 64), I_POOL = 4 * 8 * 8, I_UP = 32 * 64, I_OUT = 64 * 64, I_W1 = 2 * 64 * 2, I_W2 = 2 * 2 * 2;
constexpr int I_LAYER = I_IN + I_POOL + 2 * I_UP + I_OUT + I_W1 + I_W2;
constexpr int OFF_WGS = 96, OFF_FIRST = 160, OFF_ITEMS = 12288;
static_assert(OFF_ITEMS <= I_IN && (32 * NINT) - 9 * 256 == OFF_FIRST && OFF_FIRST + OFF_WGS == 256, "in-projection slack split");
template <bool NT> DI void conv_item(const Args& a, int l, int r, LAS float* scr, int lane) {
    unsigned char* ws = a.ws; const int c4 = (lane & 15) * 4;
        const float* src; size_t pitch, dpitch; int sc; bf16* dst; int w1c0 = -1, w1k0 = 0; const float* gk = nullptr;
        if (r < I_IN) {
            const int nblk = NPAD / 64, kb = r / nblk, nb = r % nblk, np = nb * 64 + c4;
            if (np < 11264) sc = np;
        else if (np < 19456) { const int q = (np - 11264) & 255, k = (np - 11264) >> 8;
            sc = 11312 + ((q >> 5) & 1) * 4096 + 128 * k + 32 * (q >> 6) + (q & 31); }
        else if (np < 19504) sc = 11264 + (np - 19456); else sc = -1;
            gk = a.in[1] + (size_t)l * DM + kb * 64;
            src = a.in[2] + (size_t)l * DM * NIN + (size_t)kb * 64 * NIN; pitch = NIN; dst = (bf16*)(ws + WS_WIN + l * SZ_WIN) + (size_t)nb * 64 * DM + kb * 64; dpitch = DM;
        } else if ((r -= I_IN) < I_POOL) {
            const int g = r / 64, q = r % 64, kb = q / 8, nb = q % 8;
            src = a.in[4] + ((size_t)(l * 4 + g) * 512 + kb * 64) * 512; pitch = 512; sc = nb * 64 + c4; dst = (bf16*)(ws + WS_POOLW + l * SZ_POOLW) + ((size_t)g * 512 + nb * 64) * 512 + kb * 64; dpitch = 512;
        } else if ((r -= I_POOL) < 2 * I_UP) {
            const int which = r / I_UP, q = r % I_UP, kb = q / 64, nb = q % 64;
            src = a.in[12 + which] + ((size_t)l * PW + kb * 64) * DM; pitch = DM; sc = nb * 64 + c4; dst = (bf16*)(ws + (which ? WS_WNU : WS_WPU) + l * SZ_WUP) + (size_t)nb * 64 * PW + kb * 64; dpitch = PW;
        } else if ((r -= 2 * I_UP) < I_OUT) {
            const int kb = r / 64, nb = r % 64;
            src = a.in[14] + ((size_t)l * DM + kb * 64) * DM; pitch = DM; sc = nb * 64 + c4; dst = (bf16*)(ws + WS_WOUT + l * SZ_WOUT) + (size_t)nb * 64 * DM + kb * 64; dpitch = DM;
        } else if ((r -= I_OUT) < I_W1) {
            const int i = r / 128, q = r % 128, kb = q / 2, nb = q % 2;
            src = a.in[9] + ((size_t)(l * 2 + i) * 4096 + kb * 64) * 128; pitch = 128; sc = nb * 64 + c4; dst = (bf16*)(ws + WS_W1 + l * SZ_W1) + (size_t)i * 128 * 4096; dpitch = 4096; w1c0 = nb * 64; w1k0 = kb * 64;
        } else {
            r -= I_W1; const int i = r / 4, q = r % 4, kb = q / 2, nb = q % 2;
            src = a.in[11] + ((size_t)(l * 2 + i) * 128 + kb * 64) * 128; pitch = 128; sc = nb * 64 + c4; dst = (bf16*)(ws + WS_W2 + l * SZ_W2) + ((size_t)i * 128 + nb * 64) * 128 + kb * 64; dpitch = 128;
        }
        tr_item<NT>(src, pitch, sc, dst, dpitch, scr, lane, gk, w1c0, w1k0);
}
DI void prologue(const Args& a, LAS unsigned char* lds, int gw, int NGW, int wave, int lane, bool offload) {
    LAS float* scr = (LAS float*)(lds + wave * 16640);
    const int skip = offload ? OFF_ITEMS : 0, per = I_LAYER - skip, n = I_LAYER + (DEPTH - 1) * per;
    for (int it = gw; it < n; it += NGW) {
        int l, r; if (it < I_LAYER) { l = 0; r = it; } else { const int q = it - I_LAYER; l = 1 + q / per; r = skip + q % per; }
        conv_item<false>(a, l, r, scr, lane);
    }
}
DI void slack_convert(const Args& a, LAS unsigned char* lds, int l_next, int bx, int wave, int lane) {
    LAS float* scr = (LAS float*)(lds + wave * 16640);
    for (int r = (bx - OFF_FIRST) * NWAVES + wave; r < OFF_ITEMS; r += OFF_WGS * NWAVES) conv_item<true>(a, l_next, r, scr, lane);
}

DI void p1_xb(const float* x, bf16* xb, float* ss, int gw, int NGW, int lane) {
    for (int m = gw; m < T; m += NGW) {
        const f32x4* xr = (const f32x4*)(x + (size_t)m * DM) + lane;
        f32x4 v[16]; float s = 0.f;
#pragma unroll
        for (int j = 0; j < 16; ++j) { v[j] = xr[64 * j]; s += (v[j].x * v[j].x + v[j].y * v[j].y) + (v[j].z * v[j].z + v[j].w * v[j].w); }
        ss[(size_t)m * 64 + lane] = s;
        u32x2* o = (u32x2*)(xb + (size_t)m * DM) + lane;
#pragma unroll
        for (int j = 0; j < 16; ++j) { u32x2 w; w.x = pk2(v[j].x, v[j].y); w.y = pk2(v[j].z, v[j].w); o[64 * j] = w; }
    }
}

DI int swap23(int m) { return (m & 0x13) | ((m & 4) << 1) | ((m & 8) >> 1); }
DI size_t ktile_off(int key, int c  ) { return (size_t)(key >> 5) * 8192 + (size_t)((c & 7) * 1024 + ((c >> 3) * 32 + swap23(key & 31)) * 16); }
DI size_t vtile_off(int kb  , int d) { return (size_t)(kb >> 5) * 8192 + (size_t)(((d >> 5) * 2 + ((kb >> 4) & 1)) * 1024 + (((kb >> 3) & 1) * 32 + (d & 31)) * 16); }
struct MidP { const bf16 *U, *QR, *KV6; bf16 *MP, *QN, *KSN, *KWN, *VST, *VWT; const float *qg, *kg; };
template <int W> DI void pool_item4(const bf16* U, bf16* MP, int t0, int g, int lane) {
    const bf16* up = U + (size_t)t0 * PW + g * 512 + lane * 8;
    u32x4 v[W + 3];
#pragma unroll
    for (int i = 0; i < W + 3; ++i) { const int r = 3 - i;
        v[i] = (t0 + r >= 0) ? *(const u32x4*)(up + (ptrdiff_t)r * PW) : (u32x4){0u, 0u, 0u, 0u}; }
#pragma unroll
    for (int k = 0; k < 4; ++k) {
        float s[8], u0[8]; unpack8(v[3 - k], u0);
#pragma unroll
        for (int e = 0; e < 8; ++e) s[e] = u0[e];
#pragma unroll
        for (int i = 1; i < W; ++i) { float f[8]; unpack8(v[3 - k + i], f);
#pragma unroll
            for (int e = 0; e < 8; ++e) s[e] += f[e]; }
        const int t = t0 + k, nwin = (t + 1 < W) ? t + 1 : W; const float inv = 1.f / (float)nwin; float o[8];
#pragma unroll
        for (int e = 0; e < 8; ++e) o[e] = s[e] * inv - u0[e];
        *(u32x4*)(MP + (size_t)t * PW + g * 512 + lane * 8) = pack8(o);
    }
}
DI void p3_mid(const MidP& P, LAS unsigned char* lds, int gw, int NGW, int wave, int lane) {
    for (int it = gw; it < T; it += NGW) {
        const int g = it / (T / 4), t0 = (it % (T / 4)) * 4;
        if (g == 0) pool_item4<2>(P.U, P.MP, t0, 0, lane); else if (g == 1) pool_item4<4>(P.U, P.MP, t0, 1, lane); else if (g == 2) pool_item4<8>(P.U, P.MP, t0, 2, lane); else pool_item4<16>(P.U, P.MP, t0, 3, lane);
    }
    for (int it = gw; it < 2 * 4 * (T / 32); it += NGW) {
        const int w = it / (4 * (T / 32)), r = it % (4 * (T / 32)), h = r / (T / 32), tile = r % (T / 32);
        const int hi2 = lane >> 5, key = tile * 32 + swap23(lane & 31);
        const u32x4* src = (const u32x4*)(P.KV6 + (size_t)key * KV6W + (w ? 2048 : 1024) + h * 128 + 64 * hi2);
        u32x4 v[8];
#pragma unroll
        for (int j = 0; j < 8; ++j) v[j] = src[j];
        float ss = 0.f;
#pragma unroll
        for (int j = 0; j < 8; ++j) { float f[8]; unpack8(v[j], f);
#pragma unroll
            for (int e = 0; e < 8; ++e) ss += f[e] * f[e]; }
        ss += shx(ss, 32);
        const float rs = 1.f / sqrtf(ss * (1.f / 128.f) + EPS);
        const float* kgp = P.kg + (1 + w) * 128 + 64 * hi2;
        char* dstb = (char*)((w ? P.KWN : P.KSN) + (size_t)h * T * 128) + (size_t)tile * 8192 + lane * 16;
#pragma unroll
        for (int j = 0; j < 8; ++j) { float f[8], o[8]; unpack8(v[j], f); const f32x4 g0 = *(const f32x4*)(kgp + 8 * j), g1 = *(const f32x4*)(kgp + 8 * j + 4);
            o[0] = f[0] * rs * g0.x; o[1] = f[1] * rs * g0.y; o[2] = f[2] * rs * g0.z; o[3] = f[3] * rs * g0.w; o[4] = f[4] * rs * g1.x; o[5] = f[5] * rs * g1.y; o[6] = f[6] * rs * g1.z; o[7] = f[7] * rs * g1.w;
            *(u32x4*)(dstb + j * 1024) = pack8(o); }
    }
    LAS bf16* tl = (LAS bf16*)(lds + wave * 17408);
    for (int it = gw; it < 2 * 4 * (T / 64); it += NGW) {
        const int which = it / (4 * (T / 64)), r = it % (4 * (T / 64)), h = r / (T / 64), tb = r % (T / 64);
        const bf16* src = P.KV6 + (size_t)(tb * 64) * KV6W + (which ? 2560 : 1536) + h * 128;
#pragma unroll
        for (int i = 0; i < 16; ++i) { const int tt = i * 4 + (lane >> 4), dc = (lane & 15) * 8; const u32x4 v = *(const u32x4*)(src + (size_t)tt * KV6W + dc); *(LAS u32x4*)(tl + tt * 136 + dc) = v; }
        LDS_WAIT(); asm volatile("" ::: "memory");
        char* dst = (char*)((which ? P.VWT : P.VST) + (size_t)h * 128 * T) + (size_t)(tb * 2) * 8192 + lane * 16;
        const int m2 = lane & 31, hi2 = lane >> 5;
#pragma unroll
        for (int i = 0; i < 16; ++i) { const int tl2 = i >> 3, dt = (i >> 1) & 3, s2 = i & 1;
            const int d = 32 * dt + m2, k0 = 32 * tl2 + 16 * s2 + 8 * hi2; unsigned short e[8];
#pragma unroll
            for (int k = 0; k < 8; ++k) e[k] = tl[(k0 + k) * 136 + d];
            u32x4 w; w.x = e[0] | ((unsigned)e[1] << 16); w.y = e[2] | ((unsigned)e[3] << 16); w.z = e[4] | ((unsigned)e[5] << 16); w.w = e[6] | ((unsigned)e[7] << 16);
            *(u32x4*)(dst + (size_t)tl2 * 8192 + (dt * 2 + s2) * 1024) = w; }
        LDS_WAIT(); asm volatile("" ::: "memory");
    }
}

struct CmpP { const bf16* KV6; const float* pe; const bf16* W1T; const float* b1; const bf16* W2T; const float* kg0; bf16* KCN; bf16* VCT; };
DI void p3_compress(const CmpP& P, LAS unsigned char* lds, int G, int tid, int wave, int lane) {
    LAS float* red = (LAS float*)lds;
    LAS bf16* hid = (LAS bf16*)(lds + 65536);
    LAS float* out2 = (LAS float*)(lds + 65536 + 8192);
    for (int cu = blockIdx.x; cu < 256; cu += G) {
        const int which = cu & 1, h = (cu >> 1) & 3, n0 = (cu >> 3) * 16;
        const int i = lane & 15, kq = lane >> 4;
        const bf16* w1t = P.W1T + (size_t)which * 128 * 4096; const float* pe = P.pe + which * 4096;
        f32x4 acc[8];
#pragma unroll
        for (int ct = 0; ct < 8; ++ct) acc[ct] = (f32x4){0.f, 0.f, 0.f, 0.f};
#pragma unroll 8
        for (int ks = 0; ks < 16; ++ks) {
            const int kk = wave * 512 + ks * 32 + kq * 8, lt = kk >> 7, d = kk & 127, tok = 16 * (n0 + i) + lt;
            float af[8];
            if (tok < T) { const u32x4 v = *(const u32x4*)(P.KV6 + (size_t)tok * KV6W + which * 512 + h * 128 + d); unpack8(v, af); }
            else {
#pragma unroll
                for (int e = 0; e < 8; ++e) af[e] = 0.f; }
            const f32x4 p0 = *(const f32x4*)(pe + kk), p1 = *(const f32x4*)(pe + kk + 4);
            af[0] += p0.x; af[1] += p0.y; af[2] += p0.z; af[3] += p0.w; af[4] += p1.x; af[5] += p1.y; af[6] += p1.z; af[7] += p1.w;
            const bf16x8 a = __builtin_bit_cast(bf16x8, pack8(af));
#pragma unroll
            for (int ct = 0; ct < 8; ++ct) { const bf16x8 b = *(const bf16x8*)((const char*)w1t + (size_t)((wave * 16 + ks) * 8 + ct) * 1024 + lane * 16);
                acc[ct] = __builtin_amdgcn_mfma_f32_16x16x32_bf16(a, b, acc[ct], 0, 0, 0); }
        }
#pragma unroll
        for (int ct = 0; ct < 8; ++ct)
#pragma unroll
            for (int e = 0; e < 4; ++e) red[(wave * 16 + kq * 4 + e) * 128 + ct * 16 + i] = acc[ct][e];
        __syncthreads();
        {
            const int n = tid >> 5, c0 = (tid & 31) * 4; f32x4 s = *(const f32x4*)(P.b1 + which * 128 + c0);
#pragma unroll
            for (int w = 0; w < 8; ++w) { const f32x4 v = *(const LAS f32x4*)(red + (w * 16 + n) * 128 + c0); s += v; }
            u32x2 hw; hw.x = pk2(s.x * sigm(s.x), s.y * sigm(s.y)); hw.y = pk2(s.z * sigm(s.z), s.w * sigm(s.w));
            *(LAS u32x2*)(hid + n * 136 + c0) = hw;
        }
        __syncthreads();
        {
            const bf16* w2t = P.W2T + (size_t)which * 128 * 128; f32x4 c2 = (f32x4){0.f, 0.f, 0.f, 0.f};
#pragma unroll
            for (int ks = 0; ks < 4; ++ks) { const bf16x8 a = *(const LAS bf16x8*)(hid + i * 136 + ks * 32 + kq * 8); const bf16x8 b = *(const bf16x8*)(w2t + (size_t)(wave * 16 + i) * 128 + ks * 32 + kq * 8);
                c2 = __builtin_amdgcn_mfma_f32_16x16x32_bf16(a, b, c2, 0, 0, 0); }
#pragma unroll
            for (int e = 0; e < 4; ++e) out2[(kq * 4 + e) * 132 + wave * 16 + i] = c2[e];
        }
        __syncthreads();
        if (which == 0) {
            if (tid < 256) { const int n = tid >> 4, c = tid & 15; const f32x4 v0 = *(const LAS f32x4*)(out2 + n * 132 + c * 8), v1 = *(const LAS f32x4*)(out2 + n * 132 + c * 8 + 4);
                float ss = (v0.x * v0.x + v0.y * v0.y) + (v0.z * v0.z + v0.w * v0.w) + (v1.x * v1.x + v1.y * v1.y) + (v1.z * v1.z + v1.w * v1.w);
                ss = sum16(ss);
                const float rs = 1.f / sqrtf(ss * (1.f / 128.f) + EPS); const f32x4 g0 = *(const f32x4*)(P.kg0 + c * 8), g1 = *(const f32x4*)(P.kg0 + c * 8 + 4);
                u32x4 w; w.x = pk2(v0.x * rs * g0.x, v0.y * rs * g0.y); w.y = pk2(v0.z * rs * g0.z, v0.w * rs * g0.w); w.z = pk2(v1.x * rs * g1.x, v1.y * rs * g1.y); w.w = pk2(v1.z * rs * g1.z, v1.w * rs * g1.w);
                *(u32x4*)((char*)(P.KCN + (size_t)h * NCP * 128) + ktile_off(n0 + n, c)) = w; }
        } else {
            if (tid < 256) { const int d = tid >> 1, a = tid & 1; float e[8];
#pragma unroll
                for (int k = 0; k < 8; ++k) e[k] = out2[(8 * a + k) * 132 + d];
                *(u32x4*)((char*)(P.VCT + (size_t)h * 128 * NCP) + vtile_off(n0 + 8 * a, d)) = pack8(e); }
        }
        __syncthreads();
    }
}

#define MFMA32(a, b, c) __builtin_amdgcn_mfma_f32_32x32x16_bf16((a), (b), (c), 0, 0, 0)
struct AttP { const bf16 *QN  , *KCN, *VCT, *KSN, *VST, *KWN, *VWT, *NG, *ZN; bf16* NO; float* OST; const float* qg; };
constexpr int AT_STG = 0, AT_IMP = 65536, AT_WUN = 98304, AT_CLIST = 98304 + 256;

template <int STRIDE>
DI void qk_tile(f32x16& S, const bf16x8 (&qf)[8], const LAS unsigned char* kl  , float sl2, float tbm) {
    bf16x8 kf[8];
#pragma unroll
    for (int j = 0; j < 8; ++j) kf[j] = *(const LAS bf16x8*)(kl + j * 1024);
    __builtin_amdgcn_sched_barrier(0);
    const float sl2s = sl2 * (float)STRIDE;
#pragma unroll
    for (int r = 0; r < 16; ++r) { float x = __builtin_fmaf(sl2s, (float)(16 * (r >> 3) + (r & 7)), tbm); asm volatile("" : "+v"(x)); S[r] = x; }
#pragma unroll
    for (int j = 0; j < 8; ++j) S = MFMA32(kf[j], qf[j], S);
}
template <int STRIDE>
DI void edge_mask(f32x16& S, int rel0, int lo) {
#pragma unroll
    for (int r = 0; r < 16; ++r) { const int rel = rel0 + STRIDE * (16 * (r >> 3) + (r & 7)); S[r] = (rel <= 0 && rel >= lo) ? S[r] : NEG; }
}
DI float tile_max(const f32x16& S) {
    float mx = S[0];
#pragma unroll
    for (int r = 1; r < 16; ++r) mx = fmaxf(mx, S[r]);
    return fmaxf(mx, shx(mx, 32));
}
DI void soft_fixed(f32x16& S, float& mref, float& l) {
    const bool unset = mref < -1e29f;
    if (__builtin_amdgcn_ballot_w64(unset) != 0ull) {
        const float mx = tile_max(S); const bool now = unset && (mx > -1e29f); const float d = now ? mx : 0.f;
#pragma unroll
        for (int r = 0; r < 16; ++r) S[r] -= d;
        mref = now ? mx : mref;
    }
    float sum = 0.f;
#pragma unroll
    for (int r = 0; r < 16; ++r) { S[r] = ex2(S[r]); sum += S[r]; }
    l += sum;
}
DI void v_load4(bf16x8 (&vf)[4], const LAS unsigned char* vl  ) {
#pragma unroll
    for (int i = 0; i < 4; ++i) vf[i] = *(const LAS bf16x8*)(vl + i * 1024);
    __builtin_amdgcn_sched_barrier(0);
}
DI void pack_p(const f32x16& Pm, u32x4& p0, u32x4& p1) {
    p0.x = pk2(Pm[0], Pm[1]); p0.y = pk2(Pm[2], Pm[3]); p0.z = pk2(Pm[4], Pm[5]); p0.w = pk2(Pm[6], Pm[7]);
    p1.x = pk2(Pm[8], Pm[9]); p1.y = pk2(Pm[10], Pm[11]); p1.z = pk2(Pm[12], Pm[13]); p1.w = pk2(Pm[14], Pm[15]);
}
DI void pv_mma(f32x16 (&O)[4], const u32x4& p0, const u32x4& p1, const bf16x8 (&va)[4], const bf16x8 (&vb)[4]) {
    const bf16x8 pb0 = __builtin_bit_cast(bf16x8, p0), pb1 = __builtin_bit_cast(bf16x8, p1);
#pragma unroll
    for (int dt = 0; dt < 2; ++dt) { O[dt] = MFMA32(va[2 * dt], pb0, O[dt]); O[dt] = MFMA32(va[2 * dt + 1], pb1, O[dt]); }
#pragma unroll
    for (int dt = 0; dt < 2; ++dt) { O[2 + dt] = MFMA32(vb[2 * dt], pb0, O[2 + dt]); O[2 + dt] = MFMA32(vb[2 * dt + 1], pb1, O[2 + dt]); }
}
DI void o_zero(f32x16 (&O)[4]) {
#pragma unroll
    for (int dt = 0; dt < 4; ++dt)
#pragma unroll
        for (int r = 0; r < 16; ++r) O[dt][r] = 0.f;
}
DI float dpp_xor1(float v) { return __builtin_bit_cast(float, __builtin_amdgcn_update_dpp(0, __builtin_bit_cast(int, v), 0xB1, 0xF, 0xF, true)); }
DI float dpp_xor2(float v) { return __builtin_bit_cast(float, __builtin_amdgcn_update_dpp(0, __builtin_bit_cast(int, v), 0x4E, 0xF, 0xF, true)); }
DI void lds_fadd(LAS float* p, float v) { (void)__hip_atomic_fetch_add(p, v, __ATOMIC_RELAXED, __HIP_MEMORY_SCOPE_WORKGROUP); }

struct TileCtx { const char *kc, *vc, *kw, *vw, *ks, *vs; int nt, nd, wlast, cur; const LAS unsigned char* clist; };
DI void tile_ptrs(const TileCtx& X, int idx, const char*& k, const char*& v) {
    if (idx < X.nt) { k = X.kc + (size_t)(X.nt - 1 - idx) * 8192; v = nullptr; }
    else if (idx < 2 * X.nt) { k = X.kc + (size_t)(2 * X.nt - 1 - idx) * 8192; v = X.vc + (size_t)(2 * X.nt - 1 - idx) * 8192; }
    else if (idx < 2 * X.nt + X.nd) { const int k0 = X.wlast - 32 * (idx - 2 * X.nt); k = X.kw + (size_t)k0 * 256; v = X.vw + (size_t)k0 * 256; }
    else { const int j = idx - 2 * X.nt - X.nd; const int b = (j < 2) ? X.cur : __builtin_amdgcn_readfirstlane((int)X.clist[j >> 1]); const int k0 = b * 64 + 32 * (1 - (j & 1)); k = X.ks + (size_t)k0 * 256; v = X.vs + (size_t)k0 * 256; }
}

DI void attn_wg_unit(const AttP& P, LAS unsigned char* lds, int wave, int lane, int c, int h) {
    LAS float* imp = (LAS float*)(lds + AT_IMP + wave * 4096);
    LAS unsigned* wun = (LAS unsigned*)(lds + AT_WUN);
    LAS unsigned char* clist = lds + AT_CLIST;
    LAS unsigned short* selw = (LAS unsigned short*)(lds + SELW_OFF + wave * 128);
    const int t0 = c * 64 + wave * 8;
    const int n = lane & 31, hi = lane >> 5, tok = n >> 2, gq = n & 3, t = t0 + tok, hq = h * 4 + gq;
    const unsigned koff = (unsigned)lane * 16u;
    const float sl2 = ex2(-0.5f * (float)(hq + 1)) * LOG2E;
    const int cur = c;
    bf16x8 qf[8];
    {
        const u32x4* qp = (const u32x4*)(P.QN + (size_t)t * NSAW + hq * 128 + 64 * hi);
        u32x4 qv[8];
#pragma unroll
        for (int j = 0; j < 8; ++j) qv[j] = qp[j];
        float ss = 0.f;
#pragma unroll
        for (int j = 0; j < 8; ++j) { float f[8]; unpack8(qv[j], f);
#pragma unroll
            for (int e = 0; e < 8; ++e) ss += f[e] * f[e]; }
        ss += shx(ss, 32);
        const float rs = (0.08838834764831845f * LOG2E) / sqrtf(ss * (1.f / 128.f) + EPS);
        const float* gp = P.qg + 64 * hi;
#pragma unroll
        for (int j = 0; j < 8; ++j) { float f[8]; unpack8(qv[j], f); const f32x4 g0 = *(const f32x4*)(gp + 8 * j), g1 = *(const f32x4*)(gp + 8 * j + 4);
            f[0] *= rs * g0.x; f[1] *= rs * g0.y; f[2] *= rs * g0.z; f[3] *= rs * g0.w; f[4] *= rs * g1.x; f[5] *= rs * g1.y; f[6] *= rs * g1.z; f[7] *= rs * g1.w;
            qf[j] = __builtin_bit_cast(bf16x8, pack8(f)); }
    }
#define AT_GATE(br) bflo((unsigned)*(const bf16*)(P.NG + (size_t)t * 256 + hq * 3 + (br)))
#define AT_OST() u32x2* ost; { int l2_ = lane; asm volatile("" : "+v"(l2_)); ost = (u32x2*)P.OST + ((size_t)(t0 >> 3) * 4 + h) * 1024 + l2_; }
    f32x16 O[4], S;
#pragma unroll
    for (int i = 0; i < 4; ++i) *(LAS f32x4*)(imp + (i * 64 + lane) * 4) = (f32x4){0.f, 0.f, 0.f, 0.f};

    TileCtx X;
    X.kc = (const char*)(P.KCN + (size_t)h * NCP * 128); X.vc = (const char*)(P.VCT + (size_t)h * 128 * NCP);
    X.kw = (const char*)(P.KWN + (size_t)h * T * 128); X.vw = (const char*)(P.VWT + (size_t)h * 128 * T);
    X.ks = (const char*)(P.KSN + (size_t)h * T * 128); X.vs = (const char*)(P.VST + (size_t)h * 128 * T);
    X.nt = ((((c * 64 + 63 - 31) >> 4) + 1) + 31) >> 5;
    X.wlast = c * 64 + 32; { const int wf = (c >= 8) ? 64 * (c - 8) : 0; X.nd = ((X.wlast - wf) >> 5) + 1; }
    X.clist = clist; X.cur = c;
    const int nvalid = (t0 + 7 >= 31) ? ((t0 + 7 - 31) >> 4) + 1 : 0, ntw = (nvalid + 31) >> 5;
    int kfw = t0 - 511; kfw = kfw < 0 ? 0 : (kfw & ~31); const int klw = t0 & ~31;
    const int nt = X.nt, nd = X.nd, S1 = 2 * nt + nd;
    int total = S1 + 2;
    unsigned un[4] = {0u, 0u, 0u, 0u};
    float m = NEG, l = 0.f, rl = 0.f, mu = 0.f;

    int idx = 0, pend = S1 + 2;
#define AT_ISSUE(ti) do { const char *k_, *v_; tile_ptrs(X, (ti), k_, v_); LAS unsigned char* nb_ = lds + AT_STG + ((ti) & 3) * 16384 + wave * 1024; \
        __builtin_amdgcn_global_load_lds((const unsigned*)(k_ + wave * 1024 + koff), (LAS unsigned*)nb_, 16, 0, 0); \
        __builtin_amdgcn_global_load_lds((const unsigned*)((v_ ? v_ : k_) + wave * 1024 + koff), (LAS unsigned*)(nb_ + 8192), 16, 0, 0); } while (0)
#define AT_SYNC() do { if (idx + 1 < pend) asm volatile("s_waitcnt vmcnt(2) lgkmcnt(0)\n\ts_barrier" ::: "memory"); else asm volatile("s_waitcnt vmcnt(0) lgkmcnt(0)\n\ts_barrier" ::: "memory"); } while (0)
#define AT_PREFETCH() do { if (idx + 2 < pend) AT_ISSUE(idx + 2); } while (0)
#define AT_VL(ti) (lds + AT_STG + ((ti) & 3) * 16384 + 8192 + koff)
#define AT_KL() (lds + AT_STG + (idx & 3) * 16384 + koff)
    asm volatile("s_waitcnt vmcnt(0) lgkmcnt(0)\n\ts_barrier" ::: "memory");
#pragma unroll 1
    for (int d = 0; d < 2; ++d) if (d < pend) AT_ISSUE(d);

#pragma unroll 1
    for (; idx < nt; ++idx) {
        AT_SYNC(); AT_PREFETCH();
        const LAS unsigned char* kl = AT_KL();
        const int ti = nt - 1 - idx, k0 = ti * 32, rel0 = 16 * (k0 + 8 * hi) + 31 - t;
        qk_tile<16>(S, qf, kl, sl2, sl2 * (float)rel0 - ((m < -1e29f) ? 0.f : m));
        if (ti >= ntw - 1) edge_mask<16>(S, rel0, -(1 << 30));
        soft_fixed(S, m, l);
    }
    { const float lt = l + shx(l, 32); const bool have = m > -1e29f; rl = have ? 1.f / lt : 0.f; mu = have ? m : 0.f; }
    o_zero(O);
    int pidx = idx; u32x4 pp0 = {0u, 0u, 0u, 0u}, pp1 = {0u, 0u, 0u, 0u};
#pragma unroll 1
    for (; idx < 2 * nt; ++idx) {
        AT_SYNC(); AT_PREFETCH();
        const LAS unsigned char* kl = AT_KL();
        const int ti = 2 * nt - 1 - idx, k0 = ti * 32, rel0 = 16 * (k0 + 8 * hi) + 31 - t;
        bf16x8 va[4], vb[4]; v_load4(va, AT_VL(pidx));
        qk_tile<16>(S, qf, kl, sl2, sl2 * (float)rel0 - mu);
        v_load4(vb, AT_VL(pidx) + 4096);
        pv_mma(O, pp0, pp1, va, vb);
        if (ti >= ntw - 1) edge_mask<16>(S, rel0, -(1 << 30));
#pragma unroll
        for (int r = 0; r < 16; ++r) S[r] = ex2(S[r]) * rl;
#pragma unroll
        for (int q4 = 0; q4 < 4; ++q4) { float v[4];
#pragma unroll
            for (int e = 0; e < 4; ++e) { float x = S[4 * q4 + e]; x += dpp_xor1(x); x += dpp_xor2(x); v[e] = x; }
            if (gq == 0) { const int j = (k0 >> 2) + 4 * (q4 >> 1) + 2 * hi + (q4 & 1);
                lds_fadd(imp + tok * 128 + j, 2.f * (v[0] + v[1] + v[2]) + v[3]); if (j + 1 < 128) lds_fadd(imp + tok * 128 + j + 1, v[3]); } }
        const float gc = AT_GATE(0);
#pragma unroll
        for (int r = 0; r < 16; ++r) S[r] *= gc;
        pack_p(S, pp0, pp1); pidx = idx;
    }
    { bf16x8 va[4], vb[4]; v_load4(va, AT_VL(pidx)); v_load4(vb, AT_VL(pidx) + 4096); pv_mma(O, pp0, pp1, va, vb); }
    {
        LDS_WAIT(); asm volatile("" ::: "memory");
        int l5 = lane; asm volatile("" : "+v"(l5));
        const int tk = l5 >> 3, sub = l5 & 7; const LAS float* pb = imp + tk * 128 + sub * 16;
        unsigned key[16];
#pragma unroll
        for (int i4 = 0; i4 < 4; ++i4) { const f32x4 q = *(const LAS f32x4*)(pb + 4 * i4);
#pragma unroll
            for (int e = 0; e < 4; ++e) { const int i = 4 * i4 + e, j = sub * 16 + i; const float iv = (e == 0) ? q.x : (e == 1) ? q.y : (e == 2) ? q.z : q.w;
                const bool valid = j <= cur, forced = (j == 0) || (j == cur) || (j == cur - 1);
                const unsigned ib = ((__builtin_bit_cast(unsigned, iv) & 0x7fffff00u) | (unsigned)(255 - j));
                key[i] = !valid ? 0u : (forced ? (0x7f000000u | (unsigned)(255 - j)) : ib); } }
        const int R = (cur + 1 < 16) ? cur + 1 : 16; unsigned sel = 0u;
        for (int rd = 0; rd < R; ++rd) {
            unsigned mx = key[0];
#pragma unroll
            for (int i = 1; i < 16; ++i) mx = mx > key[i] ? mx : key[i];
            { unsigned ot = (unsigned)__builtin_amdgcn_update_dpp(0, (int)mx, 0xB1, 0xF, 0xF, true); mx = mx > ot ? mx : ot;
              ot = (unsigned)__builtin_amdgcn_update_dpp(0, (int)mx, 0x4E, 0xF, 0xF, true); mx = mx > ot ? mx : ot;
              ot = (unsigned)__builtin_amdgcn_update_dpp(0, (int)mx, 0x141, 0xF, 0xF, true); mx = mx > ot ? mx : ot; }
#pragma unroll
            for (int i = 0; i < 16; ++i) { const bool hit = (key[i] == mx); sel |= hit ? (1u << i) : 0u; key[i] = hit ? 0u : key[i]; }
        }
        selw[tk * 8 + sub] = (unsigned short)sel;
        LDS_WAIT(); asm volatile("" ::: "memory");
        const LAS u32x4* sw = (const LAS u32x4*)selw;
        u32x4 uu = sw[0];
#pragma unroll
        for (int k = 1; k < 8; ++k) { const u32x4 o = sw[k]; uu.x |= o.x; uu.y |= o.y; uu.z |= o.z; uu.w |= o.w; }
        un[0] = __builtin_amdgcn_readfirstlane(uu.x); un[1] = __builtin_amdgcn_readfirstlane(uu.y); un[2] = __builtin_amdgcn_readfirstlane(uu.z); un[3] = __builtin_amdgcn_readfirstlane(uu.w);
        if (lane == 0) *(LAS u32x4*)(wun + 4 * wave) = (u32x4){un[0], un[1], un[2], un[3]};
        AT_OST();
#pragma unroll
        for (int i = 0; i < 4; ++i) *(LAS f32x4*)(imp + (i * 64 + lane) * 4) = (f32x4){0.f, 0.f, 0.f, 0.f};
#pragma unroll
        for (int q = 0; q < 16; ++q) { u32x2 w_; w_.x = pk2(O[q >> 2][4 * (q & 3)], O[q >> 2][4 * (q & 3) + 1]); w_.y = pk2(O[q >> 2][4 * (q & 3) + 2], O[q >> 2][4 * (q & 3) + 3]); ost[q * 64] = w_;
            if ((q & 3) == 3) asm volatile("" ::: "memory"); }
    }
    o_zero(O); m = NEG; l = 0.f;
    pidx = idx; pp0 = (u32x4){0u, 0u, 0u, 0u}; pp1 = pp0;
#define AT_D_HEAD() \
        AT_SYNC(); AT_PREFETCH(); \
        const LAS unsigned char* kl = AT_KL(); \
        const int k0 = X.wlast - 32 * (idx - 2 * nt); \
        const int rel0 = k0 + 8 * hi - t; const bool edge = (k0 + 31 > t0) || (k0 + 511 < t0 + 7)
    if (wave < 4) {
#pragma unroll 1
        for (; idx < S1; ++idx) {
            AT_D_HEAD();
            bf16x8 va[4], vb[4]; v_load4(va, AT_VL(pidx));
            qk_tile<1>(S, qf, kl, sl2, sl2 * (float)rel0 - ((m < -1e29f) ? 0.f : m));
            v_load4(vb, AT_VL(pidx) + 4096);
            pv_mma(O, pp0, pp1, va, vb);
            if (edge) edge_mask<1>(S, rel0, -511);
            soft_fixed(S, m, l); pack_p(S, pp0, pp1); pidx = idx;
        }
    } else {
#pragma unroll
        for (int r = 0; r < 16; ++r) S[r] = NEG;
        int prel0 = 0; bool pedge = false;
#pragma unroll 1
        for (; idx < S1; ++idx) {
            AT_D_HEAD();
            if (pedge) edge_mask<1>(S, prel0, -511);
            soft_fixed(S, m, l); pack_p(S, pp0, pp1);
            { bf16x8 va[4], vb[4]; v_load4(va, AT_VL(pidx)); v_load4(vb, AT_VL(pidx) + 4096); pv_mma(O, pp0, pp1, va, vb); }
            qk_tile<1>(S, qf, kl, sl2, sl2 * (float)rel0 - ((m < -1e29f) ? 0.f : m));
            pidx = idx; prel0 = rel0; pedge = edge;
        }
        if (pedge) edge_mask<1>(S, prel0, -511);
        soft_fixed(S, m, l); pack_p(S, pp0, pp1);
    }
#undef AT_D_HEAD
    { bf16x8 va[4], vb[4]; v_load4(va, AT_VL(pidx)); v_load4(vb, AT_VL(pidx) + 4096); pv_mma(O, pp0, pp1, va, vb); }
    {
        AT_OST();
        const float lt = l + shx(l, 32), cw = AT_GATE(2) / lt;
        asm volatile("s_waitcnt vmcnt(0)" ::: "memory");
#pragma unroll
        for (int q = 0; q < 16; ++q) { const u32x2 sw_ = ost[q * 64]; u32x2 w_;
            w_.x = pk2(bflo(sw_.x) + cw * O[q >> 2][4 * (q & 3)], bfhi(sw_.x) + cw * O[q >> 2][4 * (q & 3) + 1]); w_.y = pk2(bflo(sw_.y) + cw * O[q >> 2][4 * (q & 3) + 2], bfhi(sw_.y) + cw * O[q >> 2][4 * (q & 3) + 3]); ost[q * 64] = w_;
            if ((q & 3) == 3) asm volatile("" ::: "memory"); }
    }
    o_zero(O); m = NEG; l = 0.f;
    {
        u32x4 uu = *(const LAS u32x4*)(wun);
#pragma unroll
        for (int k = 1; k < 8; ++k) { const u32x4 o = *(const LAS u32x4*)(wun + 4 * k); uu.x |= o.x; uu.y |= o.y; uu.z |= o.z; uu.w |= o.w; }
        const unsigned u0 = __builtin_amdgcn_readfirstlane(uu.x), u1 = __builtin_amdgcn_readfirstlane(uu.y), u2 = __builtin_amdgcn_readfirstlane(uu.z), u3 = __builtin_amdgcn_readfirstlane(uu.w);
        const int ncu = __builtin_popcount(u0) + __builtin_popcount(u1) + __builtin_popcount(u2) + __builtin_popcount(u3);
        total = S1 + 2 * ncu;
#pragma unroll
        for (int rr = 0; rr < 2; ++rr) { const int b = lane + 64 * rr;
            const unsigned wb = (b < 32) ? u0 : (b < 64) ? u1 : (b < 96) ? u2 : u3;
            if ((wb >> (b & 31)) & 1u) {
                int above = __builtin_popcount(wb >> (b & 31)) - 1;
                if (b < 96) above += __builtin_popcount(u3); if (b < 64) above += __builtin_popcount(u2); if (b < 32) above += __builtin_popcount(u1);
                clist[above] = (unsigned char)b; } }
        LDS_WAIT(); asm volatile("" ::: "memory");
    }
    pend = total;
    pidx = idx; pp0 = (u32x4){0u, 0u, 0u, 0u}; pp1 = pp0;
    {
        const int ncu2 = (total - S1) >> 1;
        int bc = cur;
        unsigned mc = ((const LAS unsigned*)selw)[tok * 4 + (bc >> 5)];
        unsigned bn_raw = (ncu2 > 1) ? (unsigned)clist[1] : (unsigned)cur;
#define AT_C_HEAD() \
            AT_SYNC(); \
            const int j = idx - S1, half = 1 - (j & 1); \
            const int bn = __builtin_amdgcn_readfirstlane((int)bn_raw); \
            if (idx + 2 < pend) { \
                const int k2 = bn * 64 + 32 * half; LAS unsigned char* nb_ = lds + AT_STG + ((idx + 2) & 3) * 16384 + wave * 1024; \
                __builtin_amdgcn_global_load_lds((const unsigned*)(X.ks + (size_t)k2 * 256 + wave * 1024 + koff), (LAS unsigned*)nb_, 16, 0, 0); \
                __builtin_amdgcn_global_load_lds((const unsigned*)(X.vs + (size_t)k2 * 256 + wave * 1024 + koff), (LAS unsigned*)(nb_ + 8192), 16, 0, 0); } \
            const LAS unsigned char* kl = AT_KL(); \
            const int k0 = bc * 64 + 32 * half; const bool rok = (mc >> (bc & 31)) & 1u; \
            const int rel0 = k0 + 8 * hi - t
#define AT_C_TAIL() \
            if (half == 0) { const int jb = j >> 1; bc = bn; mc = ((const LAS unsigned*)selw)[tok * 4 + (bc >> 5)]; bn_raw = (jb + 2 < ncu2) ? (unsigned)clist[jb + 2] : (unsigned)cur; }
        if (wave < 4) {
#pragma unroll 1
            for (; idx < total; ++idx) {
                AT_C_HEAD();
                bf16x8 va[4], vb[4]; v_load4(va, AT_VL(pidx));
                qk_tile<1>(S, qf, kl, sl2, rok ? (sl2 * (float)rel0 - ((m < -1e29f) ? 0.f : m)) : NEG);
                v_load4(vb, AT_VL(pidx) + 4096);
                pv_mma(O, pp0, pp1, va, vb);
                if (bc == cur) edge_mask<1>(S, rel0, -(1 << 30));
                soft_fixed(S, m, l); pack_p(S, pp0, pp1); pidx = idx;
                AT_C_TAIL();
            }
        } else {
#pragma unroll
            for (int r = 0; r < 16; ++r) S[r] = NEG;
            int prel0 = 0; bool pedge = false;
#pragma unroll 1
            for (; idx < total; ++idx) {
                AT_C_HEAD();
                if (pedge) edge_mask<1>(S, prel0, -(1 << 30));
                soft_fixed(S, m, l); pack_p(S, pp0, pp1);
                { bf16x8 va[4], vb[4]; v_load4(va, AT_VL(pidx)); v_load4(vb, AT_VL(pidx) + 4096); pv_mma(O, pp0, pp1, va, vb); }
                qk_tile<1>(S, qf, kl, sl2, rok ? (sl2 * (float)rel0 - ((m < -1e29f) ? 0.f : m)) : NEG);
                pidx = idx; prel0 = rel0; pedge = (bc == cur);
                AT_C_TAIL();
            }
            if (pedge) edge_mask<1>(S, prel0, -(1 << 30));
            soft_fixed(S, m, l); pack_p(S, pp0, pp1);
        }
#undef AT_C_HEAD
#undef AT_C_TAIL
    }
    { bf16x8 va[4], vb[4]; v_load4(va, AT_VL(pidx)); v_load4(vb, AT_VL(pidx) + 4096); pv_mma(O, pp0, pp1, va, vb); }
#undef AT_SYNC
#undef AT_PREFETCH
#undef AT_KL
#undef AT_VL
#undef AT_ISSUE
    {
        AT_OST();
        const float lt = l + shx(l, 32), cs = AT_GATE(1) / lt;
        asm volatile("s_waitcnt vmcnt(0)" ::: "memory");
        LAS unsigned char* tb = (LAS unsigned char*)imp;
        int l4 = lane; asm volatile("" : "+v"(l4)); const int n4 = l4 & 31, hi4 = l4 >> 5;
#pragma unroll
        for (int ph = 0; ph < 2; ++ph) {
#pragma unroll
            for (int q8 = 0; q8 < 8; ++q8) { const int q = 8 * ph + q8; const u32x2 sw_ = ost[q * 64]; const f32x4 sv = (f32x4){bflo(sw_.x), bfhi(sw_.x), bflo(sw_.y), bfhi(sw_.y)};
                const float o0 = sv.x + cs * O[q >> 2][4 * (q & 3)], o1 = sv.y + cs * O[q >> 2][4 * (q & 3) + 1], o2 = sv.z + cs * O[q >> 2][4 * (q & 3) + 2], o3 = sv.w + cs * O[q >> 2][4 * (q & 3) + 3];
                const int byte = (32 * (q8 >> 2) + 8 * (q8 & 3) + 4 * hi4) * 2;
                u32x2 w; w.x = pk2(o0, o1); w.y = pk2(o2, o3);
                *(LAS u32x2*)(tb + n4 * 128 + ((((byte >> 4) ^ (n4 & 7)) << 4) | (byte & 15))) = w;
                if (q8 & 1) asm volatile("" ::: "memory"); }
            LDS_WAIT(); asm volatile("" ::: "memory");
#pragma unroll
            for (int k = 0; k < 4; ++k) { const int p = l4 + 64 * k, row = p >> 3, ch = p & 7;
                const u32x4 ov = *(const LAS u32x4*)(tb + row * 128 + ((ch ^ (row & 7)) << 4));
                const size_t go = (size_t)(t0 + (row >> 2)) * NSAW + (h * 4 + (row & 3)) * 128 + 64 * ph + 8 * ch;
                const u32x4 zv = *(const u32x4*)(P.ZN + go); float of[8], zf[8]; unpack8(ov, of); unpack8(zv, zf);
#pragma unroll
                for (int e = 0; e < 8; ++e) of[e] *= zf[e];
                *(u32x4*)(P.NO + go) = pack8(of);
                if (k & 1) asm volatile("" ::: "memory"); }
            LDS_WAIT(); asm volatile("" ::: "memory");
        }
#pragma unroll
        for (int i = 0; i < 4; ++i) *(LAS f32x4*)(imp + (i * 64 + lane) * 4) = (f32x4){0.f, 0.f, 0.f, 0.f};
    }
}
#undef AT_GATE
DI void p4_attention(const AttP& P, LAS unsigned char* lds, int G, int wave, int lane) {
    for (int w = blockIdx.x; w < 256; w += G) {
        const int h = w & 3, p = w >> 2;
#pragma unroll 1
        for (int k = 0; k < 2; ++k) attn_wg_unit(P, lds, wave, lane, k ? p : 127 - p, h);
    }
    asm volatile("s_waitcnt vmcnt(0) lgkmcnt(0)\n\ts_barrier" ::: "memory");
}

__global__ void __launch_bounds__(NTHR, 2) mega_fwd(Args args) {
    extern __shared__ __attribute__((aligned(16))) unsigned char lds_raw[];
    LAS unsigned char* lds = (LAS unsigned char*)lds_raw;
    const int tid0 = threadIdx.x;
    const int wave0 = __builtin_amdgcn_readfirstlane(tid0 >> 6);
    const int G = gridDim.x, bx = blockIdx.x;
    const int vcu = (G % 8 == 0) ? (bx % 8) * (G / 8) + bx / 8 : bx;
    const int NGW = G * NWAVES;
    unsigned char* const ws0 = args.ws;
    gu32* ctl = (gu32*)(ws0 + WS_CTL);
    for (int u = tid0; u < (LDS_BYTES - LDSCTL_OFF) / 4; u += NTHR) ((LAS unsigned*)(lds + LDSCTL_OFF))[u] = 0u;
    __syncthreads();
    volatile LAS unsigned* MISC = (volatile LAS unsigned*)(lds + MISC_OFF);
    XcdBarrier bar; bar.bar = (unsigned*)(ctl + CW_BAR); bar.x = 0; bar.st = nullptr;
    if (!MK_MULTI) bar = xcd_barrier_post((unsigned*)(ctl + CW_BAR), MISC + 8);
    const int lo = args.st_lo, hi = args.st_hi;
#define IN(k) (lo <= (k) && (k) < hi)
#ifdef PROBE_PH
    unsigned long long pr_acc = 0ull, pr_t0 = 0ull;
#define PR_B(p) do { if ((p) == PROBE_PH) pr_t0 = __builtin_amdgcn_s_memrealtime(); } while (0)
#define PR_E(p) do { if ((p) == PROBE_PH) pr_acc += __builtin_amdgcn_s_memrealtime() - pr_t0; } while (0)
#else
#define PR_B(p) do {} while (0)
#define PR_E(p) do {} while (0)
#endif
#ifndef REP_PH
#define REP_PH -1
#endif
#define REPS(p) for (int rep_ = 0; rep_ < ((p) == REP_PH ? 2 : 1); ++rep_)
#define LAUNDER_WS() unsigned char* ws = ws0; asm volatile("" : "+s"(ws)); int wave = wave0; asm volatile("" : "+s"(wave)); int lane; asm volatile("v_mbcnt_lo_u32_b32 %0, -1, 0\n\tv_mbcnt_hi_u32_b32 %0, -1, %0" : "=v"(lane)); const int tid = wave * 64 + lane, gw = vcu * NWAVES + wave; (void)tid; (void)gw
#ifndef PH_MASK
#define PH_MASK 0x7f
#endif
#define PH_ON(p) ((PH_MASK >> (p)) & 1)
#define SEAM(k) do { if ((k) + 1 < hi) xcd_barrier(bar); } while (0)

    if (PH_ON(0) && IN(0)) REPS(0) { PR_B(0); LAUNDER_WS(); prologue(args, lds, gw, NGW, wave, lane, G == 256);
        if (IN(1)) p1_xb(args.in[0], (bf16*)(ws + WS_H), (float*)(ws + WS_SS), gw, NGW, lane);
        SEAM(0); PR_E(0); }

    for (int l = 0; l < DEPTH; ++l) {
        const int s0 = 1 + 6 * l;
        if (s0 + 6 <= lo || s0 >= hi) continue;
        if (PH_ON(1) && IN(s0) && l == 0 && !IN(0)) REPS(1) { PR_B(1); LAUNDER_WS(); p1_xb(args.in[0], (bf16*)(ws + WS_H), (float*)(ws + WS_SS), gw, NGW, lane); SEAM(s0); PR_E(1); }
        if (PH_ON(2) && IN(s0 + 1)) REPS(2) {
            PR_B(2);
            LAUNDER_WS(); bf16* Hb = (bf16*)(ws + WS_H);
            pg8::Gemm g{DM, DM, DM};
            pg8::SchedPlain S{(const char*)Hb, (const char*)(ws + WS_WIN + l * SZ_WIN), 32, NINT, G, bx, (size_t)256 * DM * 2, (size_t)256 * DM * 2, WGM_IN};
            { pg8::Unit u0; if (S.next(0, u0)) {
                const f32x4* sp = (const f32x4*)((const float*)(ws + WS_SS) + ((size_t)u0.pm * 256 + (tid >> 1)) * 64 + (tid & 1) * 32); float sq = 0.f;
#pragma unroll
                for (int j = 0; j < 8; ++j) { const f32x4 q4 = sp[j]; sq += (q4.x + q4.y) + (q4.z + q4.w); }
                sq += shx(sq, 1);
                if (!(tid & 1)) ((LAS float*)(lds + RS_OFF))[tid >> 1] = 1.f / sqrtf(sq * (1.f / DM) + EPS); }
              __syncthreads(); }
            pg8::EpiIn E{(bf16*)(ws + WS_U), (bf16*)(ws + WS_ZP), (bf16*)(ws + WS_QR), (bf16*)(ws + WS_ZN), (bf16*)(ws + WS_KV6), (bf16*)(ws + WS_GM), (bf16*)(ws + WS_NG), args.in[3] + (size_t)l * 2 * DM, (const LAS float*)(lds + RS_OFF)};
            pg8::gemm_phase<pg8::EpiIn, pg8::SchedPlain, true>(lds, g, S, E, tid);
            if (G == 256 && bx >= OFF_FIRST && l + 1 < DEPTH && rep_ == 0) slack_convert(args, lds, l + 1, bx, wave, lane);
            SEAM(s0 + 1);
            PR_E(2);
        }
        if (PH_ON(3) && IN(s0 + 2)) REPS(3) {
            PR_B(3);
            LAUNDER_WS();
            CmpP C{(const bf16*)(ws + WS_KV6), args.in[8] + (size_t)l * 2 * 4096, (const bf16*)(ws + WS_W1 + l * SZ_W1), args.in[10] + (size_t)l * 2 * 128, (const bf16*)(ws + WS_W2 + l * SZ_W2),
                   args.in[7] + (size_t)l * 3 * 128, (bf16*)(ws + WS_KCN), (bf16*)(ws + WS_VCT)};
            p3_compress(C, lds, G, tid, wave, lane);
            MidP M{(const bf16*)(ws + WS_U), (const bf16*)(ws + WS_QR), (const bf16*)(ws + WS_KV6), (bf16*)(ws + WS_MP), (bf16*)(ws + WS_QN), (bf16*)(ws + WS_KSN), (bf16*)(ws + WS_KWN),
                   (bf16*)(ws + WS_VST), (bf16*)(ws + WS_VWT), args.in[6] + (size_t)l * 128, args.in[7] + (size_t)l * 3 * 128};
            p3_mid(M, lds, gw, NGW, wave, lane);
            SEAM(s0 + 2);
            PR_E(3);
        }
        if (PH_ON(4) && IN(s0 + 3)) REPS(4) {
            PR_B(4);
            LAUNDER_WS();
            {
                pg8::Gemm g{PW, 512, 512};
                pg8::SchedPool S{(const char*)(ws + WS_MP), (const char*)(ws + WS_POOLW + l * SZ_POOLW), G, bx};
                pg8::EpiPool E{(bf16*)(ws + WS_PO), (const bf16*)(ws + WS_ZP), args.in[5] + (size_t)l * PW};
                pg8::gemm_phase<pg8::EpiPool, pg8::SchedPool, false>(lds, g, S, E, tid);
            }
            __syncthreads();
            AttP A{(const bf16*)(ws + WS_QR), (const bf16*)(ws + WS_KCN), (const bf16*)(ws + WS_VCT), (const bf16*)(ws + WS_KSN), (const bf16*)(ws + WS_VST), (const bf16*)(ws + WS_KWN), (const bf16*)(ws + WS_VWT),
                   (const bf16*)(ws + WS_NG), (const bf16*)(ws + WS_ZN), (bf16*)(ws + WS_NO), (float*)(ws + WS_OST), args.in[6] + (size_t)l * 128};
#ifdef REP_ATT
            { int nra = 2; asm volatile("" : "+s"(nra));
#pragma unroll 1
              for (int ra = 0; ra < nra; ++ra) p4_attention(A, lds, G, wave, lane); }
#else
            p4_attention(A, lds, G, wave, lane);
#endif
            SEAM(s0 + 3);
            PR_E(4);
        }
        if (PH_ON(5) && IN(s0 + 4)) REPS(5) {
            PR_B(5);
            LAUNDER_WS();
            pg8::Gemm g{PW, PW, PW};
            pg8::SchedUp S{(const char*)(ws + WS_PO), (const char*)(ws + WS_NO), (const char*)(ws + WS_WPU + l * SZ_WUP), (const char*)(ws + WS_WNU + l * SZ_WUP), G, bx};
            pg8::EpiUp E{(bf16*)(ws + WS_Y), (const bf16*)(ws + WS_GM), (const bf16*)(ws + WS_GM) + (size_t)T * DM};
            pg8::gemm_phase<pg8::EpiUp, pg8::SchedUp, true>(lds, g, S, E, tid);
            SEAM(s0 + 4);
            PR_E(5);
        }
        if (PH_ON(6) && IN(s0 + 5)) REPS(6) {
            PR_B(6);
            LAUNDER_WS();
            pg8::Gemm g{DM, DM, DM};
            pg8::SchedPlain S{(const char*)(ws + WS_Y), (const char*)(ws + WS_WOUT + l * SZ_WOUT), 32, 16, G, bx, (size_t)256 * DM * 2, (size_t)256 * DM * 2, WGM_OUT};
            const bool dry = (REP_PH == 6 && rep_ == 0);
            pg8::EpiOut E{args.in[0], (const bf16*)(ws + WS_H), (bf16*)(ws + (dry ? WS_GM : WS_H)), (float*)(ws + (dry ? WS_GM + ((size_t)T * DM * 2) : WS_SS)), dry ? (float*)(ws + WS_GM) : args.out, l == 0 ? 0 : (l == DEPTH - 1 ? 2 : 1)};
            pg8::gemm_phase<pg8::EpiOut, pg8::SchedPlain, true>(lds, g, S, E, tid);
            SEAM(s0 + 5);
            PR_E(6);
        }
    }
#ifdef PROBE_PH
    xcd_barrier(bar);
    if (blockIdx.x == 0 && threadIdx.x == 0) args.out[0] = (float)pr_acc * 0.01f;
#endif
#undef IN
#undef SEAM
}

extern "C" void kernel_launch(void* const* d_in, const int* in_sizes, int n_in, void* d_out, int out_size, void* d_ws, size_t ws_size, hipStream_t stream) {
    static int grid = 0;
    if (grid == 0) {
        if (n_in != 15 || out_size != T * DM || ws_size < WS_END) { fprintf(stderr, "kernel_launch: unexpected shapes (n_in %d out %d ws %zu need %zu)\n", n_in, out_size, ws_size, (size_t)WS_END); grid = -1; return; }
        int dev = 0, cus = 0, per_cu = 0;
        if (hipGetDevice(&dev) != hipSuccess || hipDeviceGetAttribute(&cus, hipDeviceAttributeMultiprocessorCount, dev) != hipSuccess) { grid = -1; return; }
        if (hipFuncSetAttribute((const void*)mega_fwd, hipFuncAttributeMaxDynamicSharedMemorySize, LDS_BYTES) != hipSuccess) { fprintf(stderr, "kernel_launch: hipFuncSetAttribute failed\n"); grid = -1; return; }
        if (hipOccupancyMaxActiveBlocksPerMultiprocessor(&per_cu, (const void*)mega_fwd, NTHR, LDS_BYTES) != hipSuccess || per_cu < 1) { fprintf(stderr, "kernel_launch: occupancy query says %d\n", per_cu); }
        (void)hipGetLastError();
        grid = cus;
    }
    if (grid < 0) return;
    (void)hipMemsetAsync((char*)d_ws + WS_CTL, 0, CTL_ZERO_BYTES, stream);
    Args a{};
    for (int i = 0; i < 15; ++i) a.in[i] = (const float*)d_in[i];
    a.out = (float*)d_out; a.ws = (unsigned char*)d_ws;
    constexpr int NSTEP = 1 + 6 * DEPTH;
#if MK_MULTI
    for (int s = 0; s < NSTEP; ++s) { a.st_lo = s; a.st_hi = s + 1; hipLaunchKernelGGL(mega_fwd, dim3(grid), dim3(NTHR), LDS_BYTES, stream, a); }
#else
    a.st_lo = 0; a.st_hi = NSTEP;
    hipLaunchKernelGGL(mega_fwd, dim3(grid), dim3(NTHR), LDS_BYTES, stream, a);
#endif
    const hipError_t le = hipPeekAtLastError();
    if (le != hipSuccess) fprintf(stderr, "kernel_launch: launch failed: %s\n", hipGetErrorName(le));
}
```

```cpp
#include <hip/hip_runtime.h>
#include <cstdio>
#include <cstdint>

#ifndef WGM_IN
#define WGM_IN 4
#endif
#ifndef WGM_UP
#define WGM_UP 2
#endif
#ifndef WGM_OUT
#define WGM_OUT 2
#endif
#ifndef MK_MULTI
#define MK_MULTI 0
#endif

#define DI __device__ __forceinline__
#define GAS __attribute__((address_space(1)))
#define LAS __attribute__((address_space(3)))
typedef unsigned short bf16;
typedef short bf16x8 __attribute__((ext_vector_type(8)));
typedef float f32x2 __attribute__((ext_vector_type(2)));
typedef float f32x4 __attribute__((ext_vector_type(4)));
typedef float f32x16 __attribute__((ext_vector_type(16)));
typedef unsigned u32x2 __attribute__((ext_vector_type(2)));
typedef unsigned u32x4 __attribute__((ext_vector_type(4)));
typedef __bf16 bf16x2_t __attribute__((ext_vector_type(2)));
typedef GAS unsigned gu32;

constexpr int T = 8192, DM = 4096, PW = 2048, NSAW = 2048, KVW = 512, HD = 128, NQH = 16, NKVH = 4, DEPTH = 4;
constexpr int NIN = 19504, NPAD = 19712, NINT = NPAD / 256;
constexpr int KV6W = 3072;
constexpr int NCP = 512;
constexpr float EPS = 1e-6f, NEG = -1e30f, LOG2E = 1.4426950408889634f;
constexpr int NWAVES = 8, NTHR = 512;

constexpr size_t al256(size_t x) { return (x + 255) & ~(size_t)255; }
constexpr size_t WS_CTL = 0, CTL_ZERO_BYTES = 65536;
constexpr size_t SZ_WIN = (size_t)NPAD * DM * 2, SZ_POOLW = (size_t)4 * 512 * 512 * 2, SZ_WUP = (size_t)DM * PW * 2, SZ_WOUT = (size_t)DM * DM * 2;
constexpr size_t SZ_W1 = (size_t)2 * 128 * 4096 * 2, SZ_W2 = (size_t)2 * 128 * 128 * 2;
constexpr size_t WS_WIN = 1u << 20;
constexpr size_t WS_POOLW = WS_WIN + DEPTH * SZ_WIN;
constexpr size_t WS_WPU = WS_POOLW + DEPTH * SZ_POOLW;
constexpr size_t WS_WNU = WS_WPU + DEPTH * SZ_WUP;
constexpr size_t WS_WOUT = WS_WNU + DEPTH * SZ_WUP;
constexpr size_t WS_W1 = WS_WOUT + DEPTH * SZ_WOUT;
constexpr size_t WS_W2 = WS_W1 + DEPTH * SZ_W1;
constexpr size_t WS_H = WS_W2 + DEPTH * SZ_W2;
constexpr size_t WS_U = WS_H + (size_t)T * DM * 2;
constexpr size_t WS_ZP = WS_U + (size_t)T * PW * 2;
constexpr size_t WS_QR = WS_ZP + (size_t)T * PW * 2;
constexpr size_t WS_ZN = WS_QR + (size_t)T * NSAW * 2;
constexpr size_t WS_KV6 = WS_ZN + (size_t)T * NSAW * 2;
constexpr size_t WS_GM = WS_KV6 + (size_t)T * KV6W * 2;
constexpr size_t WS_NG = WS_GM + (size_t)T * 8192 * 2;
constexpr size_t WS_MP = WS_NG + (size_t)T * 256 * 2;
constexpr size_t WS_QN = WS_MP + (size_t)T * PW * 2;
constexpr size_t WS_KSN = WS_QN + (size_t)T * NSAW * 2;
constexpr size_t WS_KWN = WS_KSN + (size_t)4 * T * 128 * 2;
constexpr size_t WS_VST = WS_KWN + (size_t)4 * T * 128 * 2;
constexpr size_t WS_VWT = WS_VST + (size_t)4 * T * 128 * 2;
constexpr size_t WS_KCN = WS_VWT + (size_t)4 * T * 128 * 2;
constexpr size_t WS_VCT = WS_KCN + (size_t)4 * NCP * 128 * 2;
constexpr size_t WS_PO = WS_VCT + (size_t)4 * NCP * 128 * 2;
constexpr size_t WS_NO = WS_PO + (size_t)T * PW * 2;
constexpr size_t WS_Y = WS_NO + (size_t)T * NSAW * 2;
constexpr size_t WS_OST = WS_Y + (size_t)T * DM * 2;
static_assert(WS_ZP == WS_U + (size_t)T * PW * 2 && WS_QR == WS_ZP + (size_t)T * PW * 2 && WS_ZN == WS_QR + (size_t)T * NSAW * 2, "U | ZP | QR | ZN consecutive");
constexpr size_t WS_SS = WS_OST + (size_t)T * NSAW * 4;
constexpr size_t WS_END = WS_SS + (size_t)T * 64 * 4;
constexpr int CW_BAR = 4096;

constexpr int RING_BYTES = 131072, LDSCTL_OFF = 140288  , MISC_OFF = LDSCTL_OFF + 320, SELW_OFF = LDSCTL_OFF + 2048, LDS_BYTES = 147456, RS_OFF = RING_BYTES  ;

#define RLX_AGENT __ATOMIC_RELAXED, __HIP_MEMORY_SCOPE_AGENT
#define LDS_WAIT() asm volatile("s_waitcnt lgkmcnt(0)" ::: "memory")
DI unsigned f2bf(float f) { unsigned u = __builtin_bit_cast(unsigned, f); return (u + 0x7fffu + ((u >> 16) & 1u)) >> 16; }
DI unsigned pk2(float lo, float hi) { f32x2 v = {lo, hi}; bf16x2_t b = __builtin_convertvector(v, bf16x2_t); return __builtin_bit_cast(unsigned, b); }
DI float bflo(unsigned u) { return __builtin_bit_cast(float, u << 16); }
DI float bfhi(unsigned u) { return __builtin_bit_cast(float, u & 0xffff0000u); }
DI float ex2(float x) { return __builtin_amdgcn_exp2f(x); }
DI float rcpf(float x) { return __builtin_amdgcn_rcpf(x); }
DI float sigm(float v) { return rcpf(1.f + ex2(-v * LOG2E)); }
DI float shx(float v, int mask) {
    int ln; asm volatile("v_mbcnt_lo_u32_b32 %0, -1, 0\n\tv_mbcnt_hi_u32_b32 %0, -1, %0" : "=v"(ln));
    return __builtin_bit_cast(float, __builtin_amdgcn_ds_bpermute((ln ^ mask) << 2, __builtin_bit_cast(int, v)));
}
DI float wave_sum(float v) {
#pragma unroll
    for (int o = 1; o < 64; o <<= 1) v += shx(v, o);
    return v;
}
DI float sum16(float v) {
#pragma unroll
    for (int o = 1; o < 16; o <<= 1) v += shx(v, o);
    return v;
}
DI void unpack8(const u32x4 w, float (&f)[8]) {
    f[0] = bflo(w.x); f[1] = bfhi(w.x); f[2] = bflo(w.y); f[3] = bfhi(w.y); f[4] = bflo(w.z); f[5] = bfhi(w.z); f[6] = bflo(w.w); f[7] = bfhi(w.w);
}
DI u32x4 pack8(const float (&f)[8]) { u32x4 w; w.x = pk2(f[0], f[1]); w.y = pk2(f[2], f[3]); w.z = pk2(f[4], f[5]); w.w = pk2(f[6], f[7]); return w; }

namespace pg8 {
typedef unsigned short bf16_t;
constexpr int BM = 256, BK = 64, HALF = 128, HTB = HALF * BK * 2, NXCD = 8;
DI int lds_byte(int r, int c) { const int st = (r >> 4) * 2 + (c >> 5), rr = r & 15, cc = c & 31, ob = rr * 64 + cc * 2; return st * 1024 + (ob ^ (((ob >> 9) & 1) << 5)); }
DI void stage_rc(int b, int& R, int& C) { const int st = b / 1024, sb = b % 1024, swz = sb ^ (((sb >> 9) & 1) << 5); R = (st >> 1) * 16 + swz / 64; C = (st & 1) * 32 + (swz % 64) / 2; }
DI int perm32(int rho) { const int n = rho >> 4, i = rho & 15; return 8 * (i >> 2) + 4 * n + (i & 3); }

struct Unit { int pm, pn, aux; const char* a; const char* b; };
struct Gemm { int lda, ldb, K; };

DI void tile_of(int L, int nM, int nN, int& pm, int& pn, const int WGM) {
    const int nwg = nM * nN; int wgid = L;
    { const int q = nwg / NXCD, r = nwg % NXCD, xcd = wgid % NXCD, off = wgid / NXCD; wgid = (xcd < r ? xcd * (q + 1) : r * (q + 1) + (xcd - r) * q) + off; }
    const int nig = WGM * nN, gid = wgid / nig, fm = gid * WGM, gsz = (nM - fm) < WGM ? (nM - fm) : WGM;
    pm = fm + ((wgid % nig) % gsz); pn = (wgid % nig) / gsz;
}

template <class Epi, class Sched, bool ALIGN_EPI>
DI void gemm_phase(LAS unsigned char* lds, const Gemm g, const Sched& S, const Epi& E, const int tid) {
    const int wid = __builtin_amdgcn_readfirstlane(tid >> 6), lane = tid & 63, wr = wid >> 2, wc = wid & 3, fr = lane & 15, fq = lane >> 4;
    const int K = g.K, nt = K / BK;
    unsigned voffA[2], voffB[2];
#pragma unroll
    for (int i = 0; i < 2; ++i) { int R, C; stage_rc(tid * 16 + i * 8192, R, C); const int Rb = Epi::PERM ? (((R >> 5) * 64) + perm32(R & 31)) : R;
        voffA[i] = (unsigned)(R * g.lda + C) * 2u; voffB[i] = (unsigned)(Rb * g.ldb + C) * 2u; }
    const size_t kstep = (size_t)(BK * 2);
    const size_t hsA = (size_t)HALF * g.lda * 2, hsB = (size_t)(Epi::PERM ? 32 : HALF) * g.ldb * 2;
    const unsigned ldsw = (unsigned)wid * 1024u;
    const int aoff = lds_byte(wr * 64 + fr, fq * 8), boff = lds_byte(wc * 32 + fr, fq * 8);
#define PG8_SA(b, h) (((b) * 2 + (h)) * HTB)
#define PG8_SB(b, h) ((4 + (b) * 2 + (h)) * HTB)
#define PG8_STAGE(bufoff, gbase, voff) do { _Pragma("unroll") for (int _i = 0; _i < 2; ++_i) \
        __builtin_amdgcn_global_load_lds((const unsigned*)((const char*)(gbase) + (voff)[_i]), (LAS unsigned*)(lds + (bufoff) + ldsw + _i * 8192), 16, 0, 0); } while (0)
#define PG8_LDA(dst, b, h) do { _Pragma("unroll") for (int m = 0; m < 4; ++m) _Pragma("unroll") for (int k = 0; k < 2; ++k) dst[m][k] = *(const LAS bf16x8*)(lds + PG8_SA(b, h) + aoff + m * 2048 + k * 1024); } while (0)
#define PG8_LDB(dst, b, h) do { _Pragma("unroll") for (int n = 0; n < 2; ++n) _Pragma("unroll") for (int k = 0; k < 2; ++k) dst[n][k] = *(const LAS bf16x8*)(lds + PG8_SB(b, h) + boff + n * 2048 + k * 1024); } while (0)
#define PG8_MMA(ai, bj, At, Bt) do { __builtin_amdgcn_s_setprio(1); _Pragma("unroll") for (int m = 0; m < 4; ++m) _Pragma("unroll") for (int n = 0; n < 2; ++n) _Pragma("unroll") for (int k = 0; k < 2; ++k) \
        acc[ai][bj][m][n] = __builtin_amdgcn_mfma_f32_16x16x32_bf16(Bt[n][k], At[m][k], acc[ai][bj][m][n], 0, 0, 0); __builtin_amdgcn_s_setprio(0); } while (0)
#define PG8_WAIT_V(n) asm volatile("s_waitcnt vmcnt(" #n ")" ::: "memory")
#define PG8_WAIT_L(n) asm volatile("s_waitcnt lgkmcnt(" #n ")" ::: "memory")
#define PG8_BAR __builtin_amdgcn_s_barrier()
#define PG8_SCHED __builtin_amdgcn_sched_barrier(0)
    Unit cur, nxt; int ui = 0;
    if (!S.next(0, cur)) return;
    f32x4 acc[2][2][4][2];
#pragma unroll
    for (int a = 0; a < 2; ++a)
#pragma unroll
        for (int b = 0; b < 2; ++b)
#pragma unroll
            for (int m = 0; m < 4; ++m)
#pragma unroll
                for (int n = 0; n < 2; ++n) acc[a][b][m][n] = (f32x4){0.f, 0.f, 0.f, 0.f};
    bf16x8 At[4][2], B0[2][2], B1[2][2];
    const char* cA = cur.a; const char* cB = cur.b;
    PG8_STAGE(PG8_SB(0, 0), cB, voffB); PG8_STAGE(PG8_SB(0, 1), cB + hsB, voffB); PG8_STAGE(PG8_SA(0, 0), cA, voffA); PG8_STAGE(PG8_SA(0, 1), cA + hsA, voffA);
    if (wr == 1) PG8_BAR;
    PG8_WAIT_V(2); PG8_BAR;
    PG8_STAGE(PG8_SB(1, 0), cB + kstep, voffB); PG8_STAGE(PG8_SA(1, 0), cA + kstep, voffA); PG8_STAGE(PG8_SB(1, 1), cB + hsB + kstep, voffB);
    PG8_WAIT_V(6); PG8_BAR;
    for (;;) {
        const bool has_next = S.next(ui + 1, nxt);
        const char* nA = has_next ? nxt.a : cA; const char* nB = has_next ? nxt.b : cB;
        for (int t = 0; t < nt; t += 2) {
            const bool last = (t == nt - 2);
            const char* a1 = cA + (size_t)(t + 1) * kstep;
            const char* a2 = last ? nA : cA + (size_t)(t + 2) * kstep; const char* b2 = last ? nB : cB + (size_t)(t + 2) * kstep;
            const char* a3 = a2 + kstep; const char* b3 = b2 + kstep;
            PG8_LDB(B0, 0, 0); PG8_LDB(B1, 0, 1); PG8_SCHED; PG8_LDA(At, 0, 0); PG8_STAGE(PG8_SA(1, 1), a1 + hsA, voffA);
            PG8_WAIT_V(8); PG8_WAIT_L(0); PG8_BAR; PG8_MMA(0, 0, At, B0); PG8_MMA(0, 1, At, B1); PG8_BAR; PG8_SCHED;
            PG8_LDA(At, 0, 1); PG8_STAGE(PG8_SB(0, 0), b2, voffB); PG8_STAGE(PG8_SB(0, 1), b2 + hsB, voffB); PG8_STAGE(PG8_SA(0, 0), a2, voffA);
            PG8_WAIT_V(8); PG8_WAIT_L(0); PG8_BAR; PG8_MMA(1, 0, At, B0); PG8_MMA(1, 1, At, B1); PG8_BAR; PG8_SCHED;
            PG8_LDB(B0, 1, 0); PG8_LDB(B1, 1, 1); PG8_SCHED; PG8_LDA(At, 1, 0); PG8_STAGE(PG8_SA(0, 1), a2 + hsA, voffA);
            PG8_WAIT_V(8); PG8_WAIT_L(0); PG8_BAR; PG8_MMA(0, 0, At, B0); PG8_MMA(0, 1, At, B1); PG8_BAR; PG8_SCHED;
            PG8_LDA(At, 1, 1); PG8_STAGE(PG8_SB(1, 0), b3, voffB); PG8_STAGE(PG8_SB(1, 1), b3 + hsB, voffB); PG8_STAGE(PG8_SA(1, 0), a3, voffA);
            PG8_WAIT_V(8); PG8_WAIT_L(0); PG8_BAR; PG8_MMA(1, 0, At, B0); PG8_MMA(1, 1, At, B1); PG8_BAR; PG8_SCHED;
        }
        if constexpr (ALIGN_EPI) { if (wr == 0) PG8_BAR; }
        E(acc, cur, wr, wc, fr, fq);
        if (!has_next) break;
        if (!(Epi::CHAIN && cur.aux == 0)) {
#pragma unroll
        for (int a = 0; a < 2; ++a)
#pragma unroll
            for (int b = 0; b < 2; ++b)
#pragma unroll
                for (int m = 0; m < 4; ++m)
#pragma unroll
                    for (int n = 0; n < 2; ++n) acc[a][b][m][n] = (f32x4){0.f, 0.f, 0.f, 0.f};
        }
        cur = nxt; cA = nA; cB = nB; ++ui;
        if constexpr (ALIGN_EPI) { if (wr == 1) PG8_BAR; }
    }
    PG8_WAIT_V(0);
    if constexpr (!ALIGN_EPI) { if (wr == 0) PG8_BAR; }
    PG8_BAR;
#undef PG8_SA
#undef PG8_SB
#undef PG8_STAGE
#undef PG8_LDA
#undef PG8_LDB
#undef PG8_MMA
#undef PG8_WAIT_V
#undef PG8_WAIT_L
#undef PG8_BAR
#undef PG8_SCHED
}

struct SchedPlain {
    const char* A; const char* B; int nM, nN, G, c; size_t ta, tb; int wgm;
    DI bool next(int i, Unit& u) const { const long L = (long)i * G + c; if (L >= (long)nM * nN) return false; tile_of((int)L, nM, nN, u.pm, u.pn, wgm); u.aux = 0; u.a = A + (size_t)u.pm * ta; u.b = B + (size_t)u.pn * tb; return true; }
};
struct SchedPool {
    const char* A; const char* B; int G, c;
    DI bool next(int i, Unit& u) const { const int L = i * G + c; if (L >= 256) return false; u.pm = L >> 3; u.pn = L & 7; u.aux = 0; const int grp = u.pn >> 1, half = u.pn & 1;
        u.a = A + ((size_t)u.pm * 256 * PW + (size_t)grp * 512) * 2; u.b = B + ((size_t)grp * 512 * 512 + (size_t)half * 256 * 512) * 2; return true; }
};
struct SchedUp {
    const char* A0; const char* A1; const char* B0; const char* B1; int G, c;
    DI bool next(int i, Unit& u) const { const long L = (long)(i >> 1) * G + c; if (L >= 32 * 16) return false; tile_of((int)L, 32, 16, u.pm, u.pn, WGM_UP); u.aux = i & 1;
        u.a = (u.aux ? A1 : A0) + (size_t)u.pm * 256 * PW * 2; u.b = (u.aux ? B1 : B0) + (size_t)u.pn * 256 * PW * 2; return true; }
};

struct EpiIn {
    static constexpr bool PERM = true, CHAIN = false;
    bf16_t *U, *ZP, *QR, *ZN, *KV6, *GM, *NG; const float* mbias; const LAS float* rs;
    DI void operator()(f32x4 (&acc)[2][2][4][2], const Unit& u, int wr, int wc, int fr, int fq) const {
        const int pn = u.pn; bf16_t* base; int ldc, colt, mode;
        if (pn < 32) { base = U + (size_t)(pn >> 3) * T * PW; ldc = PW; colt = (pn & 7) * 256; mode = (pn >> 3) & 1; }
        else if (pn < 44) { base = KV6; ldc = KV6W; colt = (pn - 32) * 256; mode = 0; }
        else if (pn < 76) { base = GM; ldc = DM; colt = 0; mode = 2; }
        else { base = NG; ldc = 256; colt = 0; mode = 3; }
        const int row0 = u.pm * BM + wr * 64 + fr, col0 = colt + wc * 64 + 8 * fq;
        if (mode == 2) {
            const int ch0 = (pn - 44) * 128 + wc * 32 + 8 * fq;
            f32x4 b0[2], b1[2];
#pragma unroll
            for (int n = 0; n < 2; ++n) { b0[n] = *(const f32x4*)(mbias + ch0 + 4 * n); b1[n] = *(const f32x4*)(mbias + DM + ch0 + 4 * n); }
#pragma unroll
            for (int ai = 0; ai < 2; ++ai)
#pragma unroll
                for (int m = 0; m < 4; ++m) { const size_t ro = (size_t)(row0 + ai * HALF + m * 16) * DM + ch0; const float rr = rs[wr * 64 + fr + ai * HALF + m * 16];
                    const f32x4 a00 = acc[ai][0][m][0] * rr + b0[0], a01 = acc[ai][0][m][1] * rr + b0[1], a10 = acc[ai][1][m][0] * rr + b1[0], a11 = acc[ai][1][m][1] * rr + b1[1];
                    f32x4 r0, r1, g10, g11;
#pragma unroll
                    for (int e = 0; e < 4; ++e) { const float e00 = fminf(ex2(-a00[e] * LOG2E), 1e30f), e01 = fminf(ex2(-a01[e] * LOG2E), 1e30f), e10 = fminf(ex2(-a10[e] * LOG2E), 1e30f), e11 = fminf(ex2(-a11[e] * LOG2E), 1e30f);
                        g10[e] = rcpf(1.f + e10); g11[e] = rcpf(1.f + e11); r0[e] = rcpf(1.f + e00) * (1.f + e10); r1[e] = rcpf(1.f + e01) * (1.f + e11); }
                    u32x4 rw, gw;
                    rw.x = pk2(r0.x, r0.y); rw.y = pk2(r0.z, r0.w); rw.z = pk2(r1.x, r1.y); rw.w = pk2(r1.z, r1.w);
                    gw.x = pk2(g10.x, g10.y); gw.y = pk2(g10.z, g10.w); gw.z = pk2(g11.x, g11.y); gw.w = pk2(g11.z, g11.w);
                    *(u32x4*)(GM + ro) = rw; *(u32x4*)(GM + (size_t)T * DM + ro) = gw; }
            return; }
#pragma unroll
        for (int ai = 0; ai < 2; ++ai)
#pragma unroll
            for (int m = 0; m < 4; ++m) { bf16_t* rowp = base + (size_t)(row0 + ai * HALF + m * 16) * ldc + col0; const float rr = rs[wr * 64 + fr + ai * HALF + m * 16];
#pragma unroll
                for (int bj = 0; bj < 2; ++bj) { f32x4 v0 = acc[ai][bj][m][0] * rr, v1 = acc[ai][bj][m][1] * rr;
                    if (mode != 0) {
#pragma unroll
                        for (int e = 0; e < 4; ++e) { const float s0 = sigm(v0[e]), s1 = sigm(v1[e]); v0[e] = (mode == 1) ? v0[e] * s0 : s0; v1[e] = (mode == 1) ? v1[e] * s1 : s1; }
                    }
                    u32x4 w; w.x = pk2(v0[0], v0[1]); w.y = pk2(v0[2], v0[3]); w.z = pk2(v1[0], v1[1]); w.w = pk2(v1[2], v1[3]);
                    *(u32x4*)(rowp + bj * 32) = w; } }
    }
};
struct EpiPool {
    static constexpr bool PERM = true, CHAIN = false;
    bf16_t* O; const bf16_t* ZP; const float* scale;
    DI void operator()(f32x4 (&acc)[2][2][4][2], const Unit& u, int wr, int wc, int fr, int fq) const {
        const int row0 = u.pm * BM + wr * 64 + fr, col0 = u.pn * BM + wc * 64 + 8 * fq;
        f32x4 sv[2][2];
#pragma unroll
        for (int bj = 0; bj < 2; ++bj)
#pragma unroll
            for (int n = 0; n < 2; ++n) sv[bj][n] = *(const f32x4*)(scale + col0 + bj * 32 + 4 * n);
#pragma unroll
        for (int ai = 0; ai < 2; ++ai)
#pragma unroll
            for (int m = 0; m < 4; ++m) { const size_t ro = (size_t)(row0 + ai * HALF + m * 16) * PW + col0;
#pragma unroll
                for (int bj = 0; bj < 2; ++bj) { const u32x4 z = *(const u32x4*)(ZP + ro + bj * 32); float zf[8]; unpack8(z, zf);
                    const f32x4 v0 = acc[ai][bj][m][0] * sv[bj][0], v1 = acc[ai][bj][m][1] * sv[bj][1];
                    u32x4 w; w.x = pk2(v0[0] * zf[0], v0[1] * zf[1]); w.y = pk2(v0[2] * zf[2], v0[3] * zf[3]); w.z = pk2(v1[0] * zf[4], v1[1] * zf[5]); w.w = pk2(v1[2] * zf[6], v1[3] * zf[7]);
                    *(u32x4*)(O + ro + bj * 32) = w; } }
    }
};
struct EpiUp {
    static constexpr bool PERM = true, CHAIN = true;
    bf16_t* Y; const bf16_t* R; const bf16_t* G1;
    DI void operator()(f32x4 (&acc)[2][2][4][2], const Unit& u, int wr, int wc, int fr, int fq) const {
        const int row0 = u.pm * BM + wr * 64 + fr, col0 = u.pn * BM + wc * 64 + 8 * fq; const int which = u.aux; const bf16_t* gsrc = which ? G1 : R;
#pragma unroll
        for (int ai = 0; ai < 2; ++ai)
#pragma unroll
            for (int m = 0; m < 4; ++m) { const int row = row0 + ai * HALF + m * 16;
#pragma unroll
                for (int bj = 0; bj < 2; ++bj) { const int col = col0 + bj * 32;
                    const u32x4 gw = *(const u32x4*)(gsrc + (size_t)row * DM + col); float g[8]; unpack8(gw, g);
                    if (which == 0) {
#pragma unroll
                        for (int e = 0; e < 4; ++e) { acc[ai][bj][m][0][e] *= g[e]; acc[ai][bj][m][1][e] *= g[4 + e]; }
                    } else {
                        const f32x4 v0 = acc[ai][bj][m][0], v1 = acc[ai][bj][m][1];
                        u32x4 w; w.x = pk2(v0[0] * g[0], v0[1] * g[1]); w.y = pk2(v0[2] * g[2], v0[3] * g[3]); w.z = pk2(v1[0] * g[4], v1[1] * g[5]); w.w = pk2(v1[2] * g[6], v1[3] * g[7]);
                        *(u32x4*)(Y + (size_t)row * DM + col) = w; } } }
    }
};
struct EpiOut {
    static constexpr bool PERM = true, CHAIN = false;
    const float* X0; const bf16_t* XS; bf16_t* XD; float* SS; float* O; int mode;
    DI void operator()(f32x4 (&acc)[2][2][4][2], const Unit& u, int wr, int wc, int fr, int fq) const {
        const int row0 = u.pm * BM + wr * 64 + fr, col0 = u.pn * BM + wc * 64 + 8 * fq;
#pragma unroll
        for (int ai = 0; ai < 2; ++ai)
#pragma unroll
            for (int m = 0; m < 4; ++m) { const int row = row0 + ai * HALF + m * 16; const size_t ro = (size_t)row * DM + col0; float s = 0.f;
#pragma unroll
                for (int bj = 0; bj < 2; ++bj) { f32x4 v0, v1;
                    if (mode == 0) { v0 = *(const f32x4*)(X0 + ro + bj * 32); v1 = *(const f32x4*)(X0 + ro + bj * 32 + 4); }
                    else { const u32x4 xw = *(const u32x4*)(XS + ro + bj * 32); v0 = (f32x4){bflo(xw.x), bfhi(xw.x), bflo(xw.y), bfhi(xw.y)}; v1 = (f32x4){bflo(xw.z), bfhi(xw.z), bflo(xw.w), bfhi(xw.w)}; }
                    v0 += acc[ai][bj][m][0]; v1 += acc[ai][bj][m][1];
                    if (mode == 2) { *(f32x4*)(O + ro + bj * 32) = v0; *(f32x4*)(O + ro + bj * 32 + 4) = v1; }
                    else { u32x4 w; w.x = pk2(v0[0], v0[1]); w.y = pk2(v0[2], v0[3]); w.z = pk2(v1[0], v1[1]); w.w = pk2(v1[2], v1[3]); *(u32x4*)(XD + ro + bj * 32) = w;
                        s += (v0[0] * v0[0] + v0[1] * v0[1]) + (v0[2] * v0[2] + v0[3] * v0[3]) + (v1[0] * v1[0] + v1[1] * v1[1]) + (v1[2] * v1[2] + v1[3] * v1[3]); } }
                if (mode != 2) { s += shx(s, 16); s += shx(s, 32); if (fq == 0) SS[(size_t)row * 64 + u.pn * 4 + wc] = s; } }
    }
};
}

#define XB_TMO      128
#define XB_XCNT(j)  (256  + 64 * (j))
#define XB_XSUB(j)  (1280 + 64 * (j))
#define XB_XGEN(j)  (2304 + 64 * (j))
#define XB_TOP      3328
#define XB_TOPGEN   3392
#define XCD_BAR_WORDS 3456
#define XB_SPIN_CAP (1u << 22)
DI unsigned xb_ld(unsigned* p)              { return __hip_atomic_load(p, __ATOMIC_RELAXED, __HIP_MEMORY_SCOPE_AGENT); }
DI unsigned xb_add(unsigned* p, unsigned v) { return __hip_atomic_fetch_add(p, v, __ATOMIC_RELAXED, __HIP_MEMORY_SCOPE_AGENT); }
DI unsigned xb_xcc_id() { return (unsigned)__builtin_amdgcn_s_getreg((3 << 11) | 20) & 0xFu; }
#define XB_SPIN(cond, bar) do { unsigned _sp = 0; while (cond) { __builtin_amdgcn_s_sleep(1); \
    if ((++_sp & 255u) == 0u) { if (xb_ld(&(bar)[XB_TMO])) break; if (_sp > XB_SPIN_CAP) { atomicAdd(&(bar)[XB_TMO], 1u); break; } } } } while (0)
struct XcdBarrier { unsigned* bar; unsigned x; volatile LAS unsigned* st; };
DI XcdBarrier xcd_barrier_post(unsigned* bar, volatile LAS unsigned* st) {
    XcdBarrier b; b.bar = bar; b.x = xb_xcc_id(); b.st = st;
    if (threadIdx.x == 0) (void)xb_add(&bar[XB_XCNT(b.x)], 1u);
    return b;
}
DI void xcd_barrier_complete(unsigned* bar, unsigned x, unsigned& nloc, unsigned& nx) {
    const unsigned G = gridDim.x * gridDim.y * gridDim.z;
    unsigned sum, cnt, mine, sp = 0u;
    for (;;) {
        sum = 0u; cnt = 0u; mine = 0u;
#pragma unroll
        for (unsigned j = 0; j < 16; ++j) { const unsigned c = xb_ld(&bar[XB_XCNT(j)]); sum += c; cnt += (c > 0u) ? 1u : 0u; mine = (j == x) ? c : mine; }
        if (sum == G) break;
        __builtin_amdgcn_s_sleep(1);
        if ((++sp & 255u) == 0u) { if (xb_ld(&bar[XB_TMO])) break; if (sp > XB_SPIN_CAP) { atomicAdd(&bar[XB_TMO], 1u); break; } }
    }
    nloc = mine > 0u ? mine : 1u; nx = cnt > 0u ? cnt : 1u;
}
DI void xcd_barrier(const XcdBarrier& b) {
    asm volatile("s_waitcnt vmcnt(0)" ::: "memory");
    __syncthreads();
    if (threadIdx.x == 0) {
        unsigned* bar = b.bar;
        __builtin_amdgcn_s_waitcnt(0);
        unsigned nloc = b.st[0], nx = b.st[1];
        if (nloc == 0u) { xcd_barrier_complete(bar, b.x, nloc, nx); b.st[0] = nloc; b.st[1] = nx; }
        const unsigned old = xb_add(&bar[XB_XSUB(b.x)], 1u);
        const unsigned gen = old / nloc;
        if (old + 1u == (gen + 1u) * nloc) {
            __builtin_amdgcn_fence(__ATOMIC_RELEASE, "agent");
            asm volatile("s_waitcnt vmcnt(0)" ::: "memory");
            const unsigned og = xb_add(&bar[XB_TOP], 1u);
            const unsigned tg = og / nx;
            if (og + 1u == (tg + 1u) * nx) xb_add(&bar[XB_TOPGEN], 1u);
            else XB_SPIN(xb_ld(&bar[XB_TOPGEN]) == tg, bar);
            __builtin_amdgcn_fence(__ATOMIC_ACQUIRE, "agent");
            xb_add(&bar[XB_XGEN(b.x)], 1u);
            asm volatile("s_waitcnt vmcnt(0)" ::: "memory");
        } else {
            XB_SPIN(xb_ld(&bar[XB_XGEN(b.x)]) == gen, bar);
            __builtin_amdgcn_fence(__ATOMIC_ACQUIRE, "agent");
            asm volatile("s_waitcnt vmcnt(0)" ::: "memory");
        }
    }
    __syncthreads();
}

struct Args { const float* in[15]; float* out; unsigned char* ws; int st_lo, st_hi; };

template <bool NT> DI void tr_item(const float* src, size_t pitch, int scol, bf16* dst, size_t dpitch, LAS float* scr, int lane, const float* gk  , int w1c0 = -1  , int w1k0 = 0) {
    f32x4 v[16]; const int kr = lane >> 4, c4 = (lane & 15) * 4;
#pragma unroll
    for (int i = 0; i < 16; ++i) { const f32x4* p_ = (const f32x4*)(src + (size_t)(4 * i + kr) * pitch + scol); v[i] = (scol >= 0) ? (NT ? __builtin_nontemporal_load(p_) : *p_) : (f32x4){0.f, 0.f, 0.f, 0.f}; }
#pragma unroll
    for (int i = 0; i < 16; ++i) { if (gk) v[i] *= gk[4 * i + kr]; LAS float* p = scr + (4 * i + kr) * 65 + c4; p[0] = v[i].x; p[1] = v[i].y; p[2] = v[i].z; p[3] = v[i].w; }
    LDS_WAIT(); asm volatile("" ::: "memory");
    const int c = lane & 7;
#pragma unroll
    for (int j = 0; j < 8; ++j) { const int n = (lane >> 3) + 8 * j; const LAS float* s = scr + (8 * c) * 65 + n;
        u32x4 o; o.x = pk2(s[0 * 65], s[1 * 65]); o.y = pk2(s[2 * 65], s[3 * 65]); o.z = pk2(s[4 * 65], s[5 * 65]); o.w = pk2(s[6 * 65], s[7 * 65]);
        if (w1c0 < 0) { if (NT) __builtin_nontemporal_store(o, (u32x4*)(dst + (size_t)n * dpitch + 8 * c)); else *(u32x4*)(dst + (size_t)n * dpitch + 8 * c) = o; }
        else { const int cc = w1c0 + n, k = w1k0 + 8 * c; *(u32x4*)(dst + ((size_t)(((k >> 5) * 8 + (cc >> 4)) * 64 + ((k >> 3) & 3) * 16 + (cc & 15))) * 8) = o; } }
    LDS_WAIT(); asm volatile("" ::: "memory");
}
constexpr int I_IN = 64 * (NPAD / 64), I_POOL = 4 * 8 * 8, I_UP = 32 * 64, I_OUT = 64 * 64, I_W1 = 2 * 64 * 2, I_W2 = 2 * 2 * 2;
constexpr int I_LAYER = I_IN + I_POOL + 2 * I_UP + I_OUT + I_W1 + I_W2;
constexpr int OFF_WGS = 96, OFF_FIRST = 160, OFF_ITEMS = 12288;
static_assert(OFF_ITEMS <= I_IN && (32 * NINT) - 9 * 256 == OFF_FIRST && OFF_FIRST + OFF_WGS == 256, "in-projection slack split");
template <bool NT> DI void conv_item(const Args& a, int l, int r, LAS float* scr, int lane) {
    unsigned char* ws = a.ws; const int c4 = (lane & 15) * 4;
        const float* src; size_t pitch, dpitch; int sc; bf16* dst; int w1c0 = -1, w1k0 = 0; const float* gk = nullptr;
        if (r < I_IN) {
            const int nblk = NPAD / 64, kb = r / nblk, nb = r % nblk, np = nb * 64 + c4;
            if (np < 11264) sc = np;
        else if (np < 19456) { const int q = (np - 11264) & 255, k = (np - 11264) >> 8;
            sc = 11312 + ((q >> 5) & 1) * 4096 + 128 * k + 32 * (q >> 6) + (q & 31); }
        else if (np < 19504) sc = 11264 + (np - 19456); else sc = -1;
            gk = a.in[1] + (size_t)l * DM + kb * 64;
            src = a.in[2] + (size_t)l * DM * NIN + (size_t)kb * 64 * NIN; pitch = NIN; dst = (bf16*)(ws + WS_WIN + l * SZ_WIN) + (size_t)nb * 64 * DM + kb * 64; dpitch = DM;
        } else if ((r -= I_IN) < I_POOL) {
            const int g = r / 64, q = r % 64, kb = q / 8, nb = q % 8;
            src = a.in[4] + ((size_t)(l * 4 + g) * 512 + kb * 64) * 512; pitch = 512; sc = nb * 64 + c4; dst = (bf16*)(ws + WS_POOLW + l * SZ_POOLW) + ((size_t)g * 512 + nb * 64) * 512 + kb * 64; dpitch = 512;
        } else if ((r -= I_POOL) < 2 * I_UP) {
            const int which = r / I_UP, q = r % I_UP, kb = q / 64, nb = q % 64;
            src = a.in[12 + which] + ((size_t)l * PW + kb * 64) * DM; pitch = DM; sc = nb * 64 + c4; dst = (bf16*)(ws + (which ? WS_WNU : WS_WPU) + l * SZ_WUP) + (size_t)nb * 64 * PW + kb * 64; dpitch = PW;
        } else if ((r -= 2 * I_UP) < I_OUT) {
            const int kb = r / 64, nb = r % 64;
            src = a.in[14] + ((size_t)l * DM + kb * 64) * DM; pitch = DM; sc = nb * 64 + c4; dst = (bf16*)(ws + WS_WOUT + l * SZ_WOUT) + (size_t)nb * 64 * DM + kb * 64; dpitch = DM;
        } else if ((r -= I_OUT) < I_W1) {
            const int i = r / 128, q = r % 128, kb = q / 2, nb = q % 2;
            src = a.in[9] + ((size_t)(l * 2 + i) * 4096 + kb * 64) * 128; pitch = 128; sc = nb * 64 + c4; dst = (bf16*)(ws + WS_W1 + l * SZ_W1) + (size_t)i * 128 * 4096; dpitch = 4096; w1c0 = nb * 64; w1k0 = kb * 64;
        } else {
            r -= I_W1; const int i = r / 4, q = r % 4, kb = q / 2, nb = q % 2;
            src = a.in[11] + ((size_t)(l * 2 + i) * 128 + kb * 64) * 128; pitch = 128; sc = nb * 64 + c4; dst = (bf16*)(ws + WS_W2 + l * SZ_W2) + ((size_t)i * 128 + nb * 64) * 128 + kb * 64; dpitch = 128;
        }
        tr_item<NT>(src, pitch, sc, dst, dpitch, scr, lane, gk, w1c0, w1k0);
}
DI void prologue(const Args& a, LAS unsigned char* lds, int gw, int NGW, int wave, int lane, bool offload) {
    LAS float* scr = (LAS float*)(lds + wave * 16640);
    const int skip = offload ? OFF_ITEMS : 0, per = I_LAYER - skip, n = I_LAYER + (DEPTH - 1) * per;
    for (int it = gw; it < n; it += NGW) {
        int l, r; if (it < I_LAYER) { l = 0; r = it; } else { const int q = it - I_LAYER; l = 1 + q / per; r = skip + q % per; }
        conv_item<false>(a, l, r, scr, lane);
    }
}
DI void slack_convert(const Args& a, LAS unsigned char* lds, int l_next, int bx, int wave, int lane) {
    LAS float* scr = (LAS float*)(lds + wave * 16640);
    for (int r = (bx - OFF_FIRST) * NWAVES + wave; r < OFF_ITEMS; r += OFF_WGS * NWAVES) conv_item<true>(a, l_next, r, scr, lane);
}

DI void p1_xb(const float* x, bf16* xb, float* ss, int gw, int NGW, int lane) {
    for (int m = gw; m < T; m += NGW) {
        const f32x4* xr = (const f32x4*)(x + (size_t)m * DM) + lane;
        f32x4 v[16]; float s = 0.f;
#pragma unroll
        for (int j = 0; j < 16; ++j) { v[j] = xr[64 * j]; s += (v[j].x * v[j].x + v[j].y * v[j].y) + (v[j].z * v[j].z + v[j].w * v[j].w); }
        ss[(size_t)m * 64 + lane] = s;
        u32x2* o = (u32x2*)(xb + (size_t)m * DM) + lane;
#pragma unroll
        for (int j = 0; j < 16; ++j) { u32x2 w; w.x = pk2(v[j].x, v[j].y); w.y = pk2(v[j].z, v[j].w); o[64 * j] = w; }
    }
}

DI int swap23(int m) { return (m & 0x13) | ((m & 4) << 1) | ((m & 8) >> 1); }
DI size_t ktile_off(int key, int c  ) { return (size_t)(key >> 5) * 8192 + (size_t)((c & 7) * 1024 + ((c >> 3) * 32 + swap23(key & 31)) * 16); }
DI size_t vtile_off(int kb  , int d) { return (size_t)(kb >> 5) * 8192 + (size_t)(((d >> 5) * 2 + ((kb >> 4) & 1)) * 1024 + (((kb >> 3) & 1) * 32 + (d & 31)) * 16); }
struct MidP { const bf16 *U, *QR, *KV6; bf16 *MP, *QN, *KSN, *KWN, *VST, *VWT; const float *qg, *kg; };
template <int W> DI void pool_load4(u32x4 (&v)[W + 3], const bf16* U, int t0, int g, int lane) {
    const bf16* up = U + (size_t)t0 * PW + g * 512 + lane * 8;
#pragma unroll
    for (int i = 0; i < W + 3; ++i) { const int r = 3 - i;
        v[i] = (t0 + r >= 0) ? *(const u32x4*)(up + (ptrdiff_t)r * PW) : (u32x4){0u, 0u, 0u, 0u}; }
}
template <int W> DI void pool_finish4(const u32x4 (&v)[W + 3], bf16* MP, int t0, int g, int lane) {
#pragma unroll
    for (int k = 0; k < 4; ++k) {
        float s[8], u0[8]; unpack8(v[3 - k], u0);
#pragma unroll
        for (int e = 0; e < 8; ++e) s[e] = u0[e];
#pragma unroll
        for (int i = 1; i < W; ++i) { float f[8]; unpack8(v[3 - k + i], f);
#pragma unroll
            for (int e = 0; e < 8; ++e) s[e] += f[e]; }
        const int t = t0 + k, nwin = (t + 1 < W) ? t + 1 : W; const float inv = 1.f / (float)nwin; float o[8];
#pragma unroll
        for (int e = 0; e < 8; ++e) o[e] = s[e] * inv - u0[e];
        *(u32x4*)(MP + (size_t)t * PW + g * 512 + lane * 8) = pack8(o);
    }
}
DI void p3_mid(const MidP& P, LAS unsigned char* lds, int gw, int NGW, int wave, int lane0) {
    LAS bf16* tl = (LAS bf16*)(lds + wave * 17408);
    for (int it = gw; it < T / 4; it += NGW) {
        int lane = lane0; asm volatile("" : "+v"(lane));
        const int t0 = it * 4;
        u32x4 a0[5], a1[7], a2[11], a3[19];
        pool_load4<2>(a0, P.U, t0, 0, lane); pool_load4<4>(a1, P.U, t0, 1, lane); pool_load4<8>(a2, P.U, t0, 2, lane); pool_load4<16>(a3, P.U, t0, 3, lane);
        const int w = it / (4 * (T / 32)), r = it % (4 * (T / 32)), h = r / (T / 32), tile = r % (T / 32);
        const int hi2 = lane >> 5, key = tile * 32 + swap23(lane & 31);
        const u32x4* src = (const u32x4*)(P.KV6 + (size_t)key * KV6W + (w ? 2048 : 1024) + h * 128 + 64 * hi2);
        __builtin_amdgcn_sched_barrier(0);
        pool_finish4<2>(a0, P.MP, t0, 0, lane); pool_finish4<4>(a1, P.MP, t0, 1, lane); pool_finish4<8>(a2, P.MP, t0, 2, lane);
        const bf16* vsrc = P.KV6 + (size_t)(tile * 32) * KV6W + (w ? 2560 : 1536) + h * 128;
        u32x4 v[8], vv[8];
#pragma unroll
        for (int j = 0; j < 8; ++j) v[j] = src[j];
#pragma unroll
        for (int i = 0; i < 8; ++i) { const int tt = i * 4 + (lane >> 4), dc = (lane & 15) * 8; vv[i] = *(const u32x4*)(vsrc + (size_t)tt * KV6W + dc); }
        __builtin_amdgcn_sched_barrier(0);
        pool_finish4<16>(a3, P.MP, t0, 3, lane);
        {
            float ss = 0.f;
#pragma unroll
            for (int j = 0; j < 8; ++j) { float f[8]; unpack8(v[j], f);
#pragma unroll
                for (int e = 0; e < 8; ++e) ss += f[e] * f[e]; }
            ss += shx(ss, 32);
            const float rs = 1.f / sqrtf(ss * (1.f / 128.f) + EPS);
            const float* kgp = P.kg + (1 + w) * 128 + 64 * hi2;
            char* dstb = (char*)((w ? P.KWN : P.KSN) + (size_t)h * T * 128) + (size_t)tile * 8192 + lane * 16;
#pragma unroll
            for (int j = 0; j < 8; ++j) { float f[8], o[8]; unpack8(v[j], f); const f32x4 g0 = *(const f32x4*)(kgp + 8 * j), g1 = *(const f32x4*)(kgp + 8 * j + 4);
                o[0] = f[0] * rs * g0.x; o[1] = f[1] * rs * g0.y; o[2] = f[2] * rs * g0.z; o[3] = f[3] * rs * g0.w; o[4] = f[4] * rs * g1.x; o[5] = f[5] * rs * g1.y; o[6] = f[6] * rs * g1.z; o[7] = f[7] * rs * g1.w;
                *(u32x4*)(dstb + j * 1024) = pack8(o); }
        }
        {
#pragma unroll
            for (int i = 0; i < 8; ++i) { const int tt = i * 4 + (lane >> 4), dc = (lane & 15) * 8; *(LAS u32x4*)(tl + tt * 136 + dc) = vv[i]; }
            LDS_WAIT(); asm volatile("" ::: "memory");
            char* dst = (char*)((w ? P.VWT : P.VST) + (size_t)h * 128 * T) + (size_t)tile * 8192 + lane * 16;
            const int m2 = lane & 31, hi3 = lane >> 5;
#pragma unroll
            for (int i = 0; i < 8; ++i) { const int dt = i >> 1, s2 = i & 1;
                const int d = 32 * dt + m2, k0 = 16 * s2 + 8 * hi3; unsigned short e[8];
#pragma unroll
                for (int k = 0; k < 8; ++k) e[k] = tl[(k0 + k) * 136 + d];
                u32x4 wv; wv.x = e[0] | ((unsigned)e[1] << 16); wv.y = e[2] | ((unsigned)e[3] << 16); wv.z = e[4] | ((unsigned)e[5] << 16); wv.w = e[6] | ((unsigned)e[7] << 16);
                *(u32x4*)(dst + (dt * 2 + s2) * 1024) = wv; }
            LDS_WAIT(); asm volatile("" ::: "memory");
        }
    }
}

struct CmpP { const bf16* KV6; const float* pe; const bf16* W1T; const float* b1; const bf16* W2T; const float* kg0; bf16* KCN; bf16* VCT; };
DI void p3_compress(const CmpP& P, LAS unsigned char* lds, int G, int tid, int wave, int lane) {
    LAS float* red = (LAS float*)lds;
    LAS bf16* hid = (LAS bf16*)(lds + 65536);
    LAS float* out2 = (LAS float*)(lds + 65536 + 8192);
    for (int cu = blockIdx.x; cu < 256; cu += G) {
        const int which = cu & 1, h = (cu >> 1) & 3, n0 = (cu >> 3) * 16;
        const int i = lane & 15, kq = lane >> 4;
        const bf16* w1t = P.W1T + (size_t)which * 128 * 4096; const float* pe = P.pe + which * 4096;
        f32x4 acc[8];
#pragma unroll
        for (int ct = 0; ct < 8; ++ct) acc[ct] = (f32x4){0.f, 0.f, 0.f, 0.f};
#pragma unroll 8
        for (int ks = 0; ks < 16; ++ks) {
            const int kk = wave * 512 + ks * 32 + kq * 8, lt = kk >> 7, d = kk & 127, tok = 16 * (n0 + i) + lt;
            float af[8];
            if (tok < T) { const u32x4 v = *(const u32x4*)(P.KV6 + (size_t)tok * KV6W + which * 512 + h * 128 + d); unpack8(v, af); }
            else {
#pragma unroll
                for (int e = 0; e < 8; ++e) af[e] = 0.f; }
            const f32x4 p0 = *(const f32x4*)(pe + kk), p1 = *(const f32x4*)(pe + kk + 4);
            af[0] += p0.x; af[1] += p0.y; af[2] += p0.z; af[3] += p0.w; af[4] += p1.x; af[5] += p1.y; af[6] += p1.z; af[7] += p1.w;
            const bf16x8 a = __builtin_bit_cast(bf16x8, pack8(af));
#pragma unroll
            for (int ct = 0; ct < 8; ++ct) { const bf16x8 b = *(const bf16x8*)((const char*)w1t + (size_t)((wave * 16 + ks) * 8 + ct) * 1024 + lane * 16);
                acc[ct] = __builtin_amdgcn_mfma_f32_16x16x32_bf16(a, b, acc[ct], 0, 0, 0); }
        }
#pragma unroll
        for (int ct = 0; ct < 8; ++ct)
#pragma unroll
            for (int e = 0; e < 4; ++e) red[(wave * 16 + kq * 4 + e) * 128 + ct * 16 + i] = acc[ct][e];
        __syncthreads();
        {
            const int n = tid >> 5, c0 = (tid & 31) * 4; f32x4 s = *(const f32x4*)(P.b1 + which * 128 + c0);
#pragma unroll
            for (int w = 0; w < 8; ++w) { const f32x4 v = *(const LAS f32x4*)(red + (w * 16 + n) * 128 + c0); s += v; }
            u32x2 hw; hw.x = pk2(s.x * sigm(s.x), s.y * sigm(s.y)); hw.y = pk2(s.z * sigm(s.z), s.w * sigm(s.w));
            *(LAS u32x2*)(hid + n * 136 + c0) = hw;
        }
        __syncthreads();
        {
            const bf16* w2t = P.W2T + (size_t)which * 128 * 128; f32x4 c2 = (f32x4){0.f, 0.f, 0.f, 0.f};
#pragma unroll
            for (int ks = 0; ks < 4; ++ks) { const bf16x8 a = *(const LAS bf16x8*)(hid + i * 136 + ks * 32 + kq * 8); const bf16x8 b = *(const bf16x8*)(w2t + (size_t)(wave * 16 + i) * 128 + ks * 32 + kq * 8);
                c2 = __builtin_amdgcn_mfma_f32_16x16x32_bf16(a, b, c2, 0, 0, 0); }
#pragma unroll
            for (int e = 0; e < 4; ++e) out2[(kq * 4 + e) * 132 + wave * 16 + i] = c2[e];
        }
        __syncthreads();
        if (which == 0) {
            if (tid < 256) { const int n = tid >> 4, c = tid & 15; const f32x4 v0 = *(const LAS f32x4*)(out2 + n * 132 + c * 8), v1 = *(const LAS f32x4*)(out2 + n * 132 + c * 8 + 4);
                float ss = (v0.x * v0.x + v0.y * v0.y) + (v0.z * v0.z + v0.w * v0.w) + (v1.x * v1.x + v1.y * v1.y) + (v1.z * v1.z + v1.w * v1.w);
                ss = sum16(ss);
                const float rs = 1.f / sqrtf(ss * (1.f / 128.f) + EPS); const f32x4 g0 = *(const f32x4*)(P.kg0 + c * 8), g1 = *(const f32x4*)(P.kg0 + c * 8 + 4);
                u32x4 w; w.x = pk2(v0.x * rs * g0.x, v0.y * rs * g0.y); w.y = pk2(v0.z * rs * g0.z, v0.w * rs * g0.w); w.z = pk2(v1.x * rs * g1.x, v1.y * rs * g1.y); w.w = pk2(v1.z * rs * g1.z, v1.w * rs * g1.w);
                *(u32x4*)((char*)(P.KCN + (size_t)h * NCP * 128) + ktile_off(n0 + n, c)) = w; }
        } else {
            if (tid < 256) { const int d = tid >> 1, a = tid & 1; float e[8];
#pragma unroll
                for (int k = 0; k < 8; ++k) e[k] = out2[(8 * a + k) * 132 + d];
                *(u32x4*)((char*)(P.VCT + (size_t)h * 128 * NCP) + vtile_off(n0 + 8 * a, d)) = pack8(e); }
        }
        __syncthreads();
    }
}

#define MFMA32(a, b, c) __builtin_amdgcn_mfma_f32_32x32x16_bf16((a), (b), (c), 0, 0, 0)
struct AttP { const bf16 *QN  , *KCN, *VCT, *KSN, *VST, *KWN, *VWT, *NG, *ZN; bf16* NO; float* OST; const float* qg; };
constexpr int AT_STG = 0, AT_IMP = 65536, AT_WUN = 98304, AT_CLIST = 98304 + 256;

template <int STRIDE>
DI void qk_tile(f32x16& S, const bf16x8 (&qf)[8], const LAS unsigned char* kl  , float sl2, float tbm) {
    bf16x8 kf[8];
#pragma unroll
    for (int j = 0; j < 8; ++j) kf[j] = *(const LAS bf16x8*)(kl + j * 1024);
    __builtin_amdgcn_sched_barrier(0);
    const float sl2s = sl2 * (float)STRIDE;
#pragma unroll
    for (int r = 0; r < 16; ++r) { float x = __builtin_fmaf(sl2s, (float)(16 * (r >> 3) + (r & 7)), tbm); asm volatile("" : "+v"(x)); S[r] = x; }
#pragma unroll
    for (int j = 0; j < 8; ++j) S = MFMA32(kf[j], qf[j], S);
}
template <int STRIDE>
DI void edge_mask(f32x16& S, int rel0, int lo) {
#pragma unroll
    for (int r = 0; r < 16; ++r) { const int rel = rel0 + STRIDE * (16 * (r >> 3) + (r & 7)); S[r] = (rel <= 0 && rel >= lo) ? S[r] : NEG; }
}
DI float tile_max(const f32x16& S) {
    float mx = S[0];
#pragma unroll
    for (int r = 1; r < 16; ++r) mx = fmaxf(mx, S[r]);
    return fmaxf(mx, shx(mx, 32));
}
DI void soft_fixed(f32x16& S, float& mref, float& l) {
    const bool unset = mref < -1e29f;
    if (__builtin_amdgcn_ballot_w64(unset) != 0ull) {
        const float mx = tile_max(S); const bool now = unset && (mx > -1e29f); const float d = now ? mx : 0.f;
#pragma unroll
        for (int r = 0; r < 16; ++r) S[r] -= d;
        mref = now ? mx : mref;
    }
    float sum = 0.f;
#pragma unroll
    for (int r = 0; r < 16; ++r) { S[r] = ex2(S[r]); sum += S[r]; }
    l += sum;
}
DI void v_load4(bf16x8 (&vf)[4], const LAS unsigned char* vl  ) {
#pragma unroll
    for (int i = 0; i < 4; ++i) vf[i] = *(const LAS bf16x8*)(vl + i * 1024);
    __builtin_amdgcn_sched_barrier(0);
}
DI void pack_p(const f32x16& Pm, u32x4& p0, u32x4& p1) {
    p0.x = pk2(Pm[0], Pm[1]); p0.y = pk2(Pm[2], Pm[3]); p0.z = pk2(Pm[4], Pm[5]); p0.w = pk2(Pm[6], Pm[7]);
    p1.x = pk2(Pm[8], Pm[9]); p1.y = pk2(Pm[10], Pm[11]); p1.z = pk2(Pm[12], Pm[13]); p1.w = pk2(Pm[14], Pm[15]);
}
DI void pv_mma(f32x16 (&O)[4], const u32x4& p0, const u32x4& p1, const bf16x8 (&va)[4], const bf16x8 (&vb)[4]) {
    const bf16x8 pb0 = __builtin_bit_cast(bf16x8, p0), pb1 = __builtin_bit_cast(bf16x8, p1);
#pragma unroll
    for (int dt = 0; dt < 2; ++dt) { O[dt] = MFMA32(va[2 * dt], pb0, O[dt]); O[dt] = MFMA32(va[2 * dt + 1], pb1, O[dt]); }
#pragma unroll
    for (int dt = 0; dt < 2; ++dt) { O[2 + dt] = MFMA32(vb[2 * dt], pb0, O[2 + dt]); O[2 + dt] = MFMA32(vb[2 * dt + 1], pb1, O[2 + dt]); }
}
DI void o_zero(f32x16 (&O)[4]) {
#pragma unroll
    for (int dt = 0; dt < 4; ++dt)
#pragma unroll
        for (int r = 0; r < 16; ++r) O[dt][r] = 0.f;
}
DI float dpp_xor1(float v) { return __builtin_bit_cast(float, __builtin_amdgcn_update_dpp(0, __builtin_bit_cast(int, v), 0xB1, 0xF, 0xF, true)); }
DI float dpp_xor2(float v) { return __builtin_bit_cast(float, __builtin_amdgcn_update_dpp(0, __builtin_bit_cast(int, v), 0x4E, 0xF, 0xF, true)); }
DI void lds_fadd(LAS float* p, float v) { (void)__hip_atomic_fetch_add(p, v, __ATOMIC_RELAXED, __HIP_MEMORY_SCOPE_WORKGROUP); }

struct TileCtx { const char *kc, *vc, *kw, *vw, *ks, *vs; int nt, nd, wlast, cur; const LAS unsigned char* clist; };
DI void tile_ptrs(const TileCtx& X, int idx, const char*& k, const char*& v) {
    if (idx < X.nt) { k = X.kc + (size_t)(X.nt - 1 - idx) * 8192; v = nullptr; }
    else if (idx < 2 * X.nt) { k = X.kc + (size_t)(2 * X.nt - 1 - idx) * 8192; v = X.vc + (size_t)(2 * X.nt - 1 - idx) * 8192; }
    else if (idx < 2 * X.nt + X.nd) { const int k0 = X.wlast - 32 * (idx - 2 * X.nt); k = X.kw + (size_t)k0 * 256; v = X.vw + (size_t)k0 * 256; }
    else { const int j = idx - 2 * X.nt - X.nd; const int b = (j < 2) ? X.cur : __builtin_amdgcn_readfirstlane((int)X.clist[j >> 1]); const int k0 = b * 64 + 32 * (1 - (j & 1)); k = X.ks + (size_t)k0 * 256; v = X.vs + (size_t)k0 * 256; }
}

DI void attn_wg_unit(const AttP& P, LAS unsigned char* lds, int wave, int lane, int c, int h) {
    LAS float* imp = (LAS float*)(lds + AT_IMP + wave * 4096);
    LAS unsigned* wun = (LAS unsigned*)(lds + AT_WUN);
    LAS unsigned char* clist = lds + AT_CLIST;
    LAS unsigned short* selw = (LAS unsigned short*)(lds + SELW_OFF + wave * 128);
    const int t0 = c * 64 + wave * 8;
    const int n = lane & 31, hi = lane >> 5, tok = n >> 2, gq = n & 3, t = t0 + tok, hq = h * 4 + gq;
    const unsigned koff = (unsigned)lane * 16u;
    const float sl2 = ex2(-0.5f * (float)(hq + 1)) * LOG2E;
    const int cur = c;
    bf16x8 qf[8];
    {
        const u32x4* qp = (const u32x4*)(P.QN + (size_t)t * NSAW + hq * 128 + 64 * hi);
        u32x4 qv[8];
#pragma unroll
        for (int j = 0; j < 8; ++j) qv[j] = qp[j];
        float ss = 0.f;
#pragma unroll
        for (int j = 0; j < 8; ++j) { float f[8]; unpack8(qv[j], f);
#pragma unroll
            for (int e = 0; e < 8; ++e) ss += f[e] * f[e]; }
        ss += shx(ss, 32);
        const float rs = (0.08838834764831845f * LOG2E) / sqrtf(ss * (1.f / 128.f) + EPS);
        const float* gp = P.qg + 64 * hi;
#pragma unroll
        for (int j = 0; j < 8; ++j) { float f[8]; unpack8(qv[j], f); const f32x4 g0 = *(const f32x4*)(gp + 8 * j), g1 = *(const f32x4*)(gp + 8 * j + 4);
            f[0] *= rs * g0.x; f[1] *= rs * g0.y; f[2] *= rs * g0.z; f[3] *= rs * g0.w; f[4] *= rs * g1.x; f[5] *= rs * g1.y; f[6] *= rs * g1.z; f[7] *= rs * g1.w;
            qf[j] = __builtin_bit_cast(bf16x8, pack8(f)); }
    }
#define AT_GATE(br) bflo((unsigned)*(const bf16*)(P.NG + (size_t)t * 256 + hq * 3 + (br)))
#define AT_OST() u32x2* ost; { int l2_ = lane; asm volatile("" : "+v"(l2_)); ost = (u32x2*)P.OST + ((size_t)(t0 >> 3) * 4 + h) * 1024 + l2_; }
    f32x16 O[4], S;
#pragma unroll
    for (int i = 0; i < 4; ++i) *(LAS f32x4*)(imp + (i * 64 + lane) * 4) = (f32x4){0.f, 0.f, 0.f, 0.f};

    TileCtx X;
    X.kc = (const char*)(P.KCN + (size_t)h * NCP * 128); X.vc = (const char*)(P.VCT + (size_t)h * 128 * NCP);
    X.kw = (const char*)(P.KWN + (size_t)h * T * 128); X.vw = (const char*)(P.VWT + (size_t)h * 128 * T);
    X.ks = (const char*)(P.KSN + (size_t)h * T * 128); X.vs = (const char*)(P.VST + (size_t)h * 128 * T);
    X.nt = ((((c * 64 + 63 - 31) >> 4) + 1) + 31) >> 5;
    X.wlast = c * 64 + 32; { const int wf = (c >= 8) ? 64 * (c - 8) : 0; X.nd = ((X.wlast - wf) >> 5) + 1; }
    X.clist = clist; X.cur = c;
    const int nvalid = (t0 + 7 >= 31) ? ((t0 + 7 - 31) >> 4) + 1 : 0, ntw = (nvalid + 31) >> 5;
    int kfw = t0 - 511; kfw = kfw < 0 ? 0 : (kfw & ~31); const int klw = t0 & ~31;
    const int nt = X.nt, nd = X.nd, S1 = 2 * nt + nd;
    int total = S1 + 2;
    unsigned un[4] = {0u, 0u, 0u, 0u};
    float m = NEG, l = 0.f, rl = 0.f, mu = 0.f;

    int idx = 0, pend = S1 + 2;
#define AT_ISSUE(ti) do { const char *k_, *v_; tile_ptrs(X, (ti), k_, v_); LAS unsigned char* nb_ = lds + AT_STG + ((ti) & 3) * 16384 + wave * 1024; \
        __builtin_amdgcn_global_load_lds((const unsigned*)(k_ + wave * 1024 + koff), (LAS unsigned*)nb_, 16, 0, 0); \
        __builtin_amdgcn_global_load_lds((const unsigned*)((v_ ? v_ : k_) + wave * 1024 + koff), (LAS unsigned*)(nb_ + 8192), 16, 0, 0); } while (0)
#define AT_SYNC() do { if (idx + 1 < pend) asm volatile("s_waitcnt vmcnt(2) lgkmcnt(0)\n\ts_barrier" ::: "memory"); else asm volatile("s_waitcnt vmcnt(0) lgkmcnt(0)\n\ts_barrier" ::: "memory"); } while (0)
#define AT_PREFETCH() do { if (idx + 2 < pend) AT_ISSUE(idx + 2); } while (0)
#define AT_VL(ti) (lds + AT_STG + ((ti) & 3) * 16384 + 8192 + koff)
#define AT_KL() (lds + AT_STG + (idx & 3) * 16384 + koff)
    asm volatile("s_waitcnt vmcnt(0) lgkmcnt(0)\n\ts_barrier" ::: "memory");
#pragma unroll 1
    for (int d = 0; d < 2; ++d) if (d < pend) AT_ISSUE(d);

#pragma unroll 1
    for (; idx < nt; ++idx) {
        AT_SYNC(); AT_PREFETCH();
        const LAS unsigned char* kl = AT_KL();
        const int ti = nt - 1 - idx, k0 = ti * 32, rel0 = 16 * (k0 + 8 * hi) + 31 - t;
        qk_tile<16>(S, qf, kl, sl2, sl2 * (float)rel0 - ((m < -1e29f) ? 0.f : m));
        if (ti >= ntw - 1) edge_mask<16>(S, rel0, -(1 << 30));
        soft_fixed(S, m, l);
    }
    { const float lt = l + shx(l, 32); const bool have = m > -1e29f; rl = have ? 1.f / lt : 0.f; mu = have ? m : 0.f; }
    o_zero(O);
    int pidx = idx; u32x4 pp0 = {0u, 0u, 0u, 0u}, pp1 = {0u, 0u, 0u, 0u};
#pragma unroll 1
    for (; idx < 2 * nt; ++idx) {
        AT_SYNC(); AT_PREFETCH();
        const LAS unsigned char* kl = AT_KL();
        const int ti = 2 * nt - 1 - idx, k0 = ti * 32, rel0 = 16 * (k0 + 8 * hi) + 31 - t;
        bf16x8 va[4], vb[4]; v_load4(va, AT_VL(pidx));
        qk_tile<16>(S, qf, kl, sl2, sl2 * (float)rel0 - mu);
        v_load4(vb, AT_VL(pidx) + 4096);
        pv_mma(O, pp0, pp1, va, vb);
        if (ti >= ntw - 1) edge_mask<16>(S, rel0, -(1 << 30));
#pragma unroll
        for (int r = 0; r < 16; ++r) S[r] = ex2(S[r]) * rl;
#pragma unroll
        for (int q4 = 0; q4 < 4; ++q4) { float v[4];
#pragma unroll
            for (int e = 0; e < 4; ++e) { float x = S[4 * q4 + e]; x += dpp_xor1(x); x += dpp_xor2(x); v[e] = x; }
            if (gq == 0) { const int j = (k0 >> 2) + 4 * (q4 >> 1) + 2 * hi + (q4 & 1);
                lds_fadd(imp + tok * 128 + j, 2.f * (v[0] + v[1] + v[2]) + v[3]); if (j + 1 < 128) lds_fadd(imp + tok * 128 + j + 1, v[3]); } }
        const float gc = AT_GATE(0);
#pragma unroll
        for (int r = 0; r < 16; ++r) S[r] *= gc;
        pack_p(S, pp0, pp1); pidx = idx;
    }
    { bf16x8 va[4], vb[4]; v_load4(va, AT_VL(pidx)); v_load4(vb, AT_VL(pidx) + 4096); pv_mma(O, pp0, pp1, va, vb); }
    {
        LDS_WAIT(); asm volatile("" ::: "memory");
        int l5 = lane; asm volatile("" : "+v"(l5));
        const int tk = l5 >> 3, sub = l5 & 7; const LAS float* pb = imp + tk * 128 + sub * 16;
        unsigned key[16];
#pragma unroll
        for (int i4 = 0; i4 < 4; ++i4) { const f32x4 q = *(const LAS f32x4*)(pb + 4 * i4);
#pragma unroll
            for (int e = 0; e < 4; ++e) { const int i = 4 * i4 + e, j = sub * 16 + i; const float iv = (e == 0) ? q.x : (e == 1) ? q.y : (e == 2) ? q.z : q.w;
                const bool valid = j <= cur, forced = (j == 0) || (j == cur) || (j == cur - 1);
                const unsigned ib = ((__builtin_bit_cast(unsigned, iv) & 0x7fffff00u) | (unsigned)(255 - j));
                key[i] = !valid ? 0u : (forced ? (0x7f000000u | (unsigned)(255 - j)) : ib); } }
        const int R = (cur + 1 < 16) ? cur + 1 : 16; unsigned sel = 0u;
        for (int rd = 0; rd < R; ++rd) {
            unsigned mx = key[0];
#pragma unroll
            for (int i = 1; i < 16; ++i) mx = mx > key[i] ? mx : key[i];
            { unsigned ot = (unsigned)__builtin_amdgcn_update_dpp(0, (int)mx, 0xB1, 0xF, 0xF, true); mx = mx > ot ? mx : ot;
              ot = (unsigned)__builtin_amdgcn_update_dpp(0, (int)mx, 0x4E, 0xF, 0xF, true); mx = mx > ot ? mx : ot;
              ot = (unsigned)__builtin_amdgcn_update_dpp(0, (int)mx, 0x141, 0xF, 0xF, true); mx = mx > ot ? mx : ot; }
#pragma unroll
            for (int i = 0; i < 16; ++i) { const bool hit = (key[i] == mx); sel |= hit ? (1u << i) : 0u; key[i] = hit ? 0u : key[i]; }
        }
        selw[tk * 8 + sub] = (unsigned short)sel;
        LDS_WAIT(); asm volatile("" ::: "memory");
        const LAS u32x4* sw = (const LAS u32x4*)selw;
        u32x4 uu = sw[0];
#pragma unroll
        for (int k = 1; k < 8; ++k) { const u32x4 o = sw[k]; uu.x |= o.x; uu.y |= o.y; uu.z |= o.z; uu.w |= o.w; }
        un[0] = __builtin_amdgcn_readfirstlane(uu.x); un[1] = __builtin_amdgcn_readfirstlane(uu.y); un[2] = __builtin_amdgcn_readfirstlane(uu.z); un[3] = __builtin_amdgcn_readfirstlane(uu.w);
        if (lane == 0) *(LAS u32x4*)(wun + 4 * wave) = (u32x4){un[0], un[1], un[2], un[3]};
        AT_OST();
#pragma unroll
        for (int i = 0; i < 4; ++i) *(LAS f32x4*)(imp + (i * 64 + lane) * 4) = (f32x4){0.f, 0.f, 0.f, 0.f};
#pragma unroll
        for (int q = 0; q < 16; ++q) { u32x2 w_; w_.x = pk2(O[q >> 2][4 * (q & 3)], O[q >> 2][4 * (q & 3) + 1]); w_.y = pk2(O[q >> 2][4 * (q & 3) + 2], O[q >> 2][4 * (q & 3) + 3]); ost[q * 64] = w_;
            if ((q & 3) == 3) asm volatile("" ::: "memory"); }
    }
    o_zero(O); m = NEG; l = 0.f;
    pidx = idx; pp0 = (u32x4){0u, 0u, 0u, 0u}; pp1 = pp0;
#define AT_D_HEAD() \
        AT_SYNC(); AT_PREFETCH(); \
        const LAS unsigned char* kl = AT_KL(); \
        const int k0 = X.wlast - 32 * (idx - 2 * nt); \
        const int rel0 = k0 + 8 * hi - t; const bool edge = (k0 + 31 > t0) || (k0 + 511 < t0 + 7)
    if (wave < 4) {
#pragma unroll 1
        for (; idx < S1; ++idx) {
            AT_D_HEAD();
            bf16x8 va[4], vb[4]; v_load4(va, AT_VL(pidx));
            qk_tile<1>(S, qf, kl, sl2, sl2 * (float)rel0 - ((m < -1e29f) ? 0.f : m));
            v_load4(vb, AT_VL(pidx) + 4096);
            pv_mma(O, pp0, pp1, va, vb);
            if (edge) edge_mask<1>(S, rel0, -511);
            soft_fixed(S, m, l); pack_p(S, pp0, pp1); pidx = idx;
        }
    } else {
#pragma unroll
        for (int r = 0; r < 16; ++r) S[r] = NEG;
        int prel0 = 0; bool pedge = false;
#pragma unroll 1
        for (; idx < S1; ++idx) {
            AT_D_HEAD();
            if (pedge) edge_mask<1>(S, prel0, -511);
            soft_fixed(S, m, l); pack_p(S, pp0, pp1);
            { bf16x8 va[4], vb[4]; v_load4(va, AT_VL(pidx)); v_load4(vb, AT_VL(pidx) + 4096); pv_mma(O, pp0, pp1, va, vb); }
            qk_tile<1>(S, qf, kl, sl2, sl2 * (float)rel0 - ((m < -1e29f) ? 0.f : m));
            pidx = idx; prel0 = rel0; pedge = edge;
        }
        if (pedge) edge_mask<1>(S, prel0, -511);
        soft_fixed(S, m, l); pack_p(S, pp0, pp1);
    }
#undef AT_D_HEAD
    { bf16x8 va[4], vb[4]; v_load4(va, AT_VL(pidx)); v_load4(vb, AT_VL(pidx) + 4096); pv_mma(O, pp0, pp1, va, vb); }
    {
        AT_OST();
        const float lt = l + shx(l, 32), cw = AT_GATE(2) / lt;
        asm volatile("s_waitcnt vmcnt(0)" ::: "memory");
#pragma unroll
        for (int q = 0; q < 16; ++q) { const u32x2 sw_ = ost[q * 64]; u32x2 w_;
            w_.x = pk2(bflo(sw_.x) + cw * O[q >> 2][4 * (q & 3)], bfhi(sw_.x) + cw * O[q >> 2][4 * (q & 3) + 1]); w_.y = pk2(bflo(sw_.y) + cw * O[q >> 2][4 * (q & 3) + 2], bfhi(sw_.y) + cw * O[q >> 2][4 * (q & 3) + 3]); ost[q * 64] = w_;
            if ((q & 3) == 3) asm volatile("" ::: "memory"); }
    }
    o_zero(O); m = NEG; l = 0.f;
    {
        u32x4 uu = *(const LAS u32x4*)(wun);
#pragma unroll
        for (int k = 1; k < 8; ++k) { const u32x4 o = *(const LAS u32x4*)(wun + 4 * k); uu.x |= o.x; uu.y |= o.y; uu.z |= o.z; uu.w |= o.w; }
        const unsigned u0 = __builtin_amdgcn_readfirstlane(uu.x), u1 = __builtin_amdgcn_readfirstlane(uu.y), u2 = __builtin_amdgcn_readfirstlane(uu.z), u3 = __builtin_amdgcn_readfirstlane(uu.w);
        const int ncu = __builtin_popcount(u0) + __builtin_popcount(u1) + __builtin_popcount(u2) + __builtin_popcount(u3);
        total = S1 + 2 * ncu;
#pragma unroll
        for (int rr = 0; rr < 2; ++rr) { const int b = lane + 64 * rr;
            const unsigned wb = (b < 32) ? u0 : (b < 64) ? u1 : (b < 96) ? u2 : u3;
            if ((wb >> (b & 31)) & 1u) {
                int above = __builtin_popcount(wb >> (b & 31)) - 1;
                if (b < 96) above += __builtin_popcount(u3); if (b < 64) above += __builtin_popcount(u2); if (b < 32) above += __builtin_popcount(u1);
                clist[above] = (unsigned char)b; } }
        LDS_WAIT(); asm volatile("" ::: "memory");
    }
    pend = total;
    pidx = idx; pp0 = (u32x4){0u, 0u, 0u, 0u}; pp1 = pp0;
    {
        const int ncu2 = (total - S1) >> 1;
        int bc = cur;
        unsigned mc = ((const LAS unsigned*)selw)[tok * 4 + (bc >> 5)];
        unsigned bn_raw = (ncu2 > 1) ? (unsigned)clist[1] : (unsigned)cur;
#define AT_C_HEAD() \
            AT_SYNC(); \
            const int j = idx - S1, half = 1 - (j & 1); \
            const int bn = __builtin_amdgcn_readfirstlane((int)bn_raw); \
            if (idx + 2 < pend) { \
                const int k2 = bn * 64 + 32 * half; LAS unsigned char* nb_ = lds + AT_STG + ((idx + 2) & 3) * 16384 + wave * 1024; \
                __builtin_amdgcn_global_load_lds((const unsigned*)(X.ks + (size_t)k2 * 256 + wave * 1024 + koff), (LAS unsigned*)nb_, 16, 0, 0); \
                __builtin_amdgcn_global_load_lds((const unsigned*)(X.vs + (size_t)k2 * 256 + wave * 1024 + koff), (LAS unsigned*)(nb_ + 8192), 16, 0, 0); } \
            const LAS unsigned char* kl = AT_KL(); \
            const int k0 = bc * 64 + 32 * half; const bool rok = (mc >> (bc & 31)) & 1u; \
            const int rel0 = k0 + 8 * hi - t
#define AT_C_TAIL() \
            if (half == 0) { const int jb = j >> 1; bc = bn; mc = ((const LAS unsigned*)selw)[tok * 4 + (bc >> 5)]; bn_raw = (jb + 2 < ncu2) ? (unsigned)clist[jb + 2] : (unsigned)cur; }
        if (wave < 4) {
#pragma unroll 1
            for (; idx < total; ++idx) {
                AT_C_HEAD();
                bf16x8 va[4], vb[4]; v_load4(va, AT_VL(pidx));
                qk_tile<1>(S, qf, kl, sl2, rok ? (sl2 * (float)rel0 - ((m < -1e29f) ? 0.f : m)) : NEG);
                v_load4(vb, AT_VL(pidx) + 4096);
                pv_mma(O, pp0, pp1, va, vb);
                if (bc == cur) edge_mask<1>(S, rel0, -(1 << 30));
                soft_fixed(S, m, l); pack_p(S, pp0, pp1); pidx = idx;
                AT_C_TAIL();
            }
        } else {
#pragma unroll
            for (int r = 0; r < 16; ++r) S[r] = NEG;
            int prel0 = 0; bool pedge = false;
#pragma unroll 1
            for (; idx < total; ++idx) {
                AT_C_HEAD();
                if (pedge) edge_mask<1>(S, prel0, -(1 << 30));
                soft_fixed(S, m, l); pack_p(S, pp0, pp1);
                { bf16x8 va[4], vb[4]; v_load4(va, AT_VL(pidx)); v_load4(vb, AT_VL(pidx) + 4096); pv_mma(O, pp0, pp1, va, vb); }
                qk_tile<1>(S, qf, kl, sl2, rok ? (sl2 * (float)rel0 - ((m < -1e29f) ? 0.f : m)) : NEG);
                pidx = idx; prel0 = rel0; pedge = (bc == cur);
                AT_C_TAIL();
            }
            if (pedge) edge_mask<1>(S, prel0, -(1 << 30));
            soft_fixed(S, m, l); pack_p(S, pp0, pp1);
        }
#undef AT_C_HEAD
#undef AT_C_TAIL
    }
    { bf16x8 va[4], vb[4]; v_load4(va, AT_VL(pidx)); v_load4(vb, AT_VL(pidx) + 4096); pv_mma(O, pp0, pp1, va, vb); }
#undef AT_SYNC
#undef AT_PREFETCH
#undef AT_KL
#undef AT_VL
#undef AT_ISSUE
    {
        AT_OST();
        const float lt = l + shx(l, 32), cs = AT_GATE(1) / lt;
        asm volatile("s_waitcnt vmcnt(0)" ::: "memory");
        LAS unsigned char* tb = (LAS unsigned char*)imp;
        int l4 = lane; asm volatile("" : "+v"(l4)); const int n4 = l4 & 31, hi4 = l4 >> 5;
#pragma unroll
        for (int ph = 0; ph < 2; ++ph) {
#pragma unroll
            for (int q8 = 0; q8 < 8; ++q8) { const int q = 8 * ph + q8; const u32x2 sw_ = ost[q * 64]; const f32x4 sv = (f32x4){bflo(sw_.x), bfhi(sw_.x), bflo(sw_.y), bfhi(sw_.y)};
                const float o0 = sv.x + cs * O[q >> 2][4 * (q & 3)], o1 = sv.y + cs * O[q >> 2][4 * (q & 3) + 1], o2 = sv.z + cs * O[q >> 2][4 * (q & 3) + 2], o3 = sv.w + cs * O[q >> 2][4 * (q & 3) + 3];
                const int byte = (32 * (q8 >> 2) + 8 * (q8 & 3) + 4 * hi4) * 2;
                u32x2 w; w.x = pk2(o0, o1); w.y = pk2(o2, o3);
                *(LAS u32x2*)(tb + n4 * 128 + ((((byte >> 4) ^ (n4 & 7)) << 4) | (byte & 15))) = w;
                if (q8 & 1) asm volatile("" ::: "memory"); }
            LDS_WAIT(); asm volatile("" ::: "memory");
#pragma unroll
            for (int k = 0; k < 4; ++k) { const int p = l4 + 64 * k, row = p >> 3, ch = p & 7;
                const u32x4 ov = *(const LAS u32x4*)(tb + row * 128 + ((ch ^ (row & 7)) << 4));
                const size_t go = (size_t)(t0 + (row >> 2)) * NSAW + (h * 4 + (row & 3)) * 128 + 64 * ph + 8 * ch;
                const u32x4 zv = *(const u32x4*)(P.ZN + go); float of[8], zf[8]; unpack8(ov, of); unpack8(zv, zf);
#pragma unroll
                for (int e = 0; e < 8; ++e) of[e] *= zf[e];
                *(u32x4*)(P.NO + go) = pack8(of);
                if (k & 1) asm volatile("" ::: "memory"); }
            LDS_WAIT(); asm volatile("" ::: "memory");
        }
#pragma unroll
        for (int i = 0; i < 4; ++i) *(LAS f32x4*)(imp + (i * 64 + lane) * 4) = (f32x4){0.f, 0.f, 0.f, 0.f};
    }
}
#undef AT_GATE
DI void p4_attention(const AttP& P, LAS unsigned char* lds, int G, int wave, int lane) {
    for (int w = blockIdx.x; w < 256; w += G) {
        const int h = w & 3, p = w >> 2;
#pragma unroll 1
        for (int k = 0; k < 2; ++k) attn_wg_unit(P, lds, wave, lane, k ? p : 127 - p, h);
    }
    asm volatile("s_waitcnt vmcnt(0) lgkmcnt(0)\n\ts_barrier" ::: "memory");
}

__global__ void __launch_bounds__(NTHR, 2) mega_fwd(Args args) {
    extern __shared__ __attribute__((aligned(16))) unsigned char lds_raw[];
    LAS unsigned char* lds = (LAS unsigned char*)lds_raw;
    const int tid0 = threadIdx.x;
    const int wave0 = __builtin_amdgcn_readfirstlane(tid0 >> 6);
    const int G = gridDim.x, bx = blockIdx.x;
    const int vcu = (G % 8 == 0) ? (bx % 8) * (G / 8) + bx / 8 : bx;
    const int NGW = G * NWAVES;
    unsigned char* const ws0 = args.ws;
    gu32* ctl = (gu32*)(ws0 + WS_CTL);
    for (int u = tid0; u < (LDS_BYTES - LDSCTL_OFF) / 4; u += NTHR) ((LAS unsigned*)(lds + LDSCTL_OFF))[u] = 0u;
    __syncthreads();
    volatile LAS unsigned* MISC = (volatile LAS unsigned*)(lds + MISC_OFF);
    XcdBarrier bar; bar.bar = (unsigned*)(ctl + CW_BAR); bar.x = 0; bar.st = nullptr;
    if (!MK_MULTI) bar = xcd_barrier_post((unsigned*)(ctl + CW_BAR), MISC + 8);
    const int lo = args.st_lo, hi = args.st_hi;
#define IN(k) (lo <= (k) && (k) < hi)
#ifdef PROBE_PH
    unsigned long long pr_acc = 0ull, pr_t0 = 0ull;
#define PR_B(p) do { if ((p) == PROBE_PH) pr_t0 = __builtin_amdgcn_s_memrealtime(); } while (0)
#define PR_E(p) do { if ((p) == PROBE_PH) pr_acc += __builtin_amdgcn_s_memrealtime() - pr_t0; } while (0)
#else
#define PR_B(p) do {} while (0)
#define PR_E(p) do {} while (0)
#endif
#ifndef REP_PH
#define REP_PH -1
#endif
#define REPS(p) for (int rep_ = 0; rep_ < ((p) == REP_PH ? 2 : 1); ++rep_)
#define LAUNDER_WS() unsigned char* ws = ws0; asm volatile("" : "+s"(ws)); int wave = wave0; asm volatile("" : "+s"(wave)); int lane; asm volatile("v_mbcnt_lo_u32_b32 %0, -1, 0\n\tv_mbcnt_hi_u32_b32 %0, -1, %0" : "=v"(lane)); const int tid = wave * 64 + lane, gw = vcu * NWAVES + wave; (void)tid; (void)gw
#ifndef PH_MASK
#define PH_MASK 0x7f
#endif
#define PH_ON(p) ((PH_MASK >> (p)) & 1)
#define SEAM(k) do { if ((k) + 1 < hi) xcd_barrier(bar); } while (0)

    if (PH_ON(0) && IN(0)) REPS(0) { PR_B(0); LAUNDER_WS(); prologue(args, lds, gw, NGW, wave, lane, G == 256);
        if (IN(1)) p1_xb(args.in[0], (bf16*)(ws + WS_H), (float*)(ws + WS_SS), gw, NGW, lane);
        SEAM(0); PR_E(0); }

    for (int l = 0; l < DEPTH; ++l) {
        const int s0 = 1 + 6 * l;
        if (s0 + 6 <= lo || s0 >= hi) continue;
        if (PH_ON(1) && IN(s0) && l == 0 && !IN(0)) REPS(1) { PR_B(1); LAUNDER_WS(); p1_xb(args.in[0], (bf16*)(ws + WS_H), (float*)(ws + WS_SS), gw, NGW, lane); SEAM(s0); PR_E(1); }
        if (PH_ON(2) && IN(s0 + 1)) REPS(2) {
            PR_B(2);
            LAUNDER_WS(); bf16* Hb = (bf16*)(ws + WS_H);
            pg8::Gemm g{DM, DM, DM};
            pg8::SchedPlain S{(const char*)Hb, (const char*)(ws + WS_WIN + l * SZ_WIN), 32, NINT, G, bx, (size_t)256 * DM * 2, (size_t)256 * DM * 2, WGM_IN};
            { pg8::Unit u0; if (S.next(0, u0)) {
                const f32x4* sp = (const f32x4*)((const float*)(ws + WS_SS) + ((size_t)u0.pm * 256 + (tid >> 1)) * 64 + (tid & 1) * 32); float sq = 0.f;
#pragma unroll
                for (int j = 0; j < 8; ++j) { const f32x4 q4 = sp[j]; sq += (q4.x + q4.y) + (q4.z + q4.w); }
                sq += shx(sq, 1);
                if (!(tid & 1)) ((LAS float*)(lds + RS_OFF))[tid >> 1] = 1.f / sqrtf(sq * (1.f / DM) + EPS); }
              __syncthreads(); }
            pg8::EpiIn E{(bf16*)(ws + WS_U), (bf16*)(ws + WS_ZP), (bf16*)(ws + WS_QR), (bf16*)(ws + WS_ZN), (bf16*)(ws + WS_KV6), (bf16*)(ws + WS_GM), (bf16*)(ws + WS_NG), args.in[3] + (size_t)l * 2 * DM, (const LAS float*)(lds + RS_OFF)};
            pg8::gemm_phase<pg8::EpiIn, pg8::SchedPlain, true>(lds, g, S, E, tid);
            if (G == 256 && bx >= OFF_FIRST && l + 1 < DEPTH && rep_ == 0) slack_convert(args, lds, l + 1, bx, wave, lane);
            SEAM(s0 + 1);
            PR_E(2);
        }
        if (PH_ON(3) && IN(s0 + 2)) REPS(3) {
            PR_B(3);
            LAUNDER_WS();
            CmpP C{(const bf16*)(ws + WS_KV6), args.in[8] + (size_t)l * 2 * 4096, (const bf16*)(ws + WS_W1 + l * SZ_W1), args.in[10] + (size_t)l * 2 * 128, (const bf16*)(ws + WS_W2 + l * SZ_W2),
                   args.in[7] + (size_t)l * 3 * 128, (bf16*)(ws + WS_KCN), (bf16*)(ws + WS_VCT)};
            p3_compress(C, lds, G, tid, wave, lane);
            MidP M{(const bf16*)(ws + WS_U), (const bf16*)(ws + WS_QR), (const bf16*)(ws + WS_KV6), (bf16*)(ws + WS_MP), (bf16*)(ws + WS_QN), (bf16*)(ws + WS_KSN), (bf16*)(ws + WS_KWN),
                   (bf16*)(ws + WS_VST), (bf16*)(ws + WS_VWT), args.in[6] + (size_t)l * 128, args.in[7] + (size_t)l * 3 * 128};
            p3_mid(M, lds, gw, NGW, wave, lane);
            SEAM(s0 + 2);
            PR_E(3);
        }
        if (PH_ON(4) && IN(s0 + 3)) REPS(4) {
            PR_B(4);
            LAUNDER_WS();
            {
                pg8::Gemm g{PW, 512, 512};
                pg8::SchedPool S{(const char*)(ws + WS_MP), (const char*)(ws + WS_POOLW + l * SZ_POOLW), G, bx};
                pg8::EpiPool E{(bf16*)(ws + WS_PO), (const bf16*)(ws + WS_ZP), args.in[5] + (size_t)l * PW};
                pg8::gemm_phase<pg8::EpiPool, pg8::SchedPool, false>(lds, g, S, E, tid);
            }
            __syncthreads();
            AttP A{(const bf16*)(ws + WS_QR), (const bf16*)(ws + WS_KCN), (const bf16*)(ws + WS_VCT), (const bf16*)(ws + WS_KSN), (const bf16*)(ws + WS_VST), (const bf16*)(ws + WS_KWN), (const bf16*)(ws + WS_VWT),
                   (const bf16*)(ws + WS_NG), (const bf16*)(ws + WS_ZN), (bf16*)(ws + WS_NO), (float*)(ws + WS_OST), args.in[6] + (size_t)l * 128};
#ifdef REP_ATT
            { int nra = 2; asm volatile("" : "+s"(nra));
#pragma unroll 1
              for (int ra = 0; ra < nra; ++ra) p4_attention(A, lds, G, wave, lane); }
#else
            p4_attention(A, lds, G, wave, lane);
#endif
            SEAM(s0 + 3);
            PR_E(4);
        }
        if (PH_ON(5) && IN(s0 + 4)) REPS(5) {
            PR_B(5);
            LAUNDER_WS();
            pg8::Gemm g{PW, PW, PW};
            pg8::SchedUp S{(const char*)(ws + WS_PO), (const char*)(ws + WS_NO), (const char*)(ws + WS_WPU + l * SZ_WUP), (const char*)(ws + WS_WNU + l * SZ_WUP), G, bx};
            pg8::EpiUp E{(bf16*)(ws + WS_Y), (const bf16*)(ws + WS_GM), (const bf16*)(ws + WS_GM) + (size_t)T * DM};
            pg8::gemm_phase<pg8::EpiUp, pg8::SchedUp, true>(lds, g, S, E, tid);
            SEAM(s0 + 4);
            PR_E(5);
        }
        if (PH_ON(6) && IN(s0 + 5)) REPS(6) {
            PR_B(6);
            LAUNDER_WS();
            pg8::Gemm g{DM, DM, DM};
            pg8::SchedPlain S{(const char*)(ws + WS_Y), (const char*)(ws + WS_WOUT + l * SZ_WOUT), 32, 16, G, bx, (size_t)256 * DM * 2, (size_t)256 * DM * 2, WGM_OUT};
            const bool dry = (REP_PH == 6 && rep_ == 0);
            pg8::EpiOut E{args.in[0], (const bf16*)(ws + WS_H), (bf16*)(ws + (dry ? WS_GM : WS_H)), (float*)(ws + (dry ? WS_GM + ((size_t)T * DM * 2) : WS_SS)), dry ? (float*)(ws + WS_GM) : args.out, l == 0 ? 0 : (l == DEPTH - 1 ? 2 : 1)};
            pg8::gemm_phase<pg8::EpiOut, pg8::SchedPlain, true>(lds, g, S, E, tid);
            SEAM(s0 + 5);
            PR_E(6);
        }
    }
#ifdef PROBE_PH
    xcd_barrier(bar);
    if (blockIdx.x == 0 && threadIdx.x == 0) args.out[0] = (float)pr_acc * 0.01f;
#endif
#undef IN
#undef SEAM
}

extern "C" void kernel_launch(void* const* d_in, const int* in_sizes, int n_in, void* d_out, int out_size, void* d_ws, size_t ws_size, hipStream_t stream) {
    static int grid = 0;
    if (grid == 0) {
        if (n_in != 15 || out_size != T * DM || ws_size < WS_END) { fprintf(stderr, "kernel_launch: unexpected shapes (n_in %d out %d ws %zu need %zu)\n", n_in, out_size, ws_size, (size_t)WS_END); grid = -1; return; }
        int dev = 0, cus = 0, per_cu = 0;
        if (hipGetDevice(&dev) != hipSuccess || hipDeviceGetAttribute(&cus, hipDeviceAttributeMultiprocessorCount, dev) != hipSuccess) { grid = -1; return; }
        if (hipFuncSetAttribute((const void*)mega_fwd, hipFuncAttributeMaxDynamicSharedMemorySize, LDS_BYTES) != hipSuccess) { fprintf(stderr, "kernel_launch: hipFuncSetAttribute failed\n"); grid = -1; return; }
        if (hipOccupancyMaxActiveBlocksPerMultiprocessor(&per_cu, (const void*)mega_fwd, NTHR, LDS_BYTES) != hipSuccess || per_cu < 1) { fprintf(stderr, "kernel_launch: occupancy query says %d\n", per_cu); }
        (void)hipGetLastError();
        grid = cus;
    }
    if (grid < 0) return;
    (void)hipMemsetAsync((char*)d_ws + WS_CTL, 0, CTL_ZERO_BYTES, stream);
    Args a{};
    for (int i = 0; i < 15; ++i) a.in[i] = (const float*)d_in[i];
    a.out = (float*)d_out; a.ws = (unsigned char*)d_ws;
    constexpr int NSTEP = 1 + 6 * DEPTH;
#if MK_MULTI
    for (int s = 0; s < NSTEP; ++s) { a.st_lo = s; a.st_hi = s + 1; hipLaunchKernelGGL(mega_fwd, dim3(grid), dim3(NTHR), LDS_BYTES, stream, a); }
#else
    a.st_lo = 0; a.st_hi = NSTEP;
    hipLaunchKernelGGL(mega_fwd, dim3(grid), dim3(NTHR), LDS_BYTES, stream, a);
#endif
    const hipError_t le = hipPeekAtLastError();
    if (le != hipSuccess) fprintf(stderr, "kernel_launch: launch failed: %s\n", hipGetErrorName(le));
}
```

```cpp
#include <hip/hip_runtime.h>
#include <cstdio>
#include <cstdint>

#ifndef WGM_IN
#define WGM_IN 4
#endif
#ifndef WGM_UP
#define WGM_UP 4
#endif
#ifndef WGM_OUT
#define WGM_OUT 4
#endif
#ifndef MK_MULTI
#define MK_MULTI 0
#endif

#define DI __device__ __forceinline__
#define GAS __attribute__((address_space(1)))
#define LAS __attribute__((address_space(3)))
typedef unsigned short bf16;
typedef short bf16x8 __attribute__((ext_vector_type(8)));
typedef float f32x2 __attribute__((ext_vector_type(2)));
typedef float f32x4 __attribute__((ext_vector_type(4)));
typedef float f32x16 __attribute__((ext_vector_type(16)));
typedef unsigned u32x2 __attribute__((ext_vector_type(2)));
typedef unsigned u32x4 __attribute__((ext_vector_type(4)));
typedef __bf16 bf16x2_t __attribute__((ext_vector_type(2)));
typedef GAS unsigned gu32;

constexpr int T = 8192, DM = 4096, PW = 2048, NSAW = 2048, KVW = 512, HD = 128, NQH = 16, NKVH = 4, DEPTH = 4;
constexpr int NIN = 19504, NPAD = 19712, NINT = NPAD / 256;
constexpr int KV6W = 3072;
constexpr int NCP = 512;
constexpr float EPS = 1e-6f, NEG = -1e30f, LOG2E = 1.4426950408889634f;
constexpr int NWAVES = 8, NTHR = 512;

constexpr size_t al256(size_t x) { return (x + 255) & ~(size_t)255; }
constexpr size_t WS_CTL = 0, CTL_ZERO_BYTES = 65536;
constexpr size_t SZ_WIN = (size_t)NPAD * DM * 2, SZ_POOLW = (size_t)4 * 512 * 512 * 2, SZ_WUP = (size_t)DM * PW * 2, SZ_WOUT = (size_t)DM * DM * 2;
constexpr size_t SZ_W1 = (size_t)2 * 128 * 4096 * 2, SZ_W2 = (size_t)2 * 128 * 128 * 2;
constexpr size_t WS_WIN = 1u << 20;
constexpr size_t WS_POOLW = WS_WIN + DEPTH * SZ_WIN;
constexpr size_t WS_WPU = WS_POOLW + DEPTH * SZ_POOLW;
constexpr size_t WS_WNU = WS_WPU + DEPTH * SZ_WUP;
constexpr size_t WS_WOUT = WS_WNU + DEPTH * SZ_WUP;
constexpr size_t WS_W1 = WS_WOUT + DEPTH * SZ_WOUT;
constexpr size_t WS_W2 = WS_W1 + DEPTH * SZ_W1;
constexpr size_t WS_H = WS_W2 + DEPTH * SZ_W2;
constexpr size_t WS_U = WS_H + (size_t)T * DM * 2;
constexpr size_t WS_ZP = WS_U + (size_t)T * PW * 2;
constexpr size_t WS_QR = WS_ZP + (size_t)T * PW * 2;
constexpr size_t WS_ZN = WS_QR + (size_t)T * NSAW * 2;
constexpr size_t WS_KV6 = WS_ZN + (size_t)T * NSAW * 2;
constexpr size_t WS_GM = WS_KV6 + (size_t)T * KV6W * 2;
constexpr size_t WS_NG = WS_GM + (size_t)T * 8192 * 2;
constexpr size_t WS_MP = WS_NG + (size_t)T * 256 * 2;
constexpr size_t WS_QN = WS_MP + (size_t)T * PW * 2;
constexpr size_t WS_KSN = WS_QN + (size_t)T * NSAW * 2;
constexpr size_t WS_KWN = WS_KSN + (size_t)4 * T * 128 * 2;
constexpr size_t WS_VST = WS_KWN + (size_t)4 * T * 128 * 2;
constexpr size_t WS_VWT = WS_VST + (size_t)4 * T * 128 * 2;
constexpr size_t WS_KCN = WS_VWT + (size_t)4 * T * 128 * 2;
constexpr size_t WS_VCT = WS_KCN + (size_t)4 * NCP * 128 * 2;
constexpr size_t WS_PO = WS_VCT + (size_t)4 * NCP * 128 * 2;
constexpr size_t WS_NO = WS_PO + (size_t)T * PW * 2;
constexpr size_t WS_Y = WS_NO + (size_t)T * NSAW * 2;
constexpr size_t WS_OST = WS_Y + (size_t)T * DM * 2;
static_assert(WS_ZP == WS_U + (size_t)T * PW * 2 && WS_QR == WS_ZP + (size_t)T * PW * 2 && WS_ZN == WS_QR + (size_t)T * NSAW * 2, "U | ZP | QR | ZN consecutive");
constexpr size_t WS_SS = WS_OST + (size_t)T * NSAW * 4;
constexpr size_t WS_END = WS_SS + (size_t)T * 64 * 4;
constexpr int CW_BAR = 4096;

constexpr int RING_BYTES = 131072, LDSCTL_OFF = 140288  , MISC_OFF = LDSCTL_OFF + 320, SELW_OFF = LDSCTL_OFF + 2048, LDS_BYTES = 147456, RS_OFF = RING_BYTES  ;

#define RLX_AGENT __ATOMIC_RELAXED, __HIP_MEMORY_SCOPE_AGENT
#define LDS_WAIT() asm volatile("s_waitcnt lgkmcnt(0)" ::: "memory")
DI unsigned f2bf(float f) { unsigned u = __builtin_bit_cast(unsigned, f); return (u + 0x7fffu + ((u >> 16) & 1u)) >> 16; }
DI unsigned pk2(float lo, float hi) { f32x2 v = {lo, hi}; bf16x2_t b = __builtin_convertvector(v, bf16x2_t); return __builtin_bit_cast(unsigned, b); }
DI float bflo(unsigned u) { return __builtin_bit_cast(float, u << 16); }
DI float bfhi(unsigned u) { return __builtin_bit_cast(float, u & 0xffff0000u); }
DI float ex2(float x) { return __builtin_amdgcn_exp2f(x); }
DI float rcpf(float x) { return __builtin_amdgcn_rcpf(x); }
DI float sigm(float v) { return rcpf(1.f + ex2(-v * LOG2E)); }
DI float shx(float v, int mask) {
    int ln; asm volatile("v_mbcnt_lo_u32_b32 %0, -1, 0\n\tv_mbcnt_hi_u32_b32 %0, -1, %0" : "=v"(ln));
    return __builtin_bit_cast(float, __builtin_amdgcn_ds_bpermute((ln ^ mask) << 2, __builtin_bit_cast(int, v)));
}
DI float wave_sum(float v) {
#pragma unroll
    for (int o = 1; o < 64; o <<= 1) v += shx(v, o);
    return v;
}
DI float sum16(float v) {
#pragma unroll
    for (int o = 1; o < 16; o <<= 1) v += shx(v, o);
    return v;
}
DI void unpack8(const u32x4 w, float (&f)[8]) {
    f[0] = bflo(w.x); f[1] = bfhi(w.x); f[2] = bflo(w.y); f[3] = bfhi(w.y); f[4] = bflo(w.z); f[5] = bfhi(w.z); f[6] = bflo(w.w); f[7] = bfhi(w.w);
}
DI u32x4 pack8(const float (&f)[8]) { u32x4 w; w.x = pk2(f[0], f[1]); w.y = pk2(f[2], f[3]); w.z = pk2(f[4], f[5]); w.w = pk2(f[6], f[7]); return w; }

namespace pg8 {
typedef unsigned short bf16_t;
constexpr int BM = 256, BK = 64, HALF = 128, HTB = HALF * BK * 2, NXCD = 8;
DI int lds_byte(int r, int c) { const int st = (r >> 4) * 2 + (c >> 5), rr = r & 15, cc = c & 31, ob = rr * 64 + cc * 2; return st * 1024 + (ob ^ (((ob >> 9) & 1) << 5)); }
DI void stage_rc(int b, int& R, int& C) { const int st = b / 1024, sb = b % 1024, swz = sb ^ (((sb >> 9) & 1) << 5); R = (st >> 1) * 16 + swz / 64; C = (st & 1) * 32 + (swz % 64) / 2; }
DI int perm32(int rho) { const int n = rho >> 4, i = rho & 15; return 8 * (i >> 2) + 4 * n + (i & 3); }

struct Unit { int pm, pn, aux; const char* a; const char* b; };
struct Gemm { int lda, ldb, K; };

DI void tile_of(int L, int nM, int nN, int& pm, int& pn, const int WGM) {
    const int nwg = nM * nN; int wgid = L;
    { const int q = nwg / NXCD, r = nwg % NXCD, xcd = wgid % NXCD, off = wgid / NXCD; wgid = (xcd < r ? xcd * (q + 1) : r * (q + 1) + (xcd - r) * q) + off; }
    const int nig = WGM * nN, gid = wgid / nig, fm = gid * WGM, gsz = (nM - fm) < WGM ? (nM - fm) : WGM;
    pm = fm + ((wgid % nig) % gsz); pn = (wgid % nig) / gsz;
}

template <class Epi, class Sched, bool ALIGN_EPI>
DI void gemm_phase(LAS unsigned char* lds, const Gemm g, const Sched& S, const Epi& E, const int tid) {
    const int wid = __builtin_amdgcn_readfirstlane(tid >> 6), lane = tid & 63, wr = wid >> 2, wc = wid & 3, fr = lane & 15, fq = lane >> 4;
    const int K = g.K, nt = K / BK;
    unsigned voffA[2], voffB[2];
#pragma unroll
    for (int i = 0; i < 2; ++i) { int R, C; stage_rc(tid * 16 + i * 8192, R, C); const int Rb = Epi::PERM ? (((R >> 5) * 64) + perm32(R & 31)) : R;
        voffA[i] = (unsigned)(R * g.lda + C) * 2u; voffB[i] = (unsigned)(Rb * g.ldb + C) * 2u; }
    const size_t kstep = (size_t)(BK * 2);
    const size_t hsA = (size_t)HALF * g.lda * 2, hsB = (size_t)(Epi::PERM ? 32 : HALF) * g.ldb * 2;
    const unsigned ldsw = (unsigned)wid * 1024u;
    const int aoff = lds_byte(wr * 64 + fr, fq * 8), boff = lds_byte(wc * 32 + fr, fq * 8);
#define PG8_SA(b, h) (((b) * 2 + (h)) * HTB)
#define PG8_SB(b, h) ((4 + (b) * 2 + (h)) * HTB)
#define PG8_STAGE(bufoff, gbase, voff) do { _Pragma("unroll") for (int _i = 0; _i < 2; ++_i) \
        __builtin_amdgcn_global_load_lds((const unsigned*)((const char*)(gbase) + (voff)[_i]), (LAS unsigned*)(lds + (bufoff) + ldsw + _i * 8192), 16, 0, 0); } while (0)
#define PG8_LDA(dst, b, h) do { _Pragma("unroll") for (int m = 0; m < 4; ++m) _Pragma("unroll") for (int k = 0; k < 2; ++k) dst[m][k] = *(const LAS bf16x8*)(lds + PG8_SA(b, h) + aoff + m * 2048 + k * 1024); } while (0)
#define PG8_LDB(dst, b, h) do { _Pragma("unroll") for (int n = 0; n < 2; ++n) _Pragma("unroll") for (int k = 0; k < 2; ++k) dst[n][k] = *(const LAS bf16x8*)(lds + PG8_SB(b, h) + boff + n * 2048 + k * 1024); } while (0)
#define PG8_MMA(ai, bj, At, Bt) do { __builtin_amdgcn_s_setprio(1); _Pragma("unroll") for (int m = 0; m < 4; ++m) _Pragma("unroll") for (int n = 0; n < 2; ++n) _Pragma("unroll") for (int k = 0; k < 2; ++k) \
        acc[ai][bj][m][n] = __builtin_amdgcn_mfma_f32_16x16x32_bf16(Bt[n][k], At[m][k], acc[ai][bj][m][n], 0, 0, 0); __builtin_amdgcn_s_setprio(0); } while (0)
#define PG8_WAIT_V(n) asm volatile("s_waitcnt vmcnt(" #n ")" ::: "memory")
#define PG8_WAIT_L(n) asm volatile("s_waitcnt lgkmcnt(" #n ")" ::: "memory")
#define PG8_BAR __builtin_amdgcn_s_barrier()
#define PG8_SCHED __builtin_amdgcn_sched_barrier(0)
    Unit cur, nxt; int ui = 0;
    if (!S.next(0, cur)) return;
    f32x4 acc[2][2][4][2];
#pragma unroll
    for (int a = 0; a < 2; ++a)
#pragma unroll
        for (int b = 0; b < 2; ++b)
#pragma unroll
            for (int m = 0; m < 4; ++m)
#pragma unroll
                for (int n = 0; n < 2; ++n) acc[a][b][m][n] = (f32x4){0.f, 0.f, 0.f, 0.f};
    bf16x8 At[4][2], B0[2][2], B1[2][2];
    const char* cA = cur.a; const char* cB = cur.b;
    PG8_STAGE(PG8_SB(0, 0), cB, voffB); PG8_STAGE(PG8_SB(0, 1), cB + hsB, voffB); PG8_STAGE(PG8_SA(0, 0), cA, voffA); PG8_STAGE(PG8_SA(0, 1), cA + hsA, voffA);
    if (wr == 1) PG8_BAR;
    PG8_WAIT_V(2); PG8_BAR;
    PG8_STAGE(PG8_SB(1, 0), cB + kstep, voffB); PG8_STAGE(PG8_SA(1, 0), cA + kstep, voffA); PG8_STAGE(PG8_SB(1, 1), cB + hsB + kstep, voffB);
    PG8_WAIT_V(6); PG8_BAR;
    for (;;) {
        const bool has_next = S.next(ui + 1, nxt);
        const char* nA = has_next ? nxt.a : cA; const char* nB = has_next ? nxt.b : cB;
        for (int t = 0; t < nt; t += 2) {
            const bool last = (t == nt - 2);
            const char* a1 = cA + (size_t)(t + 1) * kstep;
            const char* a2 = last ? nA : cA + (size_t)(t + 2) * kstep; const char* b2 = last ? nB : cB + (size_t)(t + 2) * kstep;
            const char* a3 = a2 + kstep; const char* b3 = b2 + kstep;
            PG8_LDB(B0, 0, 0); PG8_LDB(B1, 0, 1); PG8_SCHED; PG8_LDA(At, 0, 0); PG8_STAGE(PG8_SA(1, 1), a1 + hsA, voffA);
            PG8_WAIT_V(8); PG8_WAIT_L(0); PG8_BAR; PG8_MMA(0, 0, At, B0); PG8_MMA(0, 1, At, B1); PG8_BAR; PG8_SCHED;
            PG8_LDA(At, 0, 1); PG8_STAGE(PG8_SB(0, 0), b2, voffB); PG8_STAGE(PG8_SB(0, 1), b2 + hsB, voffB); PG8_STAGE(PG8_SA(0, 0), a2, voffA);
            PG8_WAIT_V(8); PG8_WAIT_L(0); PG8_BAR; PG8_MMA(1, 0, At, B0); PG8_MMA(1, 1, At, B1); PG8_BAR; PG8_SCHED;
            PG8_LDB(B0, 1, 0); PG8_LDB(B1, 1, 1); PG8_SCHED; PG8_LDA(At, 1, 0); PG8_STAGE(PG8_SA(0, 1), a2 + hsA, voffA);
            PG8_WAIT_V(8); PG8_WAIT_L(0); PG8_BAR; PG8_MMA(0, 0, At, B0); PG8_MMA(0, 1, At, B1); PG8_BAR; PG8_SCHED;
            PG8_LDA(At, 1, 1); PG8_STAGE(PG8_SB(1, 0), b3, voffB); PG8_STAGE(PG8_SB(1, 1), b3 + hsB, voffB); PG8_STAGE(PG8_SA(1, 0), a3, voffA);
            PG8_WAIT_V(8); PG8_WAIT_L(0); PG8_BAR; PG8_MMA(1, 0, At, B0); PG8_MMA(1, 1, At, B1); PG8_BAR; PG8_SCHED;
        }
        if constexpr (ALIGN_EPI) { if (wr == 0) PG8_BAR; }
        E(acc, cur, wr, wc, fr, fq);
        if (!has_next) break;
        if (!(Epi::CHAIN && cur.aux == 0)) {
#pragma unroll
        for (int a = 0; a < 2; ++a)
#pragma unroll
            for (int b = 0; b < 2; ++b)
#pragma unroll
                for (int m = 0; m < 4; ++m)
#pragma unroll
                    for (int n = 0; n < 2; ++n) acc[a][b][m][n] = (f32x4){0.f, 0.f, 0.f, 0.f};
        }
        cur = nxt; cA = nA; cB = nB; ++ui;
        if constexpr (ALIGN_EPI) { if (wr == 1) PG8_BAR; }
    }
    PG8_WAIT_V(0);
    if constexpr (!ALIGN_EPI) { if (wr == 0) PG8_BAR; }
    PG8_BAR;
#undef PG8_SA
#undef PG8_SB
#undef PG8_STAGE
#undef PG8_LDA
#undef PG8_LDB
#undef PG8_MMA
#undef PG8_WAIT_V
#undef PG8_WAIT_L
#undef PG8_BAR
#undef PG8_SCHED
}

struct SchedPlain {
    const char* A; const char* B; int nM, nN, G, c; size_t ta, tb; int wgm;
    DI bool next(int i, Unit& u) const { const long L = (long)i * G + c; if (L >= (long)nM * nN) return false; tile_of((int)L, nM, nN, u.pm, u.pn, wgm); u.aux = 0; u.a = A + (size_t)u.pm * ta; u.b = B + (size_t)u.pn * tb; return true; }
};
struct SchedPool {
    const char* A; const char* B; int G, c;
    DI bool next(int i, Unit& u) const { const int L = i * G + c; if (L >= 256) return false; u.pm = L >> 3; u.pn = L & 7; u.aux = 0; const int grp = u.pn >> 1, half = u.pn & 1;
        u.a = A + ((size_t)u.pm * 256 * PW + (size_t)grp * 512) * 2; u.b = B + ((size_t)grp * 512 * 512 + (size_t)half * 256 * 512) * 2; return true; }
};
struct SchedUp {
    const char* A0; const char* A1; const char* B0; const char* B1; int G, c;
    DI bool next(int i, Unit& u) const { const long L = (long)(i >> 1) * G + c; if (L >= 32 * 16) return false; tile_of((int)L, 32, 16, u.pm, u.pn, WGM_UP); u.aux = i & 1;
        u.a = (u.aux ? A1 : A0) + (size_t)u.pm * 256 * PW * 2; u.b = (u.aux ? B1 : B0) + (size_t)u.pn * 256 * PW * 2; return true; }
};

struct EpiIn {
    static constexpr bool PERM = true, CHAIN = false;
    bf16_t *U, *ZP, *QR, *ZN, *KV6, *GM, *NG; const float* mbias; const LAS float* rs;
    DI void operator()(f32x4 (&acc)[2][2][4][2], const Unit& u, int wr, int wc, int fr, int fq) const {
        const int pn = u.pn; bf16_t* base; int ldc, colt, mode;
        if (pn < 32) { base = U + (size_t)(pn >> 3) * T * PW; ldc = PW; colt = (pn & 7) * 256; mode = (pn >> 3) & 1; }
        else if (pn < 44) { base = KV6; ldc = KV6W; colt = (pn - 32) * 256; mode = 0; }
        else if (pn < 76) { base = GM; ldc = DM; colt = 0; mode = 2; }
        else { base = NG; ldc = 256; colt = 0; mode = 3; }
        const int row0 = u.pm * BM + wr * 64 + fr, col0 = colt + wc * 64 + 8 * fq;
        if (mode == 2) {
            const int ch0 = (pn - 44) * 128 + wc * 32 + 8 * fq;
            f32x4 b0[2], b1[2];
#pragma unroll
            for (int n = 0; n < 2; ++n) { b0[n] = *(const f32x4*)(mbias + ch0 + 4 * n); b1[n] = *(const f32x4*)(mbias + DM + ch0 + 4 * n); }
#pragma unroll
            for (int ai = 0; ai < 2; ++ai)
#pragma unroll
                for (int m = 0; m < 4; ++m) { const size_t ro = (size_t)(row0 + ai * HALF + m * 16) * DM + ch0; const float rr = rs[wr * 64 + fr + ai * HALF + m * 16];
                    const f32x4 a00 = acc[ai][0][m][0] * rr + b0[0], a01 = acc[ai][0][m][1] * rr + b0[1], a10 = acc[ai][1][m][0] * rr + b1[0], a11 = acc[ai][1][m][1] * rr + b1[1];
                    f32x4 r0, r1, g10, g11;
#pragma unroll
                    for (int e = 0; e < 4; ++e) { const float e00 = fminf(ex2(-a00[e] * LOG2E), 1e30f), e01 = fminf(ex2(-a01[e] * LOG2E), 1e30f), e10 = fminf(ex2(-a10[e] * LOG2E), 1e30f), e11 = fminf(ex2(-a11[e] * LOG2E), 1e30f);
                        g10[e] = rcpf(1.f + e10); g11[e] = rcpf(1.f + e11); r0[e] = rcpf(1.f + e00) * (1.f + e10); r1[e] = rcpf(1.f + e01) * (1.f + e11); }
                    u32x4 rw, gw;
                    rw.x = pk2(r0.x, r0.y); rw.y = pk2(r0.z, r0.w); rw.z = pk2(r1.x, r1.y); rw.w = pk2(r1.z, r1.w);
                    gw.x = pk2(g10.x, g10.y); gw.y = pk2(g10.z, g10.w); gw.z = pk2(g11.x, g11.y); gw.w = pk2(g11.z, g11.w);
                    *(u32x4*)(GM + ro) = rw; *(u32x4*)(GM + (size_t)T * DM + ro) = gw; }
            return; }
#pragma unroll
        for (int ai = 0; ai < 2; ++ai)
#pragma unroll
            for (int m = 0; m < 4; ++m) { bf16_t* rowp = base + (size_t)(row0 + ai * HALF + m * 16) * ldc + col0; const float rr = rs[wr * 64 + fr + ai * HALF + m * 16];
#pragma unroll
                for (int bj = 0; bj < 2; ++bj) { f32x4 v0 = acc[ai][bj][m][0] * rr, v1 = acc[ai][bj][m][1] * rr;
                    if (mode != 0) {
#pragma unroll
                        for (int e = 0; e < 4; ++e) { const float s0 = sigm(v0[e]), s1 = sigm(v1[e]); v0[e] = (mode == 1) ? v0[e] * s0 : s0; v1[e] = (mode == 1) ? v1[e] * s1 : s1; }
                    }
                    u32x4 w; w.x = pk2(v0[0], v0[1]); w.y = pk2(v0[2], v0[3]); w.z = pk2(v1[0], v1[1]); w.w = pk2(v1[2], v1[3]);
                    *(u32x4*)(rowp + bj * 32) = w; } }
    }
};
struct EpiPool {
    static constexpr bool PERM = true, CHAIN = false;
    bf16_t* O; const bf16_t* ZP; const float* scale;
    DI void operator()(f32x4 (&acc)[2][2][4][2], const Unit& u, int wr, int wc, int fr, int fq) const {
        const int row0 = u.pm * BM + wr * 64 + fr, col0 = u.pn * BM + wc * 64 + 8 * fq;
        f32x4 sv[2][2];
#pragma unroll
        for (int bj = 0; bj < 2; ++bj)
#pragma unroll
            for (int n = 0; n < 2; ++n) sv[bj][n] = *(const f32x4*)(scale + col0 + bj * 32 + 4 * n);
#pragma unroll
        for (int ai = 0; ai < 2; ++ai)
#pragma unroll
            for (int m = 0; m < 4; ++m) { const size_t ro = (size_t)(row0 + ai * HALF + m * 16) * PW + col0;
#pragma unroll
                for (int bj = 0; bj < 2; ++bj) { const u32x4 z = *(const u32x4*)(ZP + ro + bj * 32); float zf[8]; unpack8(z, zf);
                    const f32x4 v0 = acc[ai][bj][m][0] * sv[bj][0], v1 = acc[ai][bj][m][1] * sv[bj][1];
                    u32x4 w; w.x = pk2(v0[0] * zf[0], v0[1] * zf[1]); w.y = pk2(v0[2] * zf[2], v0[3] * zf[3]); w.z = pk2(v1[0] * zf[4], v1[1] * zf[5]); w.w = pk2(v1[2] * zf[6], v1[3] * zf[7]);
                    *(u32x4*)(O + ro + bj * 32) = w; } }
    }
};
struct EpiUp {
    static constexpr bool PERM = true, CHAIN = true;
    bf16_t* Y; const bf16_t* R; const bf16_t* G1;
    DI void operator()(f32x4 (&acc)[2][2][4][2], const Unit& u, int wr, int wc, int fr, int fq) const {
        const int row0 = u.pm * BM + wr * 64 + fr, col0 = u.pn * BM + wc * 64 + 8 * fq; const int which = u.aux; const bf16_t* gsrc = which ? G1 : R;
#pragma unroll
        for (int ai = 0; ai < 2; ++ai)
#pragma unroll
            for (int m = 0; m < 4; ++m) { const int row = row0 + ai * HALF + m * 16;
#pragma unroll
                for (int bj = 0; bj < 2; ++bj) { const int col = col0 + bj * 32;
                    const u32x4 gw = *(const u32x4*)(gsrc + (size_t)row * DM + col); float g[8]; unpack8(gw, g);
                    if (which == 0) {
#pragma unroll
                        for (int e = 0; e < 4; ++e) { acc[ai][bj][m][0][e] *= g[e]; acc[ai][bj][m][1][e] *= g[4 + e]; }
                    } else {
                        const f32x4 v0 = acc[ai][bj][m][0], v1 = acc[ai][bj][m][1];
                        u32x4 w; w.x = pk2(v0[0] * g[0], v0[1] * g[1]); w.y = pk2(v0[2] * g[2], v0[3] * g[3]); w.z = pk2(v1[0] * g[4], v1[1] * g[5]); w.w = pk2(v1[2] * g[6], v1[3] * g[7]);
                        *(u32x4*)(Y + (size_t)row * DM + col) = w; } } }
    }
};
struct EpiOut {
    static constexpr bool PERM = true, CHAIN = false;
    const float* X0; const bf16_t* XS; bf16_t* XD; float* SS; float* O; int mode;
    DI void operator()(f32x4 (&acc)[2][2][4][2], const Unit& u, int wr, int wc, int fr, int fq) const {
        const int row0 = u.pm * BM + wr * 64 + fr, col0 = u.pn * BM + wc * 64 + 8 * fq;
#pragma unroll
        for (int ai = 0; ai < 2; ++ai)
#pragma unroll
            for (int m = 0; m < 4; ++m) { const int row = row0 + ai * HALF + m * 16; const size_t ro = (size_t)row * DM + col0; float s = 0.f;
#pragma unroll
                for (int bj = 0; bj < 2; ++bj) { f32x4 v0, v1;
                    if (mode == 0) { v0 = *(const f32x4*)(X0 + ro + bj * 32); v1 = *(const f32x4*)(X0 + ro + bj * 32 + 4); }
                    else { const u32x4 xw = *(const u32x4*)(XS + ro + bj * 32); v0 = (f32x4){bflo(xw.x), bfhi(xw.x), bflo(xw.y), bfhi(xw.y)}; v1 = (f32x4){bflo(xw.z), bfhi(xw.z), bflo(xw.w), bfhi(xw.w)}; }
                    v0 += acc[ai][bj][m][0]; v1 += acc[ai][bj][m][1];
                    if (mode == 2) { *(f32x4*)(O + ro + bj * 32) = v0; *(f32x4*)(O + ro + bj * 32 + 4) = v1; }
                    else { u32x4 w; w.x = pk2(v0[0], v0[1]); w.y = pk2(v0[2], v0[3]); w.z = pk2(v1[0], v1[1]); w.w = pk2(v1[2], v1[3]); *(u32x4*)(XD + ro + bj * 32) = w;
                        s += (v0[0] * v0[0] + v0[1] * v0[1]) + (v0[2] * v0[2] + v0[3] * v0[3]) + (v1[0] * v1[0] + v1[1] * v1[1]) + (v1[2] * v1[2] + v1[3] * v1[3]); } }
                if (mode != 2) { s += shx(s, 16); s += shx(s, 32); if (fq == 0) SS[(size_t)row * 64 + u.pn * 4 + wc] = s; } }
    }
};
}

#define XB_TMO      128
#define XB_XCNT(j)  (256  + 64 * (j))
#define XB_XSUB(j)  (1280 + 64 * (j))
#define XB_XGEN(j)  (2304 + 64 * (j))
#define XB_TOP      3328
#define XB_TOPGEN   3392
#define XCD_BAR_WORDS 3456
#define XB_SPIN_CAP (1u << 22)
DI unsigned xb_ld(unsigned* p)              { return __hip_atomic_load(p, __ATOMIC_RELAXED, __HIP_MEMORY_SCOPE_AGENT); }
DI unsigned xb_add(unsigned* p, unsigned v) { return __hip_atomic_fetch_add(p, v, __ATOMIC_RELAXED, __HIP_MEMORY_SCOPE_AGENT); }
DI unsigned xb_xcc_id() { return (unsigned)__builtin_amdgcn_s_getreg((3 << 11) | 20) & 0xFu; }
#define XB_SPIN(cond, bar) do { unsigned _sp = 0; while (cond) { __builtin_amdgcn_s_sleep(1); \
    if ((++_sp & 255u) == 0u) { if (xb_ld(&(bar)[XB_TMO])) break; if (_sp > XB_SPIN_CAP) { atomicAdd(&(bar)[XB_TMO], 1u); break; } } } } while (0)
struct XcdBarrier { unsigned* bar; unsigned x; volatile LAS unsigned* st; };
DI XcdBarrier xcd_barrier_post(unsigned* bar, volatile LAS unsigned* st) {
    XcdBarrier b; b.bar = bar; b.x = xb_xcc_id(); b.st = st;
    if (threadIdx.x == 0) (void)xb_add(&bar[XB_XCNT(b.x)], 1u);
    return b;
}
DI void xcd_barrier_complete(unsigned* bar, unsigned x, unsigned& nloc, unsigned& nx) {
    const unsigned G = gridDim.x * gridDim.y * gridDim.z;
    unsigned sum, cnt, mine, sp = 0u;
    for (;;) {
        sum = 0u; cnt = 0u; mine = 0u;
#pragma unroll
        for (unsigned j = 0; j < 16; ++j) { const unsigned c = xb_ld(&bar[XB_XCNT(j)]); sum += c; cnt += (c > 0u) ? 1u : 0u; mine = (j == x) ? c : mine; }
        if (sum == G) break;
        __builtin_amdgcn_s_sleep(1);
        if ((++sp & 255u) == 0u) { if (xb_ld(&bar[XB_TMO])) break; if (sp > XB_SPIN_CAP) { atomicAdd(&bar[XB_TMO], 1u); break; } }
    }
    nloc = mine > 0u ? mine : 1u; nx = cnt > 0u ? cnt : 1u;
}
DI void xcd_barrier(const XcdBarrier& b) {
    asm volatile("s_waitcnt vmcnt(0)" ::: "memory");
    __syncthreads();
    if (threadIdx.x == 0) {
        unsigned* bar = b.bar;
        __builtin_amdgcn_s_waitcnt(0);
        unsigned nloc = b.st[0], nx = b.st[1];
        if (nloc == 0u) { xcd_barrier_complete(bar, b.x, nloc, nx); b.st[0] = nloc; b.st[1] = nx; }
        const unsigned old = xb_add(&bar[XB_XSUB(b.x)], 1u);
        const unsigned gen = old / nloc;
        if (old + 1u == (gen + 1u) * nloc) {
            __builtin_amdgcn_fence(__ATOMIC_RELEASE, "agent");
            asm volatile("s_waitcnt vmcnt(0)" ::: "memory");
            const unsigned og = xb_add(&bar[XB_TOP], 1u);
            const unsigned tg = og / nx;
            if (og + 1u == (tg + 1u) * nx) xb_add(&bar[XB_TOPGEN], 1u);
            else XB_SPIN(xb_ld(&bar[XB_TOPGEN]) == tg, bar);
            __builtin_amdgcn_fence(__ATOMIC_ACQUIRE, "agent");
            xb_add(&bar[XB_XGEN(b.x)], 1u);
            asm volatile("s_waitcnt vmcnt(0)" ::: "memory");
        } else {
            XB_SPIN(xb_ld(&bar[XB_XGEN(b.x)]) == gen, bar);
            __builtin_amdgcn_fence(__ATOMIC_ACQUIRE, "agent");
            asm volatile("s_waitcnt vmcnt(0)" ::: "memory");
        }
    }
    __syncthreads();
}

struct Args { const float* in[15]; float* out; unsigned char* ws; int st_lo, st_hi; };

template <bool NT> DI void tr_item(const float* src, size_t pitch, int scol, bf16* dst, size_t dpitch, LAS float* scr, int lane, const float* gk  , int w1c0 = -1  , int w1k0 = 0) {
    f32x4 v[16]; const int kr = lane >> 4, c4 = (lane & 15) * 4;
#pragma unroll
    for (int i = 0; i < 16; ++i) { const f32x4* p_ = (const f32x4*)(src + (size_t)(4 * i + kr) * pitch + scol); v[i] = (scol >= 0) ? (NT ? __builtin_nontemporal_load(p_) : *p_) : (f32x4){0.f, 0.f, 0.f, 0.f}; }
#pragma unroll
    for (int i = 0; i < 16; ++i) { if (gk) v[i] *= gk[4 * i + kr]; LAS float* p = scr + (4 * i + kr) * 65 + c4; p[0] = v[i].x; p[1] = v[i].y; p[2] = v[i].z; p[3] = v[i].w; }
    LDS_WAIT(); asm volatile("" ::: "memory");
    const int c = lane & 7;
#pragma unroll
    for (int j = 0; j < 8; ++j) { const int n = (lane >> 3) + 8 * j; const LAS float* s = scr + (8 * c) * 65 + n;
        u32x4 o; o.x = pk2(s[0 * 65], s[1 * 65]); o.y = pk2(s[2 * 65], s[3 * 65]); o.z = pk2(s[4 * 65], s[5 * 65]); o.w = pk2(s[6 * 65], s[7 * 65]);
        if (w1c0 < 0) { if (NT) __builtin_nontemporal_store(o, (u32x4*)(dst + (size_t)n * dpitch + 8 * c)); else *(u32x4*)(dst + (size_t)n * dpitch + 8 * c) = o; }
        else { const int cc = w1c0 + n, k = w1k0 + 8 * c; *(u32x4*)(dst + ((size_t)(((k >> 5) * 8 + (cc >> 4)) * 64 + ((k >> 3) & 3) * 16 + (cc & 15))) * 8) = o; } }
    LDS_WAIT(); asm volatile("" ::: "memory");
}
constexpr int I_IN = 64 * (NPAD / 64), I_POOL = 4 * 8 * 8, I_UP = 32 * 64, I_OUT = 64 * 64, I_W1 = 2 * 64 * 2, I_W2 = 2 * 2 * 2;
constexpr int I_LAYER = I_IN + I_POOL + 2 * I_UP + I_OUT + I_W1 + I_W2;
constexpr int OFF_WGS = 96, OFF_FIRST = 160, OFF_ITEMS = 12288;
static_assert(OFF_ITEMS <= I_IN && (32 * NINT) - 9 * 256 == OFF_FIRST && OFF_FIRST + OFF_WGS == 256, "in-projection slack split");
template <bool NT> DI void conv_item(const Args& a, int l, int r, LAS float* scr, int lane) {
    unsigned char* ws = a.ws; const int c4 = (lane & 15) * 4;
        const float* src; size_t pitch, dpitch; int sc; bf16* dst; int w1c0 = -1, w1k0 = 0; const float* gk = nullptr;
        if (r < I_IN) {
            const int nblk = NPAD / 64, kb = r / nblk, nb = r % nblk, np = nb * 64 + c4;
            if (np < 11264) sc = np;
        else if (np < 19456) { const int q = (np - 11264) & 255, k = (np - 11264) >> 8;
            sc = 11312 + ((q >> 5) & 1) * 4096 + 128 * k + 32 * (q >> 6) + (q & 31); }
        else if (np < 19504) sc = 11264 + (np - 19456); else sc = -1;
            gk = a.in[1] + (size_t)l * DM + kb * 64;
            src = a.in[2] + (size_t)l * DM * NIN + (size_t)kb * 64 * NIN; pitch = NIN; dst = (bf16*)(ws + WS_WIN + l * SZ_WIN) + (size_t)nb * 64 * DM + kb * 64; dpitch = DM;
        } else if ((r -= I_IN) < I_POOL) {
            const int g = r / 64, q = r % 64, kb = q / 8, nb = q % 8;
            src = a.in[4] + ((size_t)(l * 4 + g) * 512 + kb * 64) * 512; pitch = 512; sc = nb * 64 + c4; dst = (bf16*)(ws + WS_POOLW + l * SZ_POOLW) + ((size_t)g * 512 + nb * 64) * 512 + kb * 64; dpitch = 512;
        } else if ((r -= I_POOL) < 2 * I_UP) {
            const int which = r / I_UP, q = r % I_UP, kb = q / 64, nb = q % 64;
            src = a.in[12 + which] + ((size_t)l * PW + kb * 64) * DM; pitch = DM; sc = nb * 64 + c4; dst = (bf16*)(ws + (which ? WS_WNU : WS_WPU) + l * SZ_WUP) + (size_t)nb * 64 * PW + kb * 64; dpitch = PW;
        } else if ((r -= 2 * I_UP) < I_OUT) {
            const int kb = r / 64, nb = r % 64;
            src = a.in[14] + ((size_t)l * DM + kb * 64) * DM; pitch = DM; sc = nb * 64 + c4; dst = (bf16*)(ws + WS_WOUT + l * SZ_WOUT) + (size_t)nb * 64 * DM + kb * 64; dpitch = DM;
        } else if ((r -= I_OUT) < I_W1) {
            const int i = r / 128, q = r % 128, kb = q / 2, nb = q % 2;
            src = a.in[9] + ((size_t)(l * 2 + i) * 4096 + kb * 64) * 128; pitch = 128; sc = nb * 64 + c4; dst = (bf16*)(ws + WS_W1 + l * SZ_W1) + (size_t)i * 128 * 4096; dpitch = 4096; w1c0 = nb * 64; w1k0 = kb * 64;
        } else {
            r -= I_W1; const int i = r / 4, q = r % 4, kb = q / 2, nb = q % 2;
            src = a.in[11] + ((size_t)(l * 2 + i) * 128 + kb * 64) * 128; pitch = 128; sc = nb * 64 + c4; dst = (bf16*)(ws + WS_W2 + l * SZ_W2) + ((size_t)i * 128 + nb * 64) * 128 + kb * 64; dpitch = 128;
        }
        tr_item<NT>(src, pitch, sc, dst, dpitch, scr, lane, gk, w1c0, w1k0);
}
DI void prologue(const Args& a, LAS unsigned char* lds, int gw, int NGW, int wave, int lane, bool offload) {
    LAS float* scr = (LAS float*)(lds + wave * 16640);
    const int skip = offload ? OFF_ITEMS : 0, per = I_LAYER - skip, n = I_LAYER + (DEPTH - 1) * per;
    for (int it = gw; it < n; it += NGW) {
        int l, r; if (it < I_LAYER) { l = 0; r = it; } else { const int q = it - I_LAYER; l = 1 + q / per; r = skip + q % per; }
        conv_item<false>(a, l, r, scr, lane);
    }
}
DI void slack_convert(const Args& a, LAS unsigned char* lds, int l_next, int bx, int wave, int lane) {
    LAS float* scr = (LAS float*)(lds + wave * 16640);
    for (int r = (bx - OFF_FIRST) * NWAVES + wave; r < OFF_ITEMS; r += OFF_WGS * NWAVES) conv_item<true>(a, l_next, r, scr, lane);
}

DI void p1_xb(const float* x, bf16* xb, float* ss, int gw, int NGW, int lane) {
    for (int m = gw; m < T; m += NGW) {
        const f32x4* xr = (const f32x4*)(x + (size_t)m * DM) + lane;
        f32x4 v[16]; float s = 0.f;
#pragma unroll
        for (int j = 0; j < 16; ++j) { v[j] = xr[64 * j]; s += (v[j].x * v[j].x + v[j].y * v[j].y) + (v[j].z * v[j].z + v[j].w * v[j].w); }
        ss[(size_t)m * 64 + lane] = s;
        u32x2* o = (u32x2*)(xb + (size_t)m * DM) + lane;
#pragma unroll
        for (int j = 0; j < 16; ++j) { u32x2 w; w.x = pk2(v[j].x, v[j].y); w.y = pk2(v[j].z, v[j].w); o[64 * j] = w; }
    }
}

DI int swap23(int m) { return (m & 0x13) | ((m & 4) << 1) | ((m & 8) >> 1); }
DI size_t ktile_off(int key, int c  ) { return (size_t)(key >> 5) * 8192 + (size_t)((c & 7) * 1024 + ((c >> 3) * 32 + swap23(key & 31)) * 16); }
DI size_t vtile_off(int kb  , int d) { return (size_t)(kb >> 5) * 8192 + (size_t)(((d >> 5) * 2 + ((kb >> 4) & 1)) * 1024 + (((kb >> 3) & 1) * 32 + (d & 31)) * 16); }
struct MidP { const bf16 *U, *QR, *KV6; bf16 *MP, *QN, *KSN, *KWN, *VST, *VWT; const float *qg, *kg; };
template <int W> DI void pool_load4(u32x4 (&v)[W + 3], const bf16* U, int t0, int g, int lane) {
    const bf16* up = U + (size_t)t0 * PW + g * 512 + lane * 8;
#pragma unroll
    for (int i = 0; i < W + 3; ++i) { const int r = 3 - i;
        v[i] = (t0 + r >= 0) ? *(const u32x4*)(up + (ptrdiff_t)r * PW) : (u32x4){0u, 0u, 0u, 0u}; }
}
template <int W> DI void pool_finish4(const u32x4 (&v)[W + 3], bf16* MP, int t0, int g, int lane) {
#pragma unroll
    for (int k = 0; k < 4; ++k) {
        float s[8], u0[8]; unpack8(v[3 - k], u0);
#pragma unroll
        for (int e = 0; e < 8; ++e) s[e] = u0[e];
#pragma unroll
        for (int i = 1; i < W; ++i) { float f[8]; unpack8(v[3 - k + i], f);
#pragma unroll
            for (int e = 0; e < 8; ++e) s[e] += f[e]; }
        const int t = t0 + k, nwin = (t + 1 < W) ? t + 1 : W; const float inv = 1.f / (float)nwin; float o[8];
#pragma unroll
        for (int e = 0; e < 8; ++e) o[e] = s[e] * inv - u0[e];
        *(u32x4*)(MP + (size_t)t * PW + g * 512 + lane * 8) = pack8(o);
    }
}
DI void p3_mid(const MidP& P, LAS unsigned char* lds, int gw, int NGW, int wave, int lane0) {
    LAS bf16* tl = (LAS bf16*)(lds + wave * 17408);
    for (int it = gw; it < T / 4; it += NGW) {
        int lane = lane0; asm volatile("" : "+v"(lane));
        const int t0 = it * 4;
        u32x4 a0[5], a1[7], a2[11], a3[19];
        pool_load4<2>(a0, P.U, t0, 0, lane); pool_load4<4>(a1, P.U, t0, 1, lane); pool_load4<8>(a2, P.U, t0, 2, lane); pool_load4<16>(a3, P.U, t0, 3, lane);
        const int w = it / (4 * (T / 32)), r = it % (4 * (T / 32)), h = r / (T / 32), tile = r % (T / 32);
        const int hi2 = lane >> 5, key = tile * 32 + swap23(lane & 31);
        const u32x4* src = (const u32x4*)(P.KV6 + (size_t)key * KV6W + (w ? 2048 : 1024) + h * 128 + 64 * hi2);
        __builtin_amdgcn_sched_barrier(0);
        pool_finish4<2>(a0, P.MP, t0, 0, lane); pool_finish4<4>(a1, P.MP, t0, 1, lane); pool_finish4<8>(a2, P.MP, t0, 2, lane);
        const bf16* vsrc = P.KV6 + (size_t)(tile * 32) * KV6W + (w ? 2560 : 1536) + h * 128;
        u32x4 v[8], vv[8];
#pragma unroll
        for (int j = 0; j < 8; ++j) v[j] = src[j];
#pragma unroll
        for (int i = 0; i < 8; ++i) { const int tt = i * 4 + (lane >> 4), dc = (lane & 15) * 8; vv[i] = *(const u32x4*)(vsrc + (size_t)tt * KV6W + dc); }
        __builtin_amdgcn_sched_barrier(0);
        pool_finish4<16>(a3, P.MP, t0, 3, lane);
        {
            float ss = 0.f;
#pragma unroll
            for (int j = 0; j < 8; ++j) { float f[8]; unpack8(v[j], f);
#pragma unroll
                for (int e = 0; e < 8; ++e) ss += f[e] * f[e]; }
            ss += shx(ss, 32);
            const float rs = 1.f / sqrtf(ss * (1.f / 128.f) + EPS);
            const float* kgp = P.kg + (1 + w) * 128 + 64 * hi2;
            char* dstb = (char*)((w ? P.KWN : P.KSN) + (size_t)h * T * 128) + (size_t)tile * 8192 + lane * 16;
#pragma unroll
            for (int j = 0; j < 8; ++j) { float f[8], o[8]; unpack8(v[j], f); const f32x4 g0 = *(const f32x4*)(kgp + 8 * j), g1 = *(const f32x4*)(kgp + 8 * j + 4);
                o[0] = f[0] * rs * g0.x; o[1] = f[1] * rs * g0.y; o[2] = f[2] * rs * g0.z; o[3] = f[3] * rs * g0.w; o[4] = f[4] * rs * g1.x; o[5] = f[5] * rs * g1.y; o[6] = f[6] * rs * g1.z; o[7] = f[7] * rs * g1.w;
                *(u32x4*)(dstb + j * 1024) = pack8(o); }
        }
        {
#pragma unroll
            for (int i = 0; i < 8; ++i) { const int tt = i * 4 + (lane >> 4), dc = (lane & 15) * 8; *(LAS u32x4*)(tl + tt * 136 + dc) = vv[i]; }
            LDS_WAIT(); asm volatile("" ::: "memory");
            char* dst = (char*)((w ? P.VWT : P.VST) + (size_t)h * 128 * T) + (size_t)tile * 8192 + lane * 16;
            const int m2 = lane & 31, hi3 = lane >> 5;
#pragma unroll
            for (int i = 0; i < 8; ++i) { const int dt = i >> 1, s2 = i & 1;
                const int d = 32 * dt + m2, k0 = 16 * s2 + 8 * hi3; unsigned short e[8];
#pragma unroll
                for (int k = 0; k < 8; ++k) e[k] = tl[(k0 + k) * 136 + d];
                u32x4 wv; wv.x = e[0] | ((unsigned)e[1] << 16); wv.y = e[2] | ((unsigned)e[3] << 16); wv.z = e[4] | ((unsigned)e[5] << 16); wv.w = e[6] | ((unsigned)e[7] << 16);
                *(u32x4*)(dst + (dt * 2 + s2) * 1024) = wv; }
            LDS_WAIT(); asm volatile("" ::: "memory");
        }
    }
}

struct CmpP { const bf16* KV6; const float* pe; const bf16* W1T; const float* b1; const bf16* W2T; const float* kg0; bf16* KCN; bf16* VCT; };
DI void p3_compress(const CmpP& P, LAS unsigned char* lds, int G, int tid, int wave, int lane) {
    LAS float* red = (LAS float*)lds;
    LAS bf16* hid = (LAS bf16*)(lds + 65536);
    LAS float* out2 = (LAS float*)(lds + 65536 + 8192);
    for (int cu = blockIdx.x; cu < 256; cu += G) {
        const int which = cu & 1, h = (cu >> 1) & 3, n0 = (cu >> 3) * 16;
        const int i = lane & 15, kq = lane >> 4;
        const bf16* w1t = P.W1T + (size_t)which * 128 * 4096; const float* pe = P.pe + which * 4096;
        f32x4 acc[8];
#pragma unroll
        for (int ct = 0; ct < 8; ++ct) acc[ct] = (f32x4){0.f, 0.f, 0.f, 0.f};
#pragma unroll 8
        for (int ks = 0; ks < 16; ++ks) {
            const int kk = wave * 512 + ks * 32 + kq * 8, lt = kk >> 7, d = kk & 127, tok = 16 * (n0 + i) + lt;
            float af[8];
            if (tok < T) { const u32x4 v = *(const u32x4*)(P.KV6 + (size_t)tok * KV6W + which * 512 + h * 128 + d); unpack8(v, af); }
            else {
#pragma unroll
                for (int e = 0; e < 8; ++e) af[e] = 0.f; }
            const f32x4 p0 = *(const f32x4*)(pe + kk), p1 = *(const f32x4*)(pe + kk + 4);
            af[0] += p0.x; af[1] += p0.y; af[2] += p0.z; af[3] += p0.w; af[4] += p1.x; af[5] += p1.y; af[6] += p1.z; af[7] += p1.w;
            const bf16x8 a = __builtin_bit_cast(bf16x8, pack8(af));
#pragma unroll
            for (int ct = 0; ct < 8; ++ct) { const bf16x8 b = *(const bf16x8*)((const char*)w1t + (size_t)((wave * 16 + ks) * 8 + ct) * 1024 + lane * 16);
                acc[ct] = __builtin_amdgcn_mfma_f32_16x16x32_bf16(a, b, acc[ct], 0, 0, 0); }
        }
#pragma unroll
        for (int ct = 0; ct < 8; ++ct)
#pragma unroll
            for (int e = 0; e < 4; ++e) red[(wave * 16 + kq * 4 + e) * 128 + ct * 16 + i] = acc[ct][e];
        __syncthreads();
        {
            const int n = tid >> 5, c0 = (tid & 31) * 4; f32x4 s = *(const f32x4*)(P.b1 + which * 128 + c0);
#pragma unroll
            for (int w = 0; w < 8; ++w) { const f32x4 v = *(const LAS f32x4*)(red + (w * 16 + n) * 128 + c0); s += v; }
            u32x2 hw; hw.x = pk2(s.x * sigm(s.x), s.y * sigm(s.y)); hw.y = pk2(s.z * sigm(s.z), s.w * sigm(s.w));
            *(LAS u32x2*)(hid + n * 136 + c0) = hw;
        }
        __syncthreads();
        {
            const bf16* w2t = P.W2T + (size_t)which * 128 * 128; f32x4 c2 = (f32x4){0.f, 0.f, 0.f, 0.f};
#pragma unroll
            for (int ks = 0; ks < 4; ++ks) { const bf16x8 a = *(const LAS bf16x8*)(hid + i * 136 + ks * 32 + kq * 8); const bf16x8 b = *(const bf16x8*)(w2t + (size_t)(wave * 16 + i) * 128 + ks * 32 + kq * 8);
                c2 = __builtin_amdgcn_mfma_f32_16x16x32_bf16(a, b, c2, 0, 0, 0); }
#pragma unroll
            for (int e = 0; e < 4; ++e) out2[(kq * 4 + e) * 132 + wave * 16 + i] = c2[e];
        }
        __syncthreads();
        if (which == 0) {
            if (tid < 256) { const int n = tid >> 4, c = tid & 15; const f32x4 v0 = *(const LAS f32x4*)(out2 + n * 132 + c * 8), v1 = *(const LAS f32x4*)(out2 + n * 132 + c * 8 + 4);
                float ss = (v0.x * v0.x + v0.y * v0.y) + (v0.z * v0.z + v0.w * v0.w) + (v1.x * v1.x + v1.y * v1.y) + (v1.z * v1.z + v1.w * v1.w);
                ss = sum16(ss);
                const float rs = 1.f / sqrtf(ss * (1.f / 128.f) + EPS); const f32x4 g0 = *(const f32x4*)(P.kg0 + c * 8), g1 = *(const f32x4*)(P.kg0 + c * 8 + 4);
                u32x4 w; w.x = pk2(v0.x * rs * g0.x, v0.y * rs * g0.y); w.y = pk2(v0.z * rs * g0.z, v0.w * rs * g0.w); w.z = pk2(v1.x * rs * g1.x, v1.y * rs * g1.y); w.w = pk2(v1.z * rs * g1.z, v1.w * rs * g1.w);
                *(u32x4*)((char*)(P.KCN + (size_t)h * NCP * 128) + ktile_off(n0 + n, c)) = w; }
        } else {
            if (tid < 256) { const int d = tid >> 1, a = tid & 1; float e[8];
#pragma unroll
                for (int k = 0; k < 8; ++k) e[k] = out2[(8 * a + k) * 132 + d];
                *(u32x4*)((char*)(P.VCT + (size_t)h * 128 * NCP) + vtile_off(n0 + 8 * a, d)) = pack8(e); }
        }
        __syncthreads();
    }
}

#define MFMA32(a, b, c) __builtin_amdgcn_mfma_f32_32x32x16_bf16((a), (b), (c), 0, 0, 0)
struct AttP { const bf16 *QN  , *KCN, *VCT, *KSN, *VST, *KWN, *VWT, *NG, *ZN; bf16* NO; float* OST; const float* qg; };
constexpr int AT_STG = 0, AT_IMP = 65536, AT_WUN = 98304, AT_CLIST = 98304 + 256;

template <int STRIDE>
DI void qk_tile(f32x16& S, const bf16x8 (&qf)[8], const LAS unsigned char* kl  , float sl2, float tbm) {
    bf16x8 kf[8];
#pragma unroll
    for (int j = 0; j < 8; ++j) kf[j] = *(const LAS bf16x8*)(kl + j * 1024);
    __builtin_amdgcn_sched_barrier(0);
    const float sl2s = sl2 * (float)STRIDE;
#pragma unroll
    for (int r = 0; r < 16; ++r) { float x = __builtin_fmaf(sl2s, (float)(16 * (r >> 3) + (r & 7)), tbm); asm volatile("" : "+v"(x)); S[r] = x; }
#pragma unroll
    for (int j = 0; j < 8; ++j) S = MFMA32(kf[j], qf[j], S);
}
template <int STRIDE>
DI void edge_mask(f32x16& S, int rel0, int lo) {
#pragma unroll
    for (int r = 0; r < 16; ++r) { const int rel = rel0 + STRIDE * (16 * (r >> 3) + (r & 7)); S[r] = (rel <= 0 && rel >= lo) ? S[r] : NEG; }
}
DI float tile_max(const f32x16& S) {
    float mx = S[0];
#pragma unroll
    for (int r = 1; r < 16; ++r) mx = fmaxf(mx, S[r]);
    return fmaxf(mx, shx(mx, 32));
}
DI void soft_fixed(f32x16& S, float& mref, float& l) {
    const bool unset = mref < -1e29f;
    if (__builtin_amdgcn_ballot_w64(unset) != 0ull) {
        const float mx = tile_max(S); const bool now = unset && (mx > -1e29f); const float d = now ? mx : 0.f;
#pragma unroll
        for (int r = 0; r < 16; ++r) S[r] -= d;
        mref = now ? mx : mref;
    }
    float sum = 0.f;
#pragma unroll
    for (int r = 0; r < 16; ++r) { S[r] = ex2(S[r]); sum += S[r]; }
    l += sum;
}
DI void v_load4(bf16x8 (&vf)[4], const LAS unsigned char* vl  ) {
#pragma unroll
    for (int i = 0; i < 4; ++i) vf[i] = *(const LAS bf16x8*)(vl + i * 1024);
    __builtin_amdgcn_sched_barrier(0);
}
DI void pack_p(const f32x16& Pm, u32x4& p0, u32x4& p1) {
    p0.x = pk2(Pm[0], Pm[1]); p0.y = pk2(Pm[2], Pm[3]); p0.z = pk2(Pm[4], Pm[5]); p0.w = pk2(Pm[6], Pm[7]);
    p1.x = pk2(Pm[8], Pm[9]); p1.y = pk2(Pm[10], Pm[11]); p1.z = pk2(Pm[12], Pm[13]); p1.w = pk2(Pm[14], Pm[15]);
}
DI void pv_mma(f32x16 (&O)[4], const u32x4& p0, const u32x4& p1, const bf16x8 (&va)[4], const bf16x8 (&vb)[4]) {
    const bf16x8 pb0 = __builtin_bit_cast(bf16x8, p0), pb1 = __builtin_bit_cast(bf16x8, p1);
#pragma unroll
    for (int dt = 0; dt < 2; ++dt) { O[dt] = MFMA32(va[2 * dt], pb0, O[dt]); O[dt] = MFMA32(va[2 * dt + 1], pb1, O[dt]); }
#pragma unroll
    for (int dt = 0; dt < 2; ++dt) { O[2 + dt] = MFMA32(vb[2 * dt], pb0, O[2 + dt]); O[2 + dt] = MFMA32(vb[2 * dt + 1], pb1, O[2 + dt]); }
}
DI void o_zero(f32x16 (&O)[4]) {
#pragma unroll
    for (int dt = 0; dt < 4; ++dt)
#pragma unroll
        for (int r = 0; r < 16; ++r) O[dt][r] = 0.f;
}
DI float dpp_xor1(float v) { return __builtin_bit_cast(float, __builtin_amdgcn_update_dpp(0, __builtin_bit_cast(int, v), 0xB1, 0xF, 0xF, true)); }
DI float dpp_xor2(float v) { return __builtin_bit_cast(float, __builtin_amdgcn_update_dpp(0, __builtin_bit_cast(int, v), 0x4E, 0xF, 0xF, true)); }
DI void lds_fadd(LAS float* p, float v) { (void)__hip_atomic_fetch_add(p, v, __ATOMIC_RELAXED, __HIP_MEMORY_SCOPE_WORKGROUP); }

struct TileCtx { const char *kc, *vc, *kw, *vw, *ks, *vs; int nt, nd, wlast, cur; const LAS unsigned char* clist; };
DI void tile_ptrs(const TileCtx& X, int idx, const char*& k, const char*& v) {
    if (idx < X.nt) { k = X.kc + (size_t)(X.nt - 1 - idx) * 8192; v = nullptr; }
    else if (idx < 2 * X.nt) { k = X.kc + (size_t)(2 * X.nt - 1 - idx) * 8192; v = X.vc + (size_t)(2 * X.nt - 1 - idx) * 8192; }
    else if (idx < 2 * X.nt + X.nd) { const int k0 = X.wlast - 32 * (idx - 2 * X.nt); k = X.kw + (size_t)k0 * 256; v = X.vw + (size_t)k0 * 256; }
    else { const int j = idx - 2 * X.nt - X.nd; const int b = (j < 2) ? X.cur : __builtin_amdgcn_readfirstlane((int)X.clist[j >> 1]); const int k0 = b * 64 + 32 * (1 - (j & 1)); k = X.ks + (size_t)k0 * 256; v = X.vs + (size_t)k0 * 256; }
}

DI void attn_wg_unit(const AttP& P, LAS unsigned char* lds, int wave, int lane, int c, int h) {
    LAS float* imp = (LAS float*)(lds + AT_IMP + wave * 4096);
    LAS unsigned* wun = (LAS unsigned*)(lds + AT_WUN);
    LAS unsigned char* clist = lds + AT_CLIST;
    LAS unsigned short* selw = (LAS unsigned short*)(lds + SELW_OFF + wave * 128);
    const int t0 = c * 64 + wave * 8;
    const int n = lane & 31, hi = lane >> 5, tok = n >> 2, gq = n & 3, t = t0 + tok, hq = h * 4 + gq;
    const unsigned koff = (unsigned)lane * 16u;
    const float sl2 = ex2(-0.5f * (float)(hq + 1)) * LOG2E;
    const int cur = c;
    bf16x8 qf[8];
    {
        const u32x4* qp = (const u32x4*)(P.QN + (size_t)t * NSAW + hq * 128 + 64 * hi);
        u32x4 qv[8];
#pragma unroll
        for (int j = 0; j < 8; ++j) qv[j] = qp[j];
        float ss = 0.f;
#pragma unroll
        for (int j = 0; j < 8; ++j) { float f[8]; unpack8(qv[j], f);
#pragma unroll
            for (int e = 0; e < 8; ++e) ss += f[e] * f[e]; }
        ss += shx(ss, 32);
        const float rs = (0.08838834764831845f * LOG2E) / sqrtf(ss * (1.f / 128.f) + EPS);
        const float* gp = P.qg + 64 * hi;
#pragma unroll
        for (int j = 0; j < 8; ++j) { float f[8]; unpack8(qv[j], f); const f32x4 g0 = *(const f32x4*)(gp + 8 * j), g1 = *(const f32x4*)(gp + 8 * j + 4);
            f[0] *= rs * g0.x; f[1] *= rs * g0.y; f[2] *= rs * g0.z; f[3] *= rs * g0.w; f[4] *= rs * g1.x; f[5] *= rs * g1.y; f[6] *= rs * g1.z; f[7] *= rs * g1.w;
            qf[j] = __builtin_bit_cast(bf16x8, pack8(f)); }
    }
#define AT_GATE(br) bflo((unsigned)*(const bf16*)(P.NG + (size_t)t * 256 + hq * 3 + (br)))
#define AT_OST() u32x2* ost; { int l2_ = lane; asm volatile("" : "+v"(l2_)); ost = (u32x2*)P.OST + ((size_t)(t0 >> 3) * 4 + h) * 1024 + l2_; }
    f32x16 O[4], S;
#pragma unroll
    for (int i = 0; i < 4; ++i) *(LAS f32x4*)(imp + (i * 64 + lane) * 4) = (f32x4){0.f, 0.f, 0.f, 0.f};

    TileCtx X;
    X.kc = (const char*)(P.KCN + (size_t)h * NCP * 128); X.vc = (const char*)(P.VCT + (size_t)h * 128 * NCP);
    X.kw = (const char*)(P.KWN + (size_t)h * T * 128); X.vw = (const char*)(P.VWT + (size_t)h * 128 * T);
    X.ks = (const char*)(P.KSN + (size_t)h * T * 128); X.vs = (const char*)(P.VST + (size_t)h * 128 * T);
    X.nt = ((((c * 64 + 63 - 31) >> 4) + 1) + 31) >> 5;
    X.wlast = c * 64 + 32; { const int wf = (c >= 8) ? 64 * (c - 8) : 0; X.nd = ((X.wlast - wf) >> 5) + 1; }
    X.clist = clist; X.cur = c;
    const int nvalid = (t0 + 7 >= 31) ? ((t0 + 7 - 31) >> 4) + 1 : 0, ntw = (nvalid + 31) >> 5;
    int kfw = t0 - 511; kfw = kfw < 0 ? 0 : (kfw & ~31); const int klw = t0 & ~31;
    const int nt = X.nt, nd = X.nd, S1 = 2 * nt + nd;
    int total = S1 + 2;
    unsigned un[4] = {0u, 0u, 0u, 0u};
    float m = NEG, l = 0.f, rl = 0.f, mu = 0.f;

    int idx = 0, pend = S1 + 2;
#define AT_ISSUE(ti) do { const char *k_, *v_; tile_ptrs(X, (ti), k_, v_); LAS unsigned char* nb_ = lds + AT_STG + ((ti) & 3) * 16384 + wave * 1024; \
        __builtin_amdgcn_global_load_lds((const unsigned*)(k_ + wave * 1024 + koff), (LAS unsigned*)nb_, 16, 0, 0); \
        __builtin_amdgcn_global_load_lds((const unsigned*)((v_ ? v_ : k_) + wave * 1024 + koff), (LAS unsigned*)(nb_ + 8192), 16, 0, 0); } while (0)
#define AT_SYNC() do { if (idx + 1 < pend) asm volatile("s_waitcnt vmcnt(2) lgkmcnt(0)\n\ts_barrier" ::: "memory"); else asm volatile("s_waitcnt vmcnt(0) lgkmcnt(0)\n\ts_barrier" ::: "memory"); } while (0)
#define AT_PREFETCH() do { if (idx + 2 < pend) AT_ISSUE(idx + 2); } while (0)
#define AT_VL(ti) (lds + AT_STG + ((ti) & 3) * 16384 + 8192 + koff)
#define AT_KL() (lds + AT_STG + (idx & 3) * 16384 + koff)
    asm volatile("s_waitcnt vmcnt(0) lgkmcnt(0)\n\ts_barrier" ::: "memory");
#pragma unroll 1
    for (int d = 0; d < 2; ++d) if (d < pend) AT_ISSUE(d);

#pragma unroll 1
    for (; idx < nt; ++idx) {
        AT_SYNC(); AT_PREFETCH();
        const LAS unsigned char* kl = AT_KL();
        const int ti = nt - 1 - idx, k0 = ti * 32, rel0 = 16 * (k0 + 8 * hi) + 31 - t;
        qk_tile<16>(S, qf, kl, sl2, sl2 * (float)rel0 - ((m < -1e29f) ? 0.f : m));
        if (ti >= ntw - 1) edge_mask<16>(S, rel0, -(1 << 30));
        soft_fixed(S, m, l);
    }
    { const float lt = l + shx(l, 32); const bool have = m > -1e29f; rl = have ? 1.f / lt : 0.f; mu = have ? m : 0.f; }
    o_zero(O);
    int pidx = idx; u32x4 pp0 = {0u, 0u, 0u, 0u}, pp1 = {0u, 0u, 0u, 0u};
#pragma unroll 1
    for (; idx < 2 * nt; ++idx) {
        AT_SYNC(); AT_PREFETCH();
        const LAS unsigned char* kl = AT_KL();
        const int ti = 2 * nt - 1 - idx, k0 = ti * 32, rel0 = 16 * (k0 + 8 * hi) + 31 - t;
        bf16x8 va[4], vb[4]; v_load4(va, AT_VL(pidx));
        qk_tile<16>(S, qf, kl, sl2, sl2 * (float)rel0 - mu);
        v_load4(vb, AT_VL(pidx) + 4096);
        pv_mma(O, pp0, pp1, va, vb);
        if (ti >= ntw - 1) edge_mask<16>(S, rel0, -(1 << 30));
#pragma unroll
        for (int r = 0; r < 16; ++r) S[r] = ex2(S[r]) * rl;
#pragma unroll
        for (int q4 = 0; q4 < 4; ++q4) { float v[4];
#pragma unroll
            for (int e = 0; e < 4; ++e) { float x = S[4 * q4 + e]; x += dpp_xor1(x); x += dpp_xor2(x); v[e] = x; }
            if (gq == 0) { const int j = (k0 >> 2) + 4 * (q4 >> 1) + 2 * hi + (q4 & 1);
                lds_fadd(imp + tok * 128 + j, 2.f * (v[0] + v[1] + v[2]) + v[3]); if (j + 1 < 128) lds_fadd(imp + tok * 128 + j + 1, v[3]); } }
        const float gc = AT_GATE(0);
#pragma unroll
        for (int r = 0; r < 16; ++r) S[r] *= gc;
        pack_p(S, pp0, pp1); pidx = idx;
    }
    { bf16x8 va[4], vb[4]; v_load4(va, AT_VL(pidx)); v_load4(vb, AT_VL(pidx) + 4096); pv_mma(O, pp0, pp1, va, vb); }
    {
        LDS_WAIT(); asm volatile("" ::: "memory");
        int l5 = lane; asm volatile("" : "+v"(l5));
        const int tk = l5 >> 3, sub = l5 & 7; const LAS float* pb = imp + tk * 128 + sub * 16;
        unsigned key[16];
#pragma unroll
        for (int i4 = 0; i4 < 4; ++i4) { const f32x4 q = *(const LAS f32x4*)(pb + 4 * i4);
#pragma unroll
            for (int e = 0; e < 4; ++e) { const int i = 4 * i4 + e, j = sub * 16 + i; const float iv = (e == 0) ? q.x : (e == 1) ? q.y : (e == 2) ? q.z : q.w;
                const bool valid = j <= cur, forced = (j == 0) || (j == cur) || (j == cur - 1);
                const unsigned ib = ((__builtin_bit_cast(unsigned, iv) & 0x7fffff00u) | (unsigned)(255 - j));
                key[i] = !valid ? 0u : (forced ? (0x7f000000u | (unsigned)(255 - j)) : ib); } }
        const int R = (cur + 1 < 16) ? cur + 1 : 16; unsigned sel = 0u;
        for (int rd = 0; rd < R; ++rd) {
            unsigned mx = key[0];
#pragma unroll
            for (int i = 1; i < 16; ++i) mx = mx > key[i] ? mx : key[i];
            { unsigned ot = (unsigned)__builtin_amdgcn_update_dpp(0, (int)mx, 0xB1, 0xF, 0xF, true); mx = mx > ot ? mx : ot;
              ot = (unsigned)__builtin_amdgcn_update_dpp(0, (int)mx, 0x4E, 0xF, 0xF, true); mx = mx > ot ? mx : ot;
              ot = (unsigned)__builtin_amdgcn_update_dpp(0, (int)mx, 0x141, 0xF, 0xF, true); mx = mx > ot ? mx : ot; }
#pragma unroll
            for (int i = 0; i < 16; ++i) { const bool hit = (key[i] == mx); sel |= hit ? (1u << i) : 0u; key[i] = hit ? 0u : key[i]; }
        }
        selw[tk * 8 + sub] = (unsigned short)sel;
        LDS_WAIT(); asm volatile("" ::: "memory");
        const LAS u32x4* sw = (const LAS u32x4*)selw;
        u32x4 uu = sw[0];
#pragma unroll
        for (int k = 1; k < 8; ++k) { const u32x4 o = sw[k]; uu.x |= o.x; uu.y |= o.y; uu.z |= o.z; uu.w |= o.w; }
        un[0] = __builtin_amdgcn_readfirstlane(uu.x); un[1] = __builtin_amdgcn_readfirstlane(uu.y); un[2] = __builtin_amdgcn_readfirstlane(uu.z); un[3] = __builtin_amdgcn_readfirstlane(uu.w);
        if (lane == 0) *(LAS u32x4*)(wun + 4 * wave) = (u32x4){un[0], un[1], un[2], un[3]};
        AT_OST();
#pragma unroll
        for (int i = 0; i < 4; ++i) *(LAS f32x4*)(imp + (i * 64 + lane) * 4) = (f32x4){0.f, 0.f, 0.f, 0.f};
#pragma unroll
        for (int q = 0; q < 16; ++q) { u32x2 w_; w_.x = pk2(O[q >> 2][4 * (q & 3)], O[q >> 2][4 * (q & 3) + 1]); w_.y = pk2(O[q >> 2][4 * (q & 3) + 2], O[q >> 2][4 * (q & 3) + 3]); ost[q * 64] = w_;
            if ((q & 3) == 3) asm volatile("" ::: "memory"); }
    }
    o_zero(O); m = NEG; l = 0.f;
    pidx = idx; pp0 = (u32x4){0u, 0u, 0u, 0u}; pp1 = pp0;
#define AT_D_HEAD() \
        AT_SYNC(); AT_PREFETCH(); \
        const LAS unsigned char* kl = AT_KL(); \
        const int k0 = X.wlast - 32 * (idx - 2 * nt); \
        const int rel0 = k0 + 8 * hi - t; const bool edge = (k0 + 31 > t0) || (k0 + 511 < t0 + 7)
    if (wave < 4) {
#pragma unroll 1
        for (; idx < S1; ++idx) {
            AT_D_HEAD();
            bf16x8 va[4], vb[4]; v_load4(va, AT_VL(pidx));
            qk_tile<1>(S, qf, kl, sl2, sl2 * (float)rel0 - ((m < -1e29f) ? 0.f : m));
            v_load4(vb, AT_VL(pidx) + 4096);
            pv_mma(O, pp0, pp1, va, vb);
            if (edge) edge_mask<1>(S, rel0, -511);
            soft_fixed(S, m, l); pack_p(S, pp0, pp1); pidx = idx;
        }
    } else {
#pragma unroll
        for (int r = 0; r < 16; ++r) S[r] = NEG;
        int prel0 = 0; bool pedge = false;
#pragma unroll 1
        for (; idx < S1; ++idx) {
            AT_D_HEAD();
            if (pedge) edge_mask<1>(S, prel0, -511);
            soft_fixed(S, m, l); pack_p(S, pp0, pp1);
            { bf16x8 va[4], vb[4]; v_load4(va, AT_VL(pidx)); v_load4(vb, AT_VL(pidx) + 4096); pv_mma(O, pp0, pp1, va, vb); }
            qk_tile<1>(S, qf, kl, sl2, sl2 * (float)rel0 - ((m < -1e29f) ? 0.f : m));
            pidx = idx; prel0 = rel0; pedge = edge;
        }
        if (pedge) edge_mask<1>(S, prel0, -511);
        soft_fixed(S, m, l); pack_p(S, pp0, pp1);
    }
#undef AT_D_HEAD
    { bf16x8 va[4], vb[4]; v_load4(va, AT_VL(pidx)); v_load4(vb, AT_VL(pidx) + 4096); pv_mma(O, pp0, pp1, va, vb); }
    {
        AT_OST();
        const float lt = l + shx(l, 32), cw = AT_GATE(2) / lt;
        asm volatile("s_waitcnt vmcnt(0)" ::: "memory");
#pragma unroll
        for (int q = 0; q < 16; ++q) { const u32x2 sw_ = ost[q * 64]; u32x2 w_;
            w_.x = pk2(bflo(sw_.x) + cw * O[q >> 2][4 * (q & 3)], bfhi(sw_.x) + cw * O[q >> 2][4 * (q & 3) + 1]); w_.y = pk2(bflo(sw_.y) + cw * O[q >> 2][4 * (q & 3) + 2], bfhi(sw_.y) + cw * O[q >> 2][4 * (q & 3) + 3]); ost[q * 64] = w_;
            if ((q & 3) == 3) asm volatile("" ::: "memory"); }
    }
    o_zero(O); m = NEG; l = 0.f;
    {
        u32x4 uu = *(const LAS u32x4*)(wun);
#pragma unroll
        for (int k = 1; k < 8; ++k) { const u32x4 o = *(const LAS u32x4*)(wun + 4 * k); uu.x |= o.x; uu.y |= o.y; uu.z |= o.z; uu.w |= o.w; }
        const unsigned u0 = __builtin_amdgcn_readfirstlane(uu.x), u1 = __builtin_amdgcn_readfirstlane(uu.y), u2 = __builtin_amdgcn_readfirstlane(uu.z), u3 = __builtin_amdgcn_readfirstlane(uu.w);
        const int ncu = __builtin_popcount(u0) + __builtin_popcount(u1) + __builtin_popcount(u2) + __builtin_popcount(u3);
        total = S1 + 2 * ncu;
#pragma unroll
        for (int rr = 0; rr < 2; ++rr) { const int b = lane + 64 * rr;
            const unsigned wb = (b < 32) ? u0 : (b < 64) ? u1 : (b < 96) ? u2 : u3;
            if ((wb >> (b & 31)) & 1u) {
                int above = __builtin_popcount(wb >> (b & 31)) - 1;
                if (b < 96) above += __builtin_popcount(u3); if (b < 64) above += __builtin_popcount(u2); if (b < 32) above += __builtin_popcount(u1);
                clist[above] = (unsigned char)b; } }
        LDS_WAIT(); asm volatile("" ::: "memory");
    }
    pend = total;
    pidx = idx; pp0 = (u32x4){0u, 0u, 0u, 0u}; pp1 = pp0;
    {
        const int ncu2 = (total - S1) >> 1;
        int bc = cur;
        unsigned mc = ((const LAS unsigned*)selw)[tok * 4 + (bc >> 5)];
        unsigned bn_raw = (ncu2 > 1) ? (unsigned)clist[1] : (unsigned)cur;
#define AT_C_HEAD() \
            AT_SYNC(); \
            const int j = idx - S1, half = 1 - (j & 1); \
            const int bn = __builtin_amdgcn_readfirstlane((int)bn_raw); \
            if (idx + 2 < pend) { \
                const int k2 = bn * 64 + 32 * half; LAS unsigned char* nb_ = lds + AT_STG + ((idx + 2) & 3) * 16384 + wave * 1024; \
                __builtin_amdgcn_global_load_lds((const unsigned*)(X.ks + (size_t)k2 * 256 + wave * 1024 + koff), (LAS unsigned*)nb_, 16, 0, 0); \
                __builtin_amdgcn_global_load_lds((const unsigned*)(X.vs + (size_t)k2 * 256 + wave * 1024 + koff), (LAS unsigned*)(nb_ + 8192), 16, 0, 0); } \
            const LAS unsigned char* kl = AT_KL(); \
            const int k0 = bc * 64 + 32 * half; const bool rok = (mc >> (bc & 31)) & 1u; \
            const int rel0 = k0 + 8 * hi - t
#define AT_C_TAIL() \
            if (half == 0) { const int jb = j >> 1; bc = bn; mc = ((const LAS unsigned*)selw)[tok * 4 + (bc >> 5)]; bn_raw = (jb + 2 < ncu2) ? (unsigned)clist[jb + 2] : (unsigned)cur; }
        if (wave < 4) {
#pragma unroll 1
            for (; idx < total; ++idx) {
                AT_C_HEAD();
                bf16x8 va[4], vb[4]; v_load4(va, AT_VL(pidx));
                qk_tile<1>(S, qf, kl, sl2, rok ? (sl2 * (float)rel0 - ((m < -1e29f) ? 0.f : m)) : NEG);
                v_load4(vb, AT_VL(pidx) + 4096);
                pv_mma(O, pp0, pp1, va, vb);
                if (bc == cur) edge_mask<1>(S, rel0, -(1 << 30));
                soft_fixed(S, m, l); pack_p(S, pp0, pp1); pidx = idx;
                AT_C_TAIL();
            }
        } else {
#pragma unroll
            for (int r = 0; r < 16; ++r) S[r] = NEG;
            int prel0 = 0; bool pedge = false;
#pragma unroll 1
            for (; idx < total; ++idx) {
                AT_C_HEAD();
                if (pedge) edge_mask<1>(S, prel0, -(1 << 30));
                soft_fixed(S, m, l); pack_p(S, pp0, pp1);
                { bf16x8 va[4], vb[4]; v_load4(va, AT_VL(pidx)); v_load4(vb, AT_VL(pidx) + 4096); pv_mma(O, pp0, pp1, va, vb); }
                qk_tile<1>(S, qf, kl, sl2, rok ? (sl2 * (float)rel0 - ((m < -1e29f) ? 0.f : m)) : NEG);
                pidx = idx; prel0 = rel0; pedge = (bc == cur);
                AT_C_TAIL();
            }
            if (pedge) edge_mask<1>(S, prel0, -(1 << 30));
            soft_fixed(S, m, l); pack_p(S, pp0, pp1);
        }
#undef AT_C_HEAD
#undef AT_C_TAIL
    }
    { bf16x8 va[4], vb[4]; v_load4(va, AT_VL(pidx)); v_load4(vb, AT_VL(pidx) + 4096); pv_mma(O, pp0, pp1, va, vb); }
#undef AT_SYNC
#undef AT_PREFETCH
#undef AT_KL
#undef AT_VL
#undef AT_ISSUE
    {
        AT_OST();
        const float lt = l + shx(l, 32), cs = AT_GATE(1) / lt;
        asm volatile("s_waitcnt vmcnt(0)" ::: "memory");
        LAS unsigned char* tb = (LAS unsigned char*)imp;
        int l4 = lane; asm volatile("" : "+v"(l4)); const int n4 = l4 & 31, hi4 = l4 >> 5;
#pragma unroll
        for (int ph = 0; ph < 2; ++ph) {
#pragma unroll
            for (int q8 = 0; q8 < 8; ++q8) { const int q = 8 * ph + q8; const u32x2 sw_ = ost[q * 64]; const f32x4 sv = (f32x4){bflo(sw_.x), bfhi(sw_.x), bflo(sw_.y), bfhi(sw_.y)};
                const float o0 = sv.x + cs * O[q >> 2][4 * (q & 3)], o1 = sv.y + cs * O[q >> 2][4 * (q & 3) + 1], o2 = sv.z + cs * O[q >> 2][4 * (q & 3) + 2], o3 = sv.w + cs * O[q >> 2][4 * (q & 3) + 3];
                const int byte = (32 * (q8 >> 2) + 8 * (q8 & 3) + 4 * hi4) * 2;
                u32x2 w; w.x = pk2(o0, o1); w.y = pk2(o2, o3);
                *(LAS u32x2*)(tb + n4 * 128 + ((((byte >> 4) ^ (n4 & 7)) << 4) | (byte & 15))) = w;
                if (q8 & 1) asm volatile("" ::: "memory"); }
            LDS_WAIT(); asm volatile("" ::: "memory");
#pragma unroll
            for (int k = 0; k < 4; ++k) { const int p = l4 + 64 * k, row = p >> 3, ch = p & 7;
                const u32x4 ov = *(const LAS u32x4*)(tb + row * 128 + ((ch ^ (row & 7)) << 4));
                const size_t go = (size_t)(t0 + (row >> 2)) * NSAW + (h * 4 + (row & 3)) * 128 + 64 * ph + 8 * ch;
                const u32x4 zv = *(const u32x4*)(P.ZN + go); float of[8], zf[8]; unpack8(ov, of); unpack8(zv, zf);
#pragma unroll
                for (int e = 0; e < 8; ++e) of[e] *= zf[e];
                *(u32x4*)(P.NO + go) = pack8(of);
                if (k & 1) asm volatile("" ::: "memory"); }
            LDS_WAIT(); asm volatile("" ::: "memory");
        }
#pragma unroll
        for (int i = 0; i < 4; ++i) *(LAS f32x4*)(imp + (i * 64 + lane) * 4) = (f32x4){0.f, 0.f, 0.f, 0.f};
    }
}
#undef AT_GATE
DI void p4_attention(const AttP& P, LAS unsigned char* lds, int G, int wave, int lane) {
    for (int w = blockIdx.x; w < 256; w += G) {
        const int h = w & 3, p = w >> 2;
#pragma unroll 1
        for (int k = 0; k < 2; ++k) attn_wg_unit(P, lds, wave, lane, k ? p : 127 - p, h);
    }
    asm volatile("s_waitcnt vmcnt(0) lgkmcnt(0)\n\ts_barrier" ::: "memory");
}

__global__ void __launch_bounds__(NTHR, 2) mega_fwd(Args args) {
    extern __shared__ __attribute__((aligned(16))) unsigned char lds_raw[];
    LAS unsigned char* lds = (LAS unsigned char*)lds_raw;
    const int tid0 = threadIdx.x;
    const int wave0 = __builtin_amdgcn_readfirstlane(tid0 >> 6);
    const int G = gridDim.x, bx = blockIdx.x;
    const int vcu = (G % 8 == 0) ? (bx % 8) * (G / 8) + bx / 8 : bx;
    const int NGW = G * NWAVES;
    unsigned char* const ws0 = args.ws;
    gu32* ctl = (gu32*)(ws0 + WS_CTL);
    for (int u = tid0; u < (LDS_BYTES - LDSCTL_OFF) / 4; u += NTHR) ((LAS unsigned*)(lds + LDSCTL_OFF))[u] = 0u;
    __syncthreads();
    volatile LAS unsigned* MISC = (volatile LAS unsigned*)(lds + MISC_OFF);
    XcdBarrier bar; bar.bar = (unsigned*)(ctl + CW_BAR); bar.x = 0; bar.st = nullptr;
    if (!MK_MULTI) bar = xcd_barrier_post((unsigned*)(ctl + CW_BAR), MISC + 8);
    const int lo = args.st_lo, hi = args.st_hi;
#define IN(k) (lo <= (k) && (k) < hi)
#ifdef PROBE_PH
    unsigned long long pr_acc = 0ull, pr_t0 = 0ull;
#define PR_B(p) do { if ((p) == PROBE_PH) pr_t0 = __builtin_amdgcn_s_memrealtime(); } while (0)
#define PR_E(p) do { if ((p) == PROBE_PH) pr_acc += __builtin_amdgcn_s_memrealtime() - pr_t0; } while (0)
#else
#define PR_B(p) do {} while (0)
#define PR_E(p) do {} while (0)
#endif
#ifndef REP_PH
#define REP_PH -1
#endif
#define REPS(p) for (int rep_ = 0; rep_ < ((p) == REP_PH ? 2 : 1); ++rep_)
#define LAUNDER_WS() unsigned char* ws = ws0; asm volatile("" : "+s"(ws)); int wave = wave0; asm volatile("" : "+s"(wave)); int lane; asm volatile("v_mbcnt_lo_u32_b32 %0, -1, 0\n\tv_mbcnt_hi_u32_b32 %0, -1, %0" : "=v"(lane)); const int tid = wave * 64 + lane, gw = vcu * NWAVES + wave; (void)tid; (void)gw
#ifndef PH_MASK
#define PH_MASK 0x7f
#endif
#define PH_ON(p) ((PH_MASK >> (p)) & 1)
#define SEAM(k) do { if ((k) + 1 < hi) xcd_barrier(bar); } while (0)

    if (PH_ON(0) && IN(0)) REPS(0) { PR_B(0); LAUNDER_WS(); prologue(args, lds, gw, NGW, wave, lane, G == 256);
        if (IN(1)) p1_xb(args.in[0], (bf16*)(ws + WS_H), (float*)(ws + WS_SS), gw, NGW, lane);
        SEAM(0); PR_E(0); }

    for (int l = 0; l < DEPTH; ++l) {
        const int s0 = 1 + 6 * l;
        if (s0 + 6 <= lo || s0 >= hi) continue;
        if (PH_ON(1) && IN(s0) && l == 0 && !IN(0)) REPS(1) { PR_B(1); LAUNDER_WS(); p1_xb(args.in[0], (bf16*)(ws + WS_H), (float*)(ws + WS_SS), gw, NGW, lane); SEAM(s0); PR_E(1); }
        if (PH_ON(2) && IN(s0 + 1)) REPS(2) {
            PR_B(2);
            LAUNDER_WS(); bf16* Hb = (bf16*)(ws + WS_H);
            pg8::Gemm g{DM, DM, DM};
            pg8::SchedPlain S{(const char*)Hb, (const char*)(ws + WS_WIN + l * SZ_WIN), 32, NINT, G, bx, (size_t)256 * DM * 2, (size_t)256 * DM * 2, WGM_IN};
            { pg8::Unit u0; if (S.next(0, u0)) {
                const f32x4* sp = (const f32x4*)((const float*)(ws + WS_SS) + ((size_t)u0.pm * 256 + (tid >> 1)) * 64 + (tid & 1) * 32); float sq = 0.f;
#pragma unroll
                for (int j = 0; j < 8; ++j) { const f32x4 q4 = sp[j]; sq += (q4.x + q4.y) + (q4.z + q4.w); }
                sq += shx(sq, 1);
                if (!(tid & 1)) ((LAS float*)(lds + RS_OFF))[tid >> 1] = 1.f / sqrtf(sq * (1.f / DM) + EPS); }
              __syncthreads(); }
            pg8::EpiIn E{(bf16*)(ws + WS_U), (bf16*)(ws + WS_ZP), (bf16*)(ws + WS_QR), (bf16*)(ws + WS_ZN), (bf16*)(ws + WS_KV6), (bf16*)(ws + WS_GM), (bf16*)(ws + WS_NG), args.in[3] + (size_t)l * 2 * DM, (const LAS float*)(lds + RS_OFF)};
            pg8::gemm_phase<pg8::EpiIn, pg8::SchedPlain, true>(lds, g, S, E, tid);
            if (G == 256 && bx >= OFF_FIRST && l + 1 < DEPTH && rep_ == 0) slack_convert(args, lds, l + 1, bx, wave, lane);
            SEAM(s0 + 1);
            PR_E(2);
        }
        if (PH_ON(3) && IN(s0 + 2)) REPS(3) {
            PR_B(3);
            LAUNDER_WS();
            CmpP C{(const bf16*)(ws + WS_KV6), args.in[8] + (size_t)l * 2 * 4096, (const bf16*)(ws + WS_W1 + l * SZ_W1), args.in[10] + (size_t)l * 2 * 128, (const bf16*)(ws + WS_W2 + l * SZ_W2),
                   args.in[7] + (size_t)l * 3 * 128, (bf16*)(ws + WS_KCN), (bf16*)(ws + WS_VCT)};
            p3_compress(C, lds, G, tid, wave, lane);
            MidP M{(const bf16*)(ws + WS_U), (const bf16*)(ws + WS_QR), (const bf16*)(ws + WS_KV6), (bf16*)(ws + WS_MP), (bf16*)(ws + WS_QN), (bf16*)(ws + WS_KSN), (bf16*)(ws + WS_KWN),
                   (bf16*)(ws + WS_VST), (bf16*)(ws + WS_VWT), args.in[6] + (size_t)l * 128, args.in[7] + (size_t)l * 3 * 128};
            p3_mid(M, lds, gw, NGW, wave, lane);
            SEAM(s0 + 2);
            PR_E(3);
        }
        if (PH_ON(4) && IN(s0 + 3)) REPS(4) {
            PR_B(4);
            LAUNDER_WS();
            {
                pg8::Gemm g{PW, 512, 512};
                pg8::SchedPool S{(const char*)(ws + WS_MP), (const char*)(ws + WS_POOLW + l * SZ_POOLW), G, bx};
                pg8::EpiPool E{(bf16*)(ws + WS_PO), (const bf16*)(ws + WS_ZP), args.in[5] + (size_t)l * PW};
                pg8::gemm_phase<pg8::EpiPool, pg8::SchedPool, false>(lds, g, S, E, tid);
            }
            __syncthreads();
            AttP A{(const bf16*)(ws + WS_QR), (const bf16*)(ws + WS_KCN), (const bf16*)(ws + WS_VCT), (const bf16*)(ws + WS_KSN), (const bf16*)(ws + WS_VST), (const bf16*)(ws + WS_KWN), (const bf16*)(ws + WS_VWT),
                   (const bf16*)(ws + WS_NG), (const bf16*)(ws + WS_ZN), (bf16*)(ws + WS_NO), (float*)(ws + WS_OST), args.in[6] + (size_t)l * 128};
#ifdef REP_ATT
            { int nra = 2; asm volatile("" : "+s"(nra));
#pragma unroll 1
              for (int ra = 0; ra < nra; ++ra) p4_attention(A, lds, G, wave, lane); }
#else
            p4_attention(A, lds, G, wave, lane);
#endif
            SEAM(s0 + 3);
            PR_E(4);
        }
        if (PH_ON(5) && IN(s0 + 4)) REPS(5) {
            PR_B(5);
            LAUNDER_WS();
            pg8::Gemm g{PW, PW, PW};
            pg8::SchedUp S{(const char*)(ws + WS_PO), (const char*)(ws + WS_NO), (const char*)(ws + WS_WPU + l * SZ_WUP), (const char*)(ws + WS_WNU + l * SZ_WUP), G, bx};
            pg8::EpiUp E{(bf16*)(ws + WS_Y), (const bf16*)(ws + WS_GM), (const bf16*)(ws + WS_GM) + (size_t)T * DM};
            pg8::gemm_phase<pg8::EpiUp, pg8::SchedUp, true>(lds, g, S, E, tid);
            SEAM(s0 + 4);
            PR_E(5);
        }
        if (PH_ON(6) && IN(s0 + 5)) REPS(6) {
            PR_B(6);
            LAUNDER_WS();
            pg8::Gemm g{DM, DM, DM};
            pg8::SchedPlain S{(const char*)(ws + WS_Y), (const char*)(ws + WS_WOUT + l * SZ_WOUT), 32, 16, G, bx, (size_t)256 * DM * 2, (size_t)256 * DM * 2, WGM_OUT};
            const bool dry = (REP_PH == 6 && rep_ == 0);
            pg8::EpiOut E{args.in[0], (const bf16*)(ws + WS_H), (bf16*)(ws + (dry ? WS_GM : WS_H)), (float*)(ws + (dry ? WS_GM + ((size_t)T * DM * 2) : WS_SS)), dry ? (float*)(ws + WS_GM) : args.out, l == 0 ? 0 : (l == DEPTH - 1 ? 2 : 1)};
            pg8::gemm_phase<pg8::EpiOut, pg8::SchedPlain, true>(lds, g, S, E, tid);
            SEAM(s0 + 5);
            PR_E(6);
        }
    }
#ifdef PROBE_PH
    xcd_barrier(bar);
    if (blockIdx.x == 0 && threadIdx.x == 0) args.out[0] = (float)pr_acc * 0.01f;
#endif
#undef IN
#undef SEAM
}

extern "C" void kernel_launch(void* const* d_in, const int* in_sizes, int n_in, void* d_out, int out_size, void* d_ws, size_t ws_size, hipStream_t stream) {
    static int grid = 0;
    if (grid == 0) {
        if (n_in != 15 || out_size != T * DM || ws_size < WS_END) { fprintf(stderr, "kernel_launch: unexpected shapes (n_in %d out %d ws %zu need %zu)\n", n_in, out_size, ws_size, (size_t)WS_END); grid = -1; return; }
        int dev = 0, cus = 0, per_cu = 0;
        if (hipGetDevice(&dev) != hipSuccess || hipDeviceGetAttribute(&cus, hipDeviceAttributeMultiprocessorCount, dev) != hipSuccess) { grid = -1; return; }
        if (hipFuncSetAttribute((const void*)mega_fwd, hipFuncAttributeMaxDynamicSharedMemorySize, LDS_BYTES) != hipSuccess) { fprintf(stderr, "kernel_launch: hipFuncSetAttribute failed\n"); grid = -1; return; }
        if (hipOccupancyMaxActiveBlocksPerMultiprocessor(&per_cu, (const void*)mega_fwd, NTHR, LDS_BYTES) != hipSuccess || per_cu < 1) { fprintf(stderr, "kernel_launch: occupancy query says %d\n", per_cu); }
        (void)hipGetLastError();
        grid = cus;
    }
    if (grid < 0) return;
    (void)hipMemsetAsync((char*)d_ws + WS_CTL, 0, CTL_ZERO_BYTES, stream);
    Args a{};
    for (int i = 0; i < 15; ++i) a.in[i] = (const float*)d_in[i];
    a.out = (float*)d_out; a.ws = (unsigned char*)d_ws;
    constexpr int NSTEP = 1 + 6 * DEPTH;
#if MK_MULTI
    for (int s = 0; s < NSTEP; ++s) { a.st_lo = s; a.st_hi = s + 1; hipLaunchKernelGGL(mega_fwd, dim3(grid), dim3(NTHR), LDS_BYTES, stream, a); }
#else
    a.st_lo = 0; a.st_hi = NSTEP;
    hipLaunchKernelGGL(mega_fwd, dim3(grid), dim3(NTHR), LDS_BYTES, stream, a);
#endif
    const hipError_t le = hipPeekAtLastError();
    if (le != hipSuccess) fprintf(stderr, "kernel_launch: launch failed: %s\n", hipGetErrorName(le));
}
```

```cpp
#include <hip/hip_runtime.h>
#include <cstdio>
#include <cstdint>

#ifndef WGM_IN
#define WGM_IN 4
#endif
#ifndef WGM_UP
#define WGM_UP 4
#endif
#ifndef WGM_OUT
#define WGM_OUT 4
#endif
#ifndef MK_MULTI
#define MK_MULTI 0
#endif

#define DI __device__ __forceinline__
#define GAS __attribute__((address_space(1)))
#define LAS __attribute__((address_space(3)))
typedef unsigned short bf16;
typedef short bf16x8 __attribute__((ext_vector_type(8)));
typedef float f32x2 __attribute__((ext_vector_type(2)));
typedef float f32x4 __attribute__((ext_vector_type(4)));
typedef float f32x16 __attribute__((ext_vector_type(16)));
typedef unsigned u32x2 __attribute__((ext_vector_type(2)));
typedef unsigned u32x4 __attribute__((ext_vector_type(4)));
typedef __bf16 bf16x2_t __attribute__((ext_vector_type(2)));
typedef GAS unsigned gu32;

constexpr int T = 8192, DM = 4096, PW = 2048, NSAW = 2048, KVW = 512, HD = 128, NQH = 16, NKVH = 4, DEPTH = 4;
constexpr int NIN = 19504, NPAD = 19712, NINT = NPAD / 256;
constexpr int KV6W = 3072;
constexpr int NCP = 512;
constexpr float EPS = 1e-6f, NEG = -1e30f, LOG2E = 1.4426950408889634f;
constexpr int NWAVES = 8, NTHR = 512;

constexpr size_t al256(size_t x) { return (x + 255) & ~(size_t)255; }
constexpr size_t WS_CTL = 0, CTL_ZERO_BYTES = 65536;
constexpr size_t SZ_WIN = (size_t)NPAD * DM * 2, SZ_POOLW = (size_t)4 * 512 * 512 * 2, SZ_WUP = (size_t)DM * PW * 2, SZ_WOUT = (size_t)DM * DM * 2;
constexpr size_t SZ_W1 = (size_t)2 * 128 * 4096 * 2, SZ_W2 = (size_t)2 * 128 * 128 * 2;
constexpr size_t WS_WIN = 1u << 20;
constexpr size_t WS_POOLW = WS_WIN + DEPTH * SZ_WIN;
constexpr size_t WS_WPU = WS_POOLW + DEPTH * SZ_POOLW;
constexpr size_t WS_WNU = WS_WPU + DEPTH * SZ_WUP;
constexpr size_t WS_WOUT = WS_WNU + DEPTH * SZ_WUP;
constexpr size_t WS_W1 = WS_WOUT + DEPTH * SZ_WOUT;
constexpr size_t WS_W2 = WS_W1 + DEPTH * SZ_W1;
constexpr size_t WS_H = WS_W2 + DEPTH * SZ_W2;
constexpr size_t WS_U = WS_H + (size_t)T * DM * 2;
constexpr size_t WS_ZP = WS_U + (size_t)T * PW * 2;
constexpr size_t WS_QR = WS_ZP + (size_t)T * PW * 2;
constexpr size_t WS_ZN = WS_QR + (size_t)T * NSAW * 2;
constexpr size_t WS_KV6 = WS_ZN + (size_t)T * NSAW * 2;
constexpr size_t WS_GM = WS_KV6 + (size_t)T * KV6W * 2;
constexpr size_t WS_NG = WS_GM + (size_t)T * 8192 * 2;
constexpr size_t WS_MP = WS_NG + (size_t)T * 256 * 2;
constexpr size_t WS_QN = WS_MP + (size_t)T * PW * 2;
constexpr size_t WS_KSN = WS_QN + (size_t)T * NSAW * 2;
constexpr size_t WS_KWN = WS_KSN + (size_t)4 * T * 128 * 2;
constexpr size_t WS_VST = WS_KWN + (size_t)4 * T * 128 * 2;
constexpr size_t WS_VWT = WS_VST + (size_t)4 * T * 128 * 2;
constexpr size_t WS_KCN = WS_VWT + (size_t)4 * T * 128 * 2;
constexpr size_t WS_VCT = WS_KCN + (size_t)4 * NCP * 128 * 2;
constexpr size_t WS_PO = WS_VCT + (size_t)4 * NCP * 128 * 2;
constexpr size_t WS_NO = WS_PO + (size_t)T * PW * 2;
constexpr size_t WS_Y = WS_NO + (size_t)T * NSAW * 2;
constexpr size_t WS_OST = WS_Y + (size_t)T * DM * 2;
static_assert(WS_ZP == WS_U + (size_t)T * PW * 2 && WS_QR == WS_ZP + (size_t)T * PW * 2 && WS_ZN == WS_QR + (size_t)T * NSAW * 2, "U | ZP | QR | ZN consecutive");
constexpr size_t WS_SS = WS_OST + (size_t)T * NSAW * 4;
constexpr size_t WS_END = WS_SS + (size_t)T * 64 * 4;
constexpr int CW_BAR = 4096;

constexpr int RING_BYTES = 131072, LDSCTL_OFF = 140288  , MISC_OFF = LDSCTL_OFF + 320, SELW_OFF = LDSCTL_OFF + 2048, LDS_BYTES = 147456, RS_OFF = RING_BYTES  ;

#define RLX_AGENT __ATOMIC_RELAXED, __HIP_MEMORY_SCOPE_AGENT
#define LDS_WAIT() asm volatile("s_waitcnt lgkmcnt(0)" ::: "memory")
DI unsigned f2bf(float f) { unsigned u = __builtin_bit_cast(unsigned, f); return (u + 0x7fffu + ((u >> 16) & 1u)) >> 16; }
DI unsigned pk2(float lo, float hi) { f32x2 v = {lo, hi}; bf16x2_t b = __builtin_convertvector(v, bf16x2_t); return __builtin_bit_cast(unsigned, b); }
DI float bflo(unsigned u) { return __builtin_bit_cast(float, u << 16); }
DI float bfhi(unsigned u) { return __builtin_bit_cast(float, u & 0xffff0000u); }
DI float ex2(float x) { return __builtin_amdgcn_exp2f(x); }
DI float rcpf(float x) { return __builtin_amdgcn_rcpf(x); }
DI float sigm(float v) { return rcpf(1.f + ex2(-v * LOG2E)); }
DI float shx(float v, int mask) {
    int ln; asm volatile("v_mbcnt_lo_u32_b32 %0, -1, 0\n\tv_mbcnt_hi_u32_b32 %0, -1, %0" : "=v"(ln));
    return __builtin_bit_cast(float, __builtin_amdgcn_ds_bpermute((ln ^ mask) << 2, __builtin_bit_cast(int, v)));
}
DI float wave_sum(float v) {
#pragma unroll
    for (int o = 1; o < 64; o <<= 1) v += shx(v, o);
    return v;
}
DI float sum16(float v) {
#pragma unroll
    for (int o = 1; o < 16; o <<= 1) v += shx(v, o);
    return v;
}
DI u32x4 gld(const void* p) { return *(const GAS u32x4*)p; }
DI f32x4 gldf(const void* p) { return *(const GAS f32x4*)p; }
DI void gst(void* p, u32x4 v) { *(GAS u32x4*)p = v; }
DI void gstf(void* p, f32x4 v) { *(GAS f32x4*)p = v; }
DI void unpack8(const u32x4 w, float (&f)[8]) {
    f[0] = bflo(w.x); f[1] = bfhi(w.x); f[2] = bflo(w.y); f[3] = bfhi(w.y); f[4] = bflo(w.z); f[5] = bfhi(w.z); f[6] = bflo(w.w); f[7] = bfhi(w.w);
}
DI u32x4 pack8(const float (&f)[8]) { u32x4 w; w.x = pk2(f[0], f[1]); w.y = pk2(f[2], f[3]); w.z = pk2(f[4], f[5]); w.w = pk2(f[6], f[7]); return w; }

namespace pg8 {
typedef unsigned short bf16_t;
constexpr int BM = 256, BK = 64, HALF = 128, HTB = HALF * BK * 2, NXCD = 8;
DI int lds_byte(int r, int c) { const int st = (r >> 4) * 2 + (c >> 5), rr = r & 15, cc = c & 31, ob = rr * 64 + cc * 2; return st * 1024 + (ob ^ (((ob >> 9) & 1) << 5)); }
DI void stage_rc(int b, int& R, int& C) { const int st = b / 1024, sb = b % 1024, swz = sb ^ (((sb >> 9) & 1) << 5); R = (st >> 1) * 16 + swz / 64; C = (st & 1) * 32 + (swz % 64) / 2; }
DI int perm32(int rho) { const int n = rho >> 4, i = rho & 15; return 8 * (i >> 2) + 4 * n + (i & 3); }

struct Unit { int pm, pn, aux; const char* a; const char* b; };
struct Gemm { int lda, ldb, K; };

DI void tile_of(int L, int nM, int nN, int& pm, int& pn, const int WGM) {
    const int nwg = nM * nN; int wgid = L;
    { const int q = nwg / NXCD, r = nwg % NXCD, xcd = wgid % NXCD, off = wgid / NXCD; wgid = (xcd < r ? xcd * (q + 1) : r * (q + 1) + (xcd - r) * q) + off; }
    const int nig = WGM * nN, gid = wgid / nig, fm = gid * WGM, gsz = (nM - fm) < WGM ? (nM - fm) : WGM;
    pm = fm + ((wgid % nig) % gsz); pn = (wgid % nig) / gsz;
}

template <class Epi, class Sched, bool ALIGN_EPI>
DI void gemm_phase(LAS unsigned char* lds, const Gemm g, const Sched& S, const Epi& E, const int tid) {
    const int wid = __builtin_amdgcn_readfirstlane(tid >> 6), lane = tid & 63, wr = wid >> 2, wc = wid & 3, fr = lane & 15, fq = lane >> 4;
    const int K = g.K, nt = K / BK;
    unsigned voffA[2], voffB[2];
#pragma unroll
    for (int i = 0; i < 2; ++i) { int R, C; stage_rc(tid * 16 + i * 8192, R, C); const int Rb = Epi::PERM ? (((R >> 5) * 64) + perm32(R & 31)) : R;
        voffA[i] = (unsigned)(R * g.lda + C) * 2u; voffB[i] = (unsigned)(Rb * g.ldb + C) * 2u; }
    const size_t kstep = (size_t)(BK * 2);
    const size_t hsA = (size_t)HALF * g.lda * 2, hsB = (size_t)(Epi::PERM ? 32 : HALF) * g.ldb * 2;
    const unsigned ldsw = (unsigned)wid * 1024u;
    const int aoff = lds_byte(wr * 64 + fr, fq * 8), boff = lds_byte(wc * 32 + fr, fq * 8);
#define PG8_SA(b, h) (((b) * 2 + (h)) * HTB)
#define PG8_SB(b, h) ((4 + (b) * 2 + (h)) * HTB)
#define PG8_STAGE(bufoff, gbase, voff) do { _Pragma("unroll") for (int _i = 0; _i < 2; ++_i) \
        __builtin_amdgcn_global_load_lds((const unsigned*)((const char*)(gbase) + (voff)[_i]), (LAS unsigned*)(lds + (bufoff) + ldsw + _i * 8192), 16, 0, 0); } while (0)
#define PG8_LDA(dst, b, h) do { _Pragma("unroll") for (int m = 0; m < 4; ++m) _Pragma("unroll") for (int k = 0; k < 2; ++k) dst[m][k] = *(const LAS bf16x8*)(lds + PG8_SA(b, h) + aoff + m * 2048 + k * 1024); } while (0)
#define PG8_LDB(dst, b, h) do { _Pragma("unroll") for (int n = 0; n < 2; ++n) _Pragma("unroll") for (int k = 0; k < 2; ++k) dst[n][k] = *(const LAS bf16x8*)(lds + PG8_SB(b, h) + boff + n * 2048 + k * 1024); } while (0)
#define PG8_MMA(ai, bj, At, Bt) do { __builtin_amdgcn_s_setprio(1); _Pragma("unroll") for (int m = 0; m < 4; ++m) _Pragma("unroll") for (int n = 0; n < 2; ++n) _Pragma("unroll") for (int k = 0; k < 2; ++k) \
        acc[ai][bj][m][n] = __builtin_amdgcn_mfma_f32_16x16x32_bf16(Bt[n][k], At[m][k], acc[ai][bj][m][n], 0, 0, 0); __builtin_amdgcn_s_setprio(0); } while (0)
#define PG8_WAIT_V(n) asm volatile("s_waitcnt vmcnt(" #n ")" ::: "memory")
#define PG8_WAIT_L(n) asm volatile("s_waitcnt lgkmcnt(" #n ")" ::: "memory")
#define PG8_BAR __builtin_amdgcn_s_barrier()
#define PG8_SCHED __builtin_amdgcn_sched_barrier(0)
    Unit cur, nxt; int ui = 0;
    if (!S.next(0, cur)) return;
    f32x4 acc[2][2][4][2];
#pragma unroll
    for (int a = 0; a < 2; ++a)
#pragma unroll
        for (int b = 0; b < 2; ++b)
#pragma unroll
            for (int m = 0; m < 4; ++m)
#pragma unroll
                for (int n = 0; n < 2; ++n) acc[a][b][m][n] = (f32x4){0.f, 0.f, 0.f, 0.f};
    bf16x8 At[4][2], B0[2][2], B1[2][2];
    const char* cA = cur.a; const char* cB = cur.b;
    PG8_STAGE(PG8_SB(0, 0), cB, voffB); PG8_STAGE(PG8_SB(0, 1), cB + hsB, voffB); PG8_STAGE(PG8_SA(0, 0), cA, voffA); PG8_STAGE(PG8_SA(0, 1), cA + hsA, voffA);
    if (wr == 1) PG8_BAR;
    PG8_WAIT_V(2); PG8_BAR;
    PG8_STAGE(PG8_SB(1, 0), cB + kstep, voffB); PG8_STAGE(PG8_SA(1, 0), cA + kstep, voffA); PG8_STAGE(PG8_SB(1, 1), cB + hsB + kstep, voffB);
    PG8_WAIT_V(6); PG8_BAR;
    for (;;) {
        const bool has_next = S.next(ui + 1, nxt);
        const char* nA = has_next ? nxt.a : cA; const char* nB = has_next ? nxt.b : cB;
        for (int t = 0; t < nt; t += 2) {
            const bool last = (t == nt - 2);
            const char* a1 = cA + (size_t)(t + 1) * kstep;
            const char* a2 = last ? nA : cA + (size_t)(t + 2) * kstep; const char* b2 = last ? nB : cB + (size_t)(t + 2) * kstep;
            const char* a3 = a2 + kstep; const char* b3 = b2 + kstep;
            PG8_LDB(B0, 0, 0); PG8_LDB(B1, 0, 1); PG8_SCHED; PG8_LDA(At, 0, 0); PG8_STAGE(PG8_SA(1, 1), a1 + hsA, voffA);
            PG8_WAIT_V(8); PG8_WAIT_L(0); PG8_BAR; PG8_MMA(0, 0, At, B0); PG8_MMA(0, 1, At, B1); PG8_BAR; PG8_SCHED;
            PG8_LDA(At, 0, 1); PG8_STAGE(PG8_SB(0, 0), b2, voffB); PG8_STAGE(PG8_SB(0, 1), b2 + hsB, voffB); PG8_STAGE(PG8_SA(0, 0), a2, voffA);
            PG8_WAIT_V(8); PG8_WAIT_L(0); PG8_BAR; PG8_MMA(1, 0, At, B0); PG8_MMA(1, 1, At, B1); PG8_BAR; PG8_SCHED;
            PG8_LDB(B0, 1, 0); PG8_LDB(B1, 1, 1); PG8_SCHED; PG8_LDA(At, 1, 0); PG8_STAGE(PG8_SA(0, 1), a2 + hsA, voffA);
            PG8_WAIT_V(8); PG8_WAIT_L(0); PG8_BAR; PG8_MMA(0, 0, At, B0); PG8_MMA(0, 1, At, B1); PG8_BAR; PG8_SCHED;
            PG8_LDA(At, 1, 1); PG8_STAGE(PG8_SB(1, 0), b3, voffB); PG8_STAGE(PG8_SB(1, 1), b3 + hsB, voffB); PG8_STAGE(PG8_SA(1, 0), a3, voffA);
            PG8_WAIT_V(8); PG8_WAIT_L(0); PG8_BAR; PG8_MMA(1, 0, At, B0); PG8_MMA(1, 1, At, B1); PG8_BAR; PG8_SCHED;
        }
        if constexpr (ALIGN_EPI) { if (wr == 0) PG8_BAR; }
        E(acc, cur, wr, wc, fr, fq);
        if (!has_next) break;
        if (!(Epi::CHAIN && cur.aux == 0)) {
#pragma unroll
        for (int a = 0; a < 2; ++a)
#pragma unroll
            for (int b = 0; b < 2; ++b)
#pragma unroll
                for (int m = 0; m < 4; ++m)
#pragma unroll
                    for (int n = 0; n < 2; ++n) acc[a][b][m][n] = (f32x4){0.f, 0.f, 0.f, 0.f};
        }
        cur = nxt; cA = nA; cB = nB; ++ui;
        if constexpr (ALIGN_EPI) { if (wr == 1) PG8_BAR; }
    }
    PG8_WAIT_V(0);
    if constexpr (!ALIGN_EPI) { if (wr == 0) PG8_BAR; }
    PG8_BAR;
#undef PG8_SA
#undef PG8_SB
#undef PG8_STAGE
#undef PG8_LDA
#undef PG8_LDB
#undef PG8_MMA
#undef PG8_WAIT_V
#undef PG8_WAIT_L
#undef PG8_BAR
#undef PG8_SCHED
}

struct SchedPlain {
    const char* A; const char* B; int nM, nN, G, c; size_t ta, tb; int wgm;
    DI bool next(int i, Unit& u) const { const long L = (long)i * G + c; if (L >= (long)nM * nN) return false; tile_of((int)L, nM, nN, u.pm, u.pn, wgm); u.aux = 0; u.a = A + (size_t)u.pm * ta; u.b = B + (size_t)u.pn * tb; return true; }
};
struct SchedPool {
    const char* A; const char* B; int G, c;
    DI bool next(int i, Unit& u) const { const int L = i * G + c; if (L >= 256) return false; u.pm = L >> 3; u.pn = L & 7; u.aux = 0; const int grp = u.pn >> 1, half = u.pn & 1;
        u.a = A + ((size_t)u.pm * 256 * PW + (size_t)grp * 512) * 2; u.b = B + ((size_t)grp * 512 * 512 + (size_t)half * 256 * 512) * 2; return true; }
};
struct SchedUp {
    const char* A0; const char* A1; const char* B0; const char* B1; int G, c;
    DI bool next(int i, Unit& u) const { const long L = (long)(i >> 1) * G + c; if (L >= 32 * 16) return false; tile_of((int)L, 32, 16, u.pm, u.pn, WGM_UP); u.aux = i & 1;
        u.a = (u.aux ? A1 : A0) + (size_t)u.pm * 256 * PW * 2; u.b = (u.aux ? B1 : B0) + (size_t)u.pn * 256 * PW * 2; return true; }
};

struct EpiIn {
    static constexpr bool PERM = true, CHAIN = false;
    bf16_t *U, *ZP, *QR, *ZN, *KV6, *GM, *NG; const float* mbias; const LAS float* rs;
    DI void operator()(f32x4 (&acc)[2][2][4][2], const Unit& u, int wr, int wc, int fr, int fq) const {
        const int pn = u.pn; bf16_t* base; int ldc, colt, mode;
        if (pn < 32) { base = U + (size_t)(pn >> 3) * T * PW; ldc = PW; colt = (pn & 7) * 256; mode = (pn >> 3) & 1; }
        else if (pn < 44) { base = KV6; ldc = KV6W; colt = (pn - 32) * 256; mode = 0; }
        else if (pn < 76) { base = GM; ldc = DM; colt = 0; mode = 2; }
        else { base = NG; ldc = 256; colt = 0; mode = 3; }
        const int row0 = u.pm * BM + wr * 64 + fr, col0 = colt + wc * 64 + 8 * fq;
        if (mode == 2) {
            const int ch0 = (pn - 44) * 128 + wc * 32 + 8 * fq;
            f32x4 b0[2], b1[2];
#pragma unroll
            for (int n = 0; n < 2; ++n) { b0[n] = gldf(mbias + ch0 + 4 * n); b1[n] = gldf(mbias + DM + ch0 + 4 * n); }
#pragma unroll
            for (int ai = 0; ai < 2; ++ai)
#pragma unroll
                for (int m = 0; m < 4; ++m) { const size_t ro = (size_t)(row0 + ai * HALF + m * 16) * DM + ch0; const float rr = rs[wr * 64 + fr + ai * HALF + m * 16];
                    const f32x4 a00 = acc[ai][0][m][0] * rr + b0[0], a01 = acc[ai][0][m][1] * rr + b0[1], a10 = acc[ai][1][m][0] * rr + b1[0], a11 = acc[ai][1][m][1] * rr + b1[1];
                    f32x4 r0, r1, g10, g11;
#pragma unroll
                    for (int e = 0; e < 4; ++e) { const float e00 = fminf(ex2(-a00[e] * LOG2E), 1e30f), e01 = fminf(ex2(-a01[e] * LOG2E), 1e30f), e10 = fminf(ex2(-a10[e] * LOG2E), 1e30f), e11 = fminf(ex2(-a11[e] * LOG2E), 1e30f);
                        g10[e] = rcpf(1.f + e10); g11[e] = rcpf(1.f + e11); r0[e] = rcpf(1.f + e00) * (1.f + e10); r1[e] = rcpf(1.f + e01) * (1.f + e11); }
                    u32x4 rw, gw;
                    rw.x = pk2(r0.x, r0.y); rw.y = pk2(r0.z, r0.w); rw.z = pk2(r1.x, r1.y); rw.w = pk2(r1.z, r1.w);
                    gw.x = pk2(g10.x, g10.y); gw.y = pk2(g10.z, g10.w); gw.z = pk2(g11.x, g11.y); gw.w = pk2(g11.z, g11.w);
                    gst(GM + ro, rw); gst(GM + (size_t)T * DM + ro, gw); }
            return; }
#pragma unroll
        for (int ai = 0; ai < 2; ++ai)
#pragma unroll
            for (int m = 0; m < 4; ++m) { bf16_t* rowp = base + (size_t)(row0 + ai * HALF + m * 16) * ldc + col0; const float rr = rs[wr * 64 + fr + ai * HALF + m * 16];
#pragma unroll
                for (int bj = 0; bj < 2; ++bj) { f32x4 v0 = acc[ai][bj][m][0] * rr, v1 = acc[ai][bj][m][1] * rr;
                    if (mode != 0) {
#pragma unroll
                        for (int e = 0; e < 4; ++e) { const float s0 = sigm(v0[e]), s1 = sigm(v1[e]); v0[e] = (mode == 1) ? v0[e] * s0 : s0; v1[e] = (mode == 1) ? v1[e] * s1 : s1; }
                    }
                    u32x4 w; w.x = pk2(v0[0], v0[1]); w.y = pk2(v0[2], v0[3]); w.z = pk2(v1[0], v1[1]); w.w = pk2(v1[2], v1[3]);
                    gst(rowp + bj * 32, w); } }
    }
};
struct EpiPool {
    static constexpr bool PERM = true, CHAIN = false;
    bf16_t* O; const bf16_t* ZP; const float* scale;
    DI void operator()(f32x4 (&acc)[2][2][4][2], const Unit& u, int wr, int wc, int fr, int fq) const {
        const int row0 = u.pm * BM + wr * 64 + fr, col0 = u.pn * BM + wc * 64 + 8 * fq;
        f32x4 sv[2][2];
#pragma unroll
        for (int bj = 0; bj < 2; ++bj)
#pragma unroll
            for (int n = 0; n < 2; ++n) sv[bj][n] = gldf(scale + col0 + bj * 32 + 4 * n);
#pragma unroll
        for (int ai = 0; ai < 2; ++ai)
#pragma unroll
            for (int m = 0; m < 4; ++m) { const size_t ro = (size_t)(row0 + ai * HALF + m * 16) * PW + col0;
#pragma unroll
                for (int bj = 0; bj < 2; ++bj) { const u32x4 z = gld(ZP + ro + bj * 32); float zf[8]; unpack8(z, zf);
                    const f32x4 v0 = acc[ai][bj][m][0] * sv[bj][0], v1 = acc[ai][bj][m][1] * sv[bj][1];
                    u32x4 w; w.x = pk2(v0[0] * zf[0], v0[1] * zf[1]); w.y = pk2(v0[2] * zf[2], v0[3] * zf[3]); w.z = pk2(v1[0] * zf[4], v1[1] * zf[5]); w.w = pk2(v1[2] * zf[6], v1[3] * zf[7]);
                    gst(O + ro + bj * 32, w); } }
    }
};
struct EpiUp {
    static constexpr bool PERM = true, CHAIN = true;
    bf16_t* Y; const bf16_t* R; const bf16_t* G1;
    DI void operator()(f32x4 (&acc)[2][2][4][2], const Unit& u, int wr, int wc, int fr, int fq) const {
        const int row0 = u.pm * BM + wr * 64 + fr, col0 = u.pn * BM + wc * 64 + 8 * fq; const int which = u.aux; const bf16_t* gsrc = which ? G1 : R;
#pragma unroll
        for (int ai = 0; ai < 2; ++ai)
#pragma unroll
            for (int m = 0; m < 4; ++m) { const int row = row0 + ai * HALF + m * 16;
#pragma unroll
                for (int bj = 0; bj < 2; ++bj) { const int col = col0 + bj * 32;
                    const u32x4 gw = gld(gsrc + (size_t)row * DM + col); float g[8]; unpack8(gw, g);
                    if (which == 0) {
#pragma unroll
                        for (int e = 0; e < 4; ++e) { acc[ai][bj][m][0][e] *= g[e]; acc[ai][bj][m][1][e] *= g[4 + e]; }
                    } else {
                        const f32x4 v0 = acc[ai][bj][m][0], v1 = acc[ai][bj][m][1];
                        u32x4 w; w.x = pk2(v0[0] * g[0], v0[1] * g[1]); w.y = pk2(v0[2] * g[2], v0[3] * g[3]); w.z = pk2(v1[0] * g[4], v1[1] * g[5]); w.w = pk2(v1[2] * g[6], v1[3] * g[7]);
                        gst(Y + (size_t)row * DM + col, w); } } }
    }
};
struct EpiOut {
    static constexpr bool PERM = true, CHAIN = false;
    const float* X0; const bf16_t* XS; bf16_t* XD; float* SS; float* O; int mode;
    DI void operator()(f32x4 (&acc)[2][2][4][2], const Unit& u, int wr, int wc, int fr, int fq) const {
        const int row0 = u.pm * BM + wr * 64 + fr, col0 = u.pn * BM + wc * 64 + 8 * fq;
#pragma unroll
        for (int ai = 0; ai < 2; ++ai)
#pragma unroll
            for (int m = 0; m < 4; ++m) { const int row = row0 + ai * HALF + m * 16; const size_t ro = (size_t)row * DM + col0; float s = 0.f;
#pragma unroll
                for (int bj = 0; bj < 2; ++bj) { f32x4 v0, v1;
                    if (mode == 0) { v0 = gldf(X0 + ro + bj * 32); v1 = gldf(X0 + ro + bj * 32 + 4); }
                    else { const u32x4 xw = gld(XS + ro + bj * 32); v0 = (f32x4){bflo(xw.x), bfhi(xw.x), bflo(xw.y), bfhi(xw.y)}; v1 = (f32x4){bflo(xw.z), bfhi(xw.z), bflo(xw.w), bfhi(xw.w)}; }
                    v0 += acc[ai][bj][m][0]; v1 += acc[ai][bj][m][1];
                    if (mode == 2) { gstf(O + ro + bj * 32, v0); gstf(O + ro + bj * 32 + 4, v1); }
                    else { u32x4 w; w.x = pk2(v0[0], v0[1]); w.y = pk2(v0[2], v0[3]); w.z = pk2(v1[0], v1[1]); w.w = pk2(v1[2], v1[3]); gst(XD + ro + bj * 32, w);
                        s += (v0[0] * v0[0] + v0[1] * v0[1]) + (v0[2] * v0[2] + v0[3] * v0[3]) + (v1[0] * v1[0] + v1[1] * v1[1]) + (v1[2] * v1[2] + v1[3] * v1[3]); } }
                if (mode != 2) { s += shx(s, 16); s += shx(s, 32); if (fq == 0) *(GAS float*)(SS + (size_t)row * 64 + u.pn * 4 + wc) = s; } }
    }
};
}

#define XB_TMO      128
#define XB_XCNT(j)  (256  + 64 * (j))
#define XB_XSUB(j)  (1280 + 64 * (j))
#define XB_XGEN(j)  (2304 + 64 * (j))
#define XB_TOP      3328
#define XB_TOPGEN   3392
#define XCD_BAR_WORDS 3456
#define XB_SPIN_CAP (1u << 22)
DI unsigned xb_ld(unsigned* p)              { return __hip_atomic_load(p, __ATOMIC_RELAXED, __HIP_MEMORY_SCOPE_AGENT); }
DI unsigned xb_add(unsigned* p, unsigned v) { return __hip_atomic_fetch_add(p, v, __ATOMIC_RELAXED, __HIP_MEMORY_SCOPE_AGENT); }
DI unsigned xb_xcc_id() { return (unsigned)__builtin_amdgcn_s_getreg((3 << 11) | 20) & 0xFu; }
#define XB_SPIN(cond, bar) do { unsigned _sp = 0; while (cond) { __builtin_amdgcn_s_sleep(1); \
    if ((++_sp & 255u) == 0u) { if (xb_ld(&(bar)[XB_TMO])) break; if (_sp > XB_SPIN_CAP) { atomicAdd(&(bar)[XB_TMO], 1u); break; } } } } while (0)
struct XcdBarrier { unsigned* bar; unsigned x; volatile LAS unsigned* st; };
DI XcdBarrier xcd_barrier_post(unsigned* bar, volatile LAS unsigned* st) {
    XcdBarrier b; b.bar = bar; b.x = xb_xcc_id(); b.st = st;
    if (threadIdx.x == 0) (void)xb_add(&bar[XB_XCNT(b.x)], 1u);
    return b;
}
DI void xcd_barrier_complete(unsigned* bar, unsigned x, unsigned& nloc, unsigned& nx) {
    const unsigned G = gridDim.x * gridDim.y * gridDim.z;
    unsigned sum, cnt, mine, sp = 0u;
    for (;;) {
        sum = 0u; cnt = 0u; mine = 0u;
#pragma unroll
        for (unsigned j = 0; j < 16; ++j) { const unsigned c = xb_ld(&bar[XB_XCNT(j)]); sum += c; cnt += (c > 0u) ? 1u : 0u; mine = (j == x) ? c : mine; }
        if (sum == G) break;
        __builtin_amdgcn_s_sleep(1);
        if ((++sp & 255u) == 0u) { if (xb_ld(&bar[XB_TMO])) break; if (sp > XB_SPIN_CAP) { atomicAdd(&bar[XB_TMO], 1u); break; } }
    }
    nloc = mine > 0u ? mine : 1u; nx = cnt > 0u ? cnt : 1u;
}
DI void xcd_barrier(const XcdBarrier& b) {
    asm volatile("s_waitcnt vmcnt(0)" ::: "memory");
    __syncthreads();
    if (threadIdx.x == 0) {
        unsigned* bar = b.bar;
        __builtin_amdgcn_s_waitcnt(0);
        unsigned nloc = b.st[0], nx = b.st[1];
        if (nloc == 0u) { xcd_barrier_complete(bar, b.x, nloc, nx); b.st[0] = nloc; b.st[1] = nx; }
        const unsigned old = xb_add(&bar[XB_XSUB(b.x)], 1u);
        const unsigned gen = old / nloc;
        if (old + 1u == (gen + 1u) * nloc) {
            __builtin_amdgcn_fence(__ATOMIC_RELEASE, "agent");
            asm volatile("s_waitcnt vmcnt(0)" ::: "memory");
            const unsigned og = xb_add(&bar[XB_TOP], 1u);
            const unsigned tg = og / nx;
            if (og + 1u == (tg + 1u) * nx) xb_add(&bar[XB_TOPGEN], 1u);
            else XB_SPIN(xb_ld(&bar[XB_TOPGEN]) == tg, bar);
            __builtin_amdgcn_fence(__ATOMIC_ACQUIRE, "agent");
            xb_add(&bar[XB_XGEN(b.x)], 1u);
            asm volatile("s_waitcnt vmcnt(0)" ::: "memory");
        } else {
            XB_SPIN(xb_ld(&bar[XB_XGEN(b.x)]) == gen, bar);
            __builtin_amdgcn_fence(__ATOMIC_ACQUIRE, "agent");
            asm volatile("s_waitcnt vmcnt(0)" ::: "memory");
        }
    }
    __syncthreads();
}

struct Args { const float* in[15]; float* out; unsigned char* ws; int st_lo, st_hi; };

template <bool NT> DI void tr_item(const float* src, size_t pitch, int scol, bf16* dst, size_t dpitch, LAS float* scr, int lane, const float* gk  , int w1c0 = -1  , int w1k0 = 0) {
    f32x4 v[16]; const int kr = lane >> 4, c4 = (lane & 15) * 4;
#pragma unroll
    for (int i = 0; i < 16; ++i) { const f32x4* p_ = (const f32x4*)(src + (size_t)(4 * i + kr) * pitch + scol); v[i] = (scol >= 0) ? (NT ? __builtin_nontemporal_load(p_) : *p_) : (f32x4){0.f, 0.f, 0.f, 0.f}; }
#pragma unroll
    for (int i = 0; i < 16; ++i) { if (gk) v[i] *= gk[4 * i + kr]; LAS float* p = scr + (4 * i + kr) * 65 + c4; p[0] = v[i].x; p[1] = v[i].y; p[2] = v[i].z; p[3] = v[i].w; }
    LDS_WAIT(); asm volatile("" ::: "memory");
    const int c = lane & 7;
#pragma unroll
    for (int j = 0; j < 8; ++j) { const int n = (lane >> 3) + 8 * j; const LAS float* s = scr + (8 * c) * 65 + n;
        u32x4 o; o.x = pk2(s[0 * 65], s[1 * 65]); o.y = pk2(s[2 * 65], s[3 * 65]); o.z = pk2(s[4 * 65], s[5 * 65]); o.w = pk2(s[6 * 65], s[7 * 65]);
        if (w1c0 < 0) { if (NT) __builtin_nontemporal_store(o, (u32x4*)(dst + (size_t)n * dpitch + 8 * c)); else *(u32x4*)(dst + (size_t)n * dpitch + 8 * c) = o; }
        else { const int cc = w1c0 + n, k = w1k0 + 8 * c; *(u32x4*)(dst + ((size_t)(((k >> 5) * 8 + (cc >> 4)) * 64 + ((k >> 3) & 3) * 16 + (cc & 15))) * 8) = o; } }
    LDS_WAIT(); asm volatile("" ::: "memory");
}
constexpr int I_IN = 64 * (NPAD / 64), I_POOL = 4 * 8 * 8, I_UP = 32 * 64, I_OUT = 64 * 64, I_W1 = 2 * 64 * 2, I_W2 = 2 * 2 * 2;
constexpr int I_LAYER = I_IN + I_POOL + 2 * I_UP + I_OUT + I_W1 + I_W2;
constexpr int OFF_WGS = 96, OFF_FIRST = 160, OFF_ITEMS = 12288;
static_assert(OFF_ITEMS <= I_IN && (32 * NINT) - 9 * 256 == OFF_FIRST && OFF_FIRST + OFF_WGS == 256, "in-projection slack split");
template <bool NT> DI void conv_item(const Args& a, int l, int r, LAS float* scr, int lane) {
    unsigned char* ws = a.ws; const int c4 = (lane & 15) * 4;
        const float* src; size_t pitch, dpitch; int sc; bf16* dst; int w1c0 = -1, w1k0 = 0; const float* gk = nullptr;
        if (r < I_IN) {
            const int nblk = NPAD / 64, kb = r / nblk, nb = r % nblk, np = nb * 64 + c4;
            if (np < 11264) sc = np;
        else if (np < 19456) { const int q = (np - 11264) & 255, k = (np - 11264) >> 8;
            sc = 11312 + ((q >> 5) & 1) * 4096 + 128 * k + 32 * (q >> 6) + (q & 31); }
        else if (np < 19504) sc = 11264 + (np - 19456); else sc = -1;
            gk = a.in[1] + (size_t)l * DM + kb * 64;
            src = a.in[2] + (size_t)l * DM * NIN + (size_t)kb * 64 * NIN; pitch = NIN; dst = (bf16*)(ws + WS_WIN + l * SZ_WIN) + (size_t)nb * 64 * DM + kb * 64; dpitch = DM;
        } else if ((r -= I_IN) < I_POOL) {
            const int g = r / 64, q = r % 64, kb = q / 8, nb = q % 8;
            src = a.in[4] + ((size_t)(l * 4 + g) * 512 + kb * 64) * 512; pitch = 512; sc = nb * 64 + c4; dst = (bf16*)(ws + WS_POOLW + l * SZ_POOLW) + ((size_t)g * 512 + nb * 64) * 512 + kb * 64; dpitch = 512;
        } else if ((r -= I_POOL) < 2 * I_UP) {
            const int which = r / I_UP, q = r % I_UP, kb = q / 64, nb = q % 64;
            src = a.in[12 + which] + ((size_t)l * PW + kb * 64) * DM; pitch = DM; sc = nb * 64 + c4; dst = (bf16*)(ws + (which ? WS_WNU : WS_WPU) + l * SZ_WUP) + (size_t)nb * 64 * PW + kb * 64; dpitch = PW;
        } else if ((r -= 2 * I_UP) < I_OUT) {
            const int kb = r / 64, nb = r % 64;
            src = a.in[14] + ((size_t)l * DM + kb * 64) * DM; pitch = DM; sc = nb * 64 + c4; dst = (bf16*)(ws + WS_WOUT + l * SZ_WOUT) + (size_t)nb * 64 * DM + kb * 64; dpitch = DM;
        } else if ((r -= I_OUT) < I_W1) {
            const int i = r / 128, q = r % 128, kb = q / 2, nb = q % 2;
            src = a.in[9] + ((size_t)(l * 2 + i) * 4096 + kb * 64) * 128; pitch = 128; sc = nb * 64 + c4; dst = (bf16*)(ws + WS_W1 + l * SZ_W1) + (size_t)i * 128 * 4096; dpitch = 4096; w1c0 = nb * 64; w1k0 = kb * 64;
        } else {
            r -= I_W1; const int i = r / 4, q = r % 4, kb = q / 2, nb = q % 2;
            src = a.in[11] + ((size_t)(l * 2 + i) * 128 + kb * 64) * 128; pitch = 128; sc = nb * 64 + c4; dst = (bf16*)(ws + WS_W2 + l * SZ_W2) + ((size_t)i * 128 + nb * 64) * 128 + kb * 64; dpitch = 128;
        }
        tr_item<NT>(src, pitch, sc, dst, dpitch, scr, lane, gk, w1c0, w1k0);
}
DI void prologue(const Args& a, LAS unsigned char* lds, int gw, int NGW, int wave, int lane, bool offload) {
    LAS float* scr = (LAS float*)(lds + wave * 16640);
    const int skip = offload ? OFF_ITEMS : 0, per = I_LAYER - skip, n = I_LAYER + (DEPTH - 1) * per;
    for (int it = gw; it < n; it += NGW) {
        int l, r; if (it < I_LAYER) { l = 0; r = it; } else { const int q = it - I_LAYER; l = 1 + q / per; r = skip + q % per; }
        conv_item<false>(a, l, r, scr, lane);
    }
}
DI void slack_convert(const Args& a, LAS unsigned char* lds, int l_next, int bx, int wave, int lane) {
    LAS float* scr = (LAS float*)(lds + wave * 16640);
    for (int r = (bx - OFF_FIRST) * NWAVES + wave; r < OFF_ITEMS; r += OFF_WGS * NWAVES) conv_item<true>(a, l_next, r, scr, lane);
}

DI void p1_xb(const float* x, bf16* xb, float* ss, int gw, int NGW, int lane) {
    for (int m = gw; m < T; m += NGW) {
        const f32x4* xr = (const f32x4*)(x + (size_t)m * DM) + lane;
        f32x4 v[16]; float s = 0.f;
#pragma unroll
        for (int j = 0; j < 16; ++j) { v[j] = xr[64 * j]; s += (v[j].x * v[j].x + v[j].y * v[j].y) + (v[j].z * v[j].z + v[j].w * v[j].w); }
        ss[(size_t)m * 64 + lane] = s;
        u32x2* o = (u32x2*)(xb + (size_t)m * DM) + lane;
#pragma unroll
        for (int j = 0; j < 16; ++j) { u32x2 w; w.x = pk2(v[j].x, v[j].y); w.y = pk2(v[j].z, v[j].w); o[64 * j] = w; }
    }
}

DI int swap23(int m) { return (m & 0x13) | ((m & 4) << 1) | ((m & 8) >> 1); }
DI size_t ktile_off(int key, int c  ) { return (size_t)(key >> 5) * 8192 + (size_t)((c & 7) * 1024 + ((c >> 3) * 32 + swap23(key & 31)) * 16); }
DI size_t vtile_off(int kb  , int d) { return (size_t)(kb >> 5) * 8192 + (size_t)(((d >> 5) * 2 + ((kb >> 4) & 1)) * 1024 + (((kb >> 3) & 1) * 32 + (d & 31)) * 16); }
struct MidP { const bf16 *U, *QR, *KV6; bf16 *MP, *QN, *KSN, *KWN, *VST, *VWT; const float *qg, *kg; };
template <int W> DI void pool_load4(u32x4 (&v)[W + 3], const bf16* U, int t0, int g, int lane) {
    const bf16* up = U + (size_t)t0 * PW + g * 512 + lane * 8;
#pragma unroll
    for (int i = 0; i < W + 3; ++i) { const int r = 3 - i;
        v[i] = (t0 + r >= 0) ? *(const u32x4*)(up + (ptrdiff_t)r * PW) : (u32x4){0u, 0u, 0u, 0u}; }
}
template <int W> DI void pool_finish4(const u32x4 (&v)[W + 3], bf16* MP, int t0, int g, int lane) {
#pragma unroll
    for (int k = 0; k < 4; ++k) {
        float s[8], u0[8]; unpack8(v[3 - k], u0);
#pragma unroll
        for (int e = 0; e < 8; ++e) s[e] = u0[e];
#pragma unroll
        for (int i = 1; i < W; ++i) { float f[8]; unpack8(v[3 - k + i], f);
#pragma unroll
            for (int e = 0; e < 8; ++e) s[e] += f[e]; }
        const int t = t0 + k, nwin = (t + 1 < W) ? t + 1 : W; const float inv = 1.f / (float)nwin; float o[8];
#pragma unroll
        for (int e = 0; e < 8; ++e) o[e] = s[e] * inv - u0[e];
        *(u32x4*)(MP + (size_t)t * PW + g * 512 + lane * 8) = pack8(o);
    }
}
DI void p3_mid(const MidP& P, LAS unsigned char* lds, int gw, int NGW, int wave, int lane0) {
    LAS bf16* tl = (LAS bf16*)(lds + wave * 17408);
    for (int it = gw; it < T / 4; it += NGW) {
        int lane = lane0; asm volatile("" : "+v"(lane));
        const int t0 = it * 4;
        u32x4 a0[5], a1[7], a2[11], a3[19];
        pool_load4<2>(a0, P.U, t0, 0, lane); pool_load4<4>(a1, P.U, t0, 1, lane); pool_load4<8>(a2, P.U, t0, 2, lane); pool_load4<16>(a3, P.U, t0, 3, lane);
        const int w = it / (4 * (T / 32)), r = it % (4 * (T / 32)), h = r / (T / 32), tile = r % (T / 32);
        const int hi2 = lane >> 5, key = tile * 32 + swap23(lane & 31);
        const u32x4* src = (const u32x4*)(P.KV6 + (size_t)key * KV6W + (w ? 2048 : 1024) + h * 128 + 64 * hi2);
        __builtin_amdgcn_sched_barrier(0);
        pool_finish4<2>(a0, P.MP, t0, 0, lane); pool_finish4<4>(a1, P.MP, t0, 1, lane); pool_finish4<8>(a2, P.MP, t0, 2, lane);
        const bf16* vsrc = P.KV6 + (size_t)(tile * 32) * KV6W + (w ? 2560 : 1536) + h * 128;
        u32x4 v[8], vv[8];
#pragma unroll
        for (int j = 0; j < 8; ++j) v[j] = src[j];
#pragma unroll
        for (int i = 0; i < 8; ++i) { const int tt = i * 4 + (lane >> 4), dc = (lane & 15) * 8; vv[i] = *(const u32x4*)(vsrc + (size_t)tt * KV6W + dc); }
        __builtin_amdgcn_sched_barrier(0);
        pool_finish4<16>(a3, P.MP, t0, 3, lane);
        {
            float ss = 0.f;
#pragma unroll
            for (int j = 0; j < 8; ++j) { float f[8]; unpack8(v[j], f);
#pragma unroll
                for (int e = 0; e < 8; ++e) ss += f[e] * f[e]; }
            ss += shx(ss, 32);
            const float rs = 1.f / sqrtf(ss * (1.f / 128.f) + EPS);
            const float* kgp = P.kg + (1 + w) * 128 + 64 * hi2;
            char* dstb = (char*)((w ? P.KWN : P.KSN) + (size_t)h * T * 128) + (size_t)tile * 8192 + lane * 16;
#pragma unroll
            for (int j = 0; j < 8; ++j) { float f[8], o[8]; unpack8(v[j], f); const f32x4 g0 = *(const f32x4*)(kgp + 8 * j), g1 = *(const f32x4*)(kgp + 8 * j + 4);
                o[0] = f[0] * rs * g0.x; o[1] = f[1] * rs * g0.y; o[2] = f[2] * rs * g0.z; o[3] = f[3] * rs * g0.w; o[4] = f[4] * rs * g1.x; o[5] = f[5] * rs * g1.y; o[6] = f[6] * rs * g1.z; o[7] = f[7] * rs * g1.w;
                *(u32x4*)(dstb + j * 1024) = pack8(o); }
        }
        {
#pragma unroll
            for (int i = 0; i < 8; ++i) { const int tt = i * 4 + (lane >> 4), dc = (lane & 15) * 8; *(LAS u32x4*)(tl + tt * 136 + dc) = vv[i]; }
            LDS_WAIT(); asm volatile("" ::: "memory");
            char* dst = (char*)((w ? P.VWT : P.VST) + (size_t)h * 128 * T) + (size_t)tile * 8192 + lane * 16;
            const int m2 = lane & 31, hi3 = lane >> 5;
#pragma unroll
            for (int i = 0; i < 8; ++i) { const int dt = i >> 1, s2 = i & 1;
                const int d = 32 * dt + m2, k0 = 16 * s2 + 8 * hi3; unsigned short e[8];
#pragma unroll
                for (int k = 0; k < 8; ++k) e[k] = tl[(k0 + k) * 136 + d];
                u32x4 wv; wv.x = e[0] | ((unsigned)e[1] << 16); wv.y = e[2] | ((unsigned)e[3] << 16); wv.z = e[4] | ((unsigned)e[5] << 16); wv.w = e[6] | ((unsigned)e[7] << 16);
                *(u32x4*)(dst + (dt * 2 + s2) * 1024) = wv; }
            LDS_WAIT(); asm volatile("" ::: "memory");
        }
    }
}

struct CmpP { const bf16* KV6; const float* pe; const bf16* W1T; const float* b1; const bf16* W2T; const float* kg0; bf16* KCN; bf16* VCT; };
DI void p3_compress(const CmpP& P, LAS unsigned char* lds, int G, int tid, int wave, int lane) {
    LAS float* red = (LAS float*)lds;
    LAS bf16* hid = (LAS bf16*)(lds + 65536);
    LAS float* out2 = (LAS float*)(lds + 65536 + 8192);
    for (int cu = blockIdx.x; cu < 256; cu += G) {
        const int which = cu & 1, h = (cu >> 1) & 3, n0 = (cu >> 3) * 16;
        const int i = lane & 15, kq = lane >> 4;
        const bf16* w1t = P.W1T + (size_t)which * 128 * 4096; const float* pe = P.pe + which * 4096;
        f32x4 acc[8];
#pragma unroll
        for (int ct = 0; ct < 8; ++ct) acc[ct] = (f32x4){0.f, 0.f, 0.f, 0.f};
#pragma unroll 8
        for (int ks = 0; ks < 16; ++ks) {
            const int kk = wave * 512 + ks * 32 + kq * 8, lt = kk >> 7, d = kk & 127, tok = 16 * (n0 + i) + lt;
            float af[8];
            if (tok < T) { const u32x4 v = *(const u32x4*)(P.KV6 + (size_t)tok * KV6W + which * 512 + h * 128 + d); unpack8(v, af); }
            else {
#pragma unroll
                for (int e = 0; e < 8; ++e) af[e] = 0.f; }
            const f32x4 p0 = *(const f32x4*)(pe + kk), p1 = *(const f32x4*)(pe + kk + 4);
            af[0] += p0.x; af[1] += p0.y; af[2] += p0.z; af[3] += p0.w; af[4] += p1.x; af[5] += p1.y; af[6] += p1.z; af[7] += p1.w;
            const bf16x8 a = __builtin_bit_cast(bf16x8, pack8(af));
#pragma unroll
            for (int ct = 0; ct < 8; ++ct) { const bf16x8 b = *(const bf16x8*)((const char*)w1t + (size_t)((wave * 16 + ks) * 8 + ct) * 1024 + lane * 16);
                acc[ct] = __builtin_amdgcn_mfma_f32_16x16x32_bf16(a, b, acc[ct], 0, 0, 0); }
        }
#pragma unroll
        for (int ct = 0; ct < 8; ++ct)
#pragma unroll
            for (int e = 0; e < 4; ++e) red[(wave * 16 + kq * 4 + e) * 128 + ct * 16 + i] = acc[ct][e];
        __syncthreads();
        {
            const int n = tid >> 5, c0 = (tid & 31) * 4; f32x4 s = *(const f32x4*)(P.b1 + which * 128 + c0);
#pragma unroll
            for (int w = 0; w < 8; ++w) { const f32x4 v = *(const LAS f32x4*)(red + (w * 16 + n) * 128 + c0); s += v; }
            u32x2 hw; hw.x = pk2(s.x * sigm(s.x), s.y * sigm(s.y)); hw.y = pk2(s.z * sigm(s.z), s.w * sigm(s.w));
            *(LAS u32x2*)(hid + n * 136 + c0) = hw;
        }
        __syncthreads();
        {
            const bf16* w2t = P.W2T + (size_t)which * 128 * 128; f32x4 c2 = (f32x4){0.f, 0.f, 0.f, 0.f};
#pragma unroll
            for (int ks = 0; ks < 4; ++ks) { const bf16x8 a = *(const LAS bf16x8*)(hid + i * 136 + ks * 32 + kq * 8); const bf16x8 b = *(const bf16x8*)(w2t + (size_t)(wave * 16 + i) * 128 + ks * 32 + kq * 8);
                c2 = __builtin_amdgcn_mfma_f32_16x16x32_bf16(a, b, c2, 0, 0, 0); }
#pragma unroll
            for (int e = 0; e < 4; ++e) out2[(kq * 4 + e) * 132 + wave * 16 + i] = c2[e];
        }
        __syncthreads();
        if (which == 0) {
            if (tid < 256) { const int n = tid >> 4, c = tid & 15; const f32x4 v0 = *(const LAS f32x4*)(out2 + n * 132 + c * 8), v1 = *(const LAS f32x4*)(out2 + n * 132 + c * 8 + 4);
                float ss = (v0.x * v0.x + v0.y * v0.y) + (v0.z * v0.z + v0.w * v0.w) + (v1.x * v1.x + v1.y * v1.y) + (v1.z * v1.z + v1.w * v1.w);
                ss = sum16(ss);
                const float rs = 1.f / sqrtf(ss * (1.f / 128.f) + EPS); const f32x4 g0 = *(const f32x4*)(P.kg0 + c * 8), g1 = *(const f32x4*)(P.kg0 + c * 8 + 4);
                u32x4 w; w.x = pk2(v0.x * rs * g0.x, v0.y * rs * g0.y); w.y = pk2(v0.z * rs * g0.z, v0.w * rs * g0.w); w.z = pk2(v1.x * rs * g1.x, v1.y * rs * g1.y); w.w = pk2(v1.z * rs * g1.z, v1.w * rs * g1.w);
                *(u32x4*)((char*)(P.KCN + (size_t)h * NCP * 128) + ktile_off(n0 + n, c)) = w; }
        } else {
            if (tid < 256) { const int d = tid >> 1, a = tid & 1; float e[8];
#pragma unroll
                for (int k = 0; k < 8; ++k) e[k] = out2[(8 * a + k) * 132 + d];
                *(u32x4*)((char*)(P.VCT + (size_t)h * 128 * NCP) + vtile_off(n0 + 8 * a, d)) = pack8(e); }
        }
        __syncthreads();
    }
}

#define MFMA32(a, b, c) __builtin_amdgcn_mfma_f32_32x32x16_bf16((a), (b), (c), 0, 0, 0)
struct AttP { const bf16 *QN  , *KCN, *VCT, *KSN, *VST, *KWN, *VWT, *NG, *ZN; bf16* NO; float* OST; const float* qg; };
constexpr int AT_STG = 0, AT_IMP = 65536, AT_WUN = 98304, AT_CLIST = 98304 + 256;

template <int STRIDE>
DI void qk_tile(f32x16& S, const bf16x8 (&qf)[8], const LAS unsigned char* kl  , float sl2, float tbm) {
    bf16x8 kf[8];
#pragma unroll
    for (int j = 0; j < 8; ++j) kf[j] = *(const LAS bf16x8*)(kl + j * 1024);
    __builtin_amdgcn_sched_barrier(0);
    const float sl2s = sl2 * (float)STRIDE;
#pragma unroll
    for (int r = 0; r < 16; ++r) { float x = __builtin_fmaf(sl2s, (float)(16 * (r >> 3) + (r & 7)), tbm); asm volatile("" : "+v"(x)); S[r] = x; }
#pragma unroll
    for (int j = 0; j < 8; ++j) S = MFMA32(kf[j], qf[j], S);
}
template <int STRIDE>
DI void edge_mask(f32x16& S, int rel0, int lo) {
#pragma unroll
    for (int r = 0; r < 16; ++r) { const int rel = rel0 + STRIDE * (16 * (r >> 3) + (r & 7)); S[r] = (rel <= 0 && rel >= lo) ? S[r] : NEG; }
}
DI float tile_max(const f32x16& S) {
    float mx = S[0];
#pragma unroll
    for (int r = 1; r < 16; ++r) mx = fmaxf(mx, S[r]);
    return fmaxf(mx, shx(mx, 32));
}
DI void soft_fixed(f32x16& S, float& mref, float& l) {
    const bool unset = mref < -1e29f;
    if (__builtin_amdgcn_ballot_w64(unset) != 0ull) {
        const float mx = tile_max(S); const bool now = unset && (mx > -1e29f); const float d = now ? mx : 0.f;
#pragma unroll
        for (int r = 0; r < 16; ++r) S[r] -= d;
        mref = now ? mx : mref;
    }
    float sum = 0.f;
#pragma unroll
    for (int r = 0; r < 16; ++r) { S[r] = ex2(S[r]); sum += S[r]; }
    l += sum;
}
DI void v_load4(bf16x8 (&vf)[4], const LAS unsigned char* vl  ) {
#pragma unroll
    for (int i = 0; i < 4; ++i) vf[i] = *(const LAS bf16x8*)(vl + i * 1024);
    __builtin_amdgcn_sched_barrier(0);
}
DI void pack_p(const f32x16& Pm, u32x4& p0, u32x4& p1) {
    p0.x = pk2(Pm[0], Pm[1]); p0.y = pk2(Pm[2], Pm[3]); p0.z = pk2(Pm[4], Pm[5]); p0.w = pk2(Pm[6], Pm[7]);
    p1.x = pk2(Pm[8], Pm[9]); p1.y = pk2(Pm[10], Pm[11]); p1.z = pk2(Pm[12], Pm[13]); p1.w = pk2(Pm[14], Pm[15]);
}
DI void pv_mma(f32x16 (&O)[4], const u32x4& p0, const u32x4& p1, const bf16x8 (&va)[4], const bf16x8 (&vb)[4]) {
    const bf16x8 pb0 = __builtin_bit_cast(bf16x8, p0), pb1 = __builtin_bit_cast(bf16x8, p1);
#pragma unroll
    for (int dt = 0; dt < 2; ++dt) { O[dt] = MFMA32(va[2 * dt], pb0, O[dt]); O[dt] = MFMA32(va[2 * dt + 1], pb1, O[dt]); }
#pragma unroll
    for (int dt = 0; dt < 2; ++dt) { O[2 + dt] = MFMA32(vb[2 * dt], pb0, O[2 + dt]); O[2 + dt] = MFMA32(vb[2 * dt + 1], pb1, O[2 + dt]); }
}
DI void o_zero(f32x16 (&O)[4]) {
#pragma unroll
    for (int dt = 0; dt < 4; ++dt)
#pragma unroll
        for (int r = 0; r < 16; ++r) O[dt][r] = 0.f;
}
DI float dpp_xor1(float v) { return __builtin_bit_cast(float, __builtin_amdgcn_update_dpp(0, __builtin_bit_cast(int, v), 0xB1, 0xF, 0xF, true)); }
DI float dpp_xor2(float v) { return __builtin_bit_cast(float, __builtin_amdgcn_update_dpp(0, __builtin_bit_cast(int, v), 0x4E, 0xF, 0xF, true)); }
DI void lds_fadd(LAS float* p, float v) { (void)__hip_atomic_fetch_add(p, v, __ATOMIC_RELAXED, __HIP_MEMORY_SCOPE_WORKGROUP); }

struct TileCtx { const char *kc, *vc, *kw, *vw, *ks, *vs; int nt, nd, wlast, cur; const LAS unsigned char* clist; };
DI void tile_ptrs(const TileCtx& X, int idx, const char*& k, const char*& v) {
    if (idx < X.nt) { k = X.kc + (size_t)(X.nt - 1 - idx) * 8192; v = nullptr; }
    else if (idx < 2 * X.nt) { k = X.kc + (size_t)(2 * X.nt - 1 - idx) * 8192; v = X.vc + (size_t)(2 * X.nt - 1 - idx) * 8192; }
    else if (idx < 2 * X.nt + X.nd) { const int k0 = X.wlast - 32 * (idx - 2 * X.nt); k = X.kw + (size_t)k0 * 256; v = X.vw + (size_t)k0 * 256; }
    else { const int j = idx - 2 * X.nt - X.nd; const int b = (j < 2) ? X.cur : __builtin_amdgcn_readfirstlane((int)X.clist[j >> 1]); const int k0 = b * 64 + 32 * (1 - (j & 1)); k = X.ks + (size_t)k0 * 256; v = X.vs + (size_t)k0 * 256; }
}

DI void attn_wg_unit(const AttP& P, LAS unsigned char* lds, int wave, int lane, int c, int h) {
    LAS float* imp = (LAS float*)(lds + AT_IMP + wave * 4096);
    LAS unsigned* wun = (LAS unsigned*)(lds + AT_WUN);
    LAS unsigned char* clist = lds + AT_CLIST;
    LAS unsigned short* selw = (LAS unsigned short*)(lds + SELW_OFF + wave * 128);
    const int t0 = c * 64 + wave * 8;
    const int n = lane & 31, hi = lane >> 5, tok = n >> 2, gq = n & 3, t = t0 + tok, hq = h * 4 + gq;
    const unsigned koff = (unsigned)lane * 16u;
    const float sl2 = ex2(-0.5f * (float)(hq + 1)) * LOG2E;
    const int cur = c;
    bf16x8 qf[8];
    {
        const GAS u32x4* qp = (const GAS u32x4*)(P.QN + (size_t)t * NSAW + hq * 128 + 64 * hi);
        u32x4 qv[8];
#pragma unroll
        for (int j = 0; j < 8; ++j) qv[j] = qp[j];
        float ss = 0.f;
#pragma unroll
        for (int j = 0; j < 8; ++j) { float f[8]; unpack8(qv[j], f);
#pragma unroll
            for (int e = 0; e < 8; ++e) ss += f[e] * f[e]; }
        ss += shx(ss, 32);
        const float rs = (0.08838834764831845f * LOG2E) / sqrtf(ss * (1.f / 128.f) + EPS);
        const GAS float* gp = (const GAS float*)P.qg + 64 * hi;
#pragma unroll
        for (int j = 0; j < 8; ++j) { float f[8]; unpack8(qv[j], f); const f32x4 g0 = *(const GAS f32x4*)(gp + 8 * j), g1 = *(const GAS f32x4*)(gp + 8 * j + 4);
            f[0] *= rs * g0.x; f[1] *= rs * g0.y; f[2] *= rs * g0.z; f[3] *= rs * g0.w; f[4] *= rs * g1.x; f[5] *= rs * g1.y; f[6] *= rs * g1.z; f[7] *= rs * g1.w;
            qf[j] = __builtin_bit_cast(bf16x8, pack8(f)); }
    }
#define AT_GATE(br) bflo((unsigned)*(const GAS bf16*)(P.NG + (size_t)t * 256 + hq * 3 + (br)))
#define AT_OST() GAS u32x2* ost; { int l2_ = lane; asm volatile("" : "+v"(l2_)); ost = (GAS u32x2*)P.OST + ((size_t)(t0 >> 3) * 4 + h) * 1024 + l2_; }
    f32x16 O[4], S;
#pragma unroll
    for (int i = 0; i < 4; ++i) *(LAS f32x4*)(imp + (i * 64 + lane) * 4) = (f32x4){0.f, 0.f, 0.f, 0.f};

    TileCtx X;
    X.kc = (const char*)(P.KCN + (size_t)h * NCP * 128); X.vc = (const char*)(P.VCT + (size_t)h * 128 * NCP);
    X.kw = (const char*)(P.KWN + (size_t)h * T * 128); X.vw = (const char*)(P.VWT + (size_t)h * 128 * T);
    X.ks = (const char*)(P.KSN + (size_t)h * T * 128); X.vs = (const char*)(P.VST + (size_t)h * 128 * T);
    X.nt = ((((c * 64 + 63 - 31) >> 4) + 1) + 31) >> 5;
    X.wlast = c * 64 + 32; { const int wf = (c >= 8) ? 64 * (c - 8) : 0; X.nd = ((X.wlast - wf) >> 5) + 1; }
    X.clist = clist; X.cur = c;
    const int nvalid = (t0 + 7 >= 31) ? ((t0 + 7 - 31) >> 4) + 1 : 0, ntw = (nvalid + 31) >> 5;
    int kfw = t0 - 511; kfw = kfw < 0 ? 0 : (kfw & ~31); const int klw = t0 & ~31;
    const int nt = X.nt, nd = X.nd, S1 = 2 * nt + nd;
    int total = S1 + 2;
    unsigned un[4] = {0u, 0u, 0u, 0u};
    float m = NEG, l = 0.f, rl = 0.f, mu = 0.f;

    int idx = 0, pend = S1 + 2;
#define AT_ISSUE(ti) do { const char *k_, *v_; tile_ptrs(X, (ti), k_, v_); LAS unsigned char* nb_ = lds + AT_STG + ((ti) & 3) * 16384 + wave * 1024; \
        __builtin_amdgcn_global_load_lds((const unsigned*)(k_ + wave * 1024 + koff), (LAS unsigned*)nb_, 16, 0, 0); \
        __builtin_amdgcn_global_load_lds((const unsigned*)((v_ ? v_ : k_) + wave * 1024 + koff), (LAS unsigned*)(nb_ + 8192), 16, 0, 0); } while (0)
#define AT_SYNC() do { if (idx + 1 < pend) asm volatile("s_waitcnt vmcnt(2) lgkmcnt(0)\n\ts_barrier" ::: "memory"); else asm volatile("s_waitcnt vmcnt(0) lgkmcnt(0)\n\ts_barrier" ::: "memory"); } while (0)
#define AT_PREFETCH() do { if (idx + 2 < pend) AT_ISSUE(idx + 2); } while (0)
#define AT_VL(ti) (lds + AT_STG + ((ti) & 3) * 16384 + 8192 + koff)
#define AT_KL() (lds + AT_STG + (idx & 3) * 16384 + koff)
    asm volatile("s_waitcnt vmcnt(0) lgkmcnt(0)\n\ts_barrier" ::: "memory");
#pragma unroll 1
    for (int d = 0; d < 2; ++d) if (d < pend) AT_ISSUE(d);

#pragma unroll 1
    for (; idx < nt; ++idx) {
        AT_SYNC(); AT_PREFETCH();
        const LAS unsigned char* kl = AT_KL();
        const int ti = nt - 1 - idx, k0 = ti * 32, rel0 = 16 * (k0 + 8 * hi) + 31 - t;
        qk_tile<16>(S, qf, kl, sl2, sl2 * (float)rel0 - ((m < -1e29f) ? 0.f : m));
        if (ti >= ntw - 1) edge_mask<16>(S, rel0, -(1 << 30));
        soft_fixed(S, m, l);
    }
    { const float lt = l + shx(l, 32); const bool have = m > -1e29f; rl = have ? 1.f / lt : 0.f; mu = have ? m : 0.f; }
    o_zero(O);
    const float gc = AT_GATE(0);
    int pidx = idx; u32x4 pp0 = {0u, 0u, 0u, 0u}, pp1 = {0u, 0u, 0u, 0u};
#pragma unroll 1
    for (; idx < 2 * nt; ++idx) {
        AT_SYNC(); AT_PREFETCH();
        const LAS unsigned char* kl = AT_KL();
        const int ti = 2 * nt - 1 - idx, k0 = ti * 32, rel0 = 16 * (k0 + 8 * hi) + 31 - t;
        bf16x8 va[4], vb[4]; v_load4(va, AT_VL(pidx));
        qk_tile<16>(S, qf, kl, sl2, sl2 * (float)rel0 - mu);
        v_load4(vb, AT_VL(pidx) + 4096);
        pv_mma(O, pp0, pp1, va, vb);
        if (ti >= ntw - 1) edge_mask<16>(S, rel0, -(1 << 30));
#pragma unroll
        for (int r = 0; r < 16; ++r) S[r] = ex2(S[r]) * rl;
#pragma unroll
        for (int q4 = 0; q4 < 4; ++q4) { float v[4];
#pragma unroll
            for (int e = 0; e < 4; ++e) { float x = S[4 * q4 + e]; x += dpp_xor1(x); x += dpp_xor2(x); v[e] = x; }
            if (gq == 0) { const int j = (k0 >> 2) + 4 * (q4 >> 1) + 2 * hi + (q4 & 1);
                lds_fadd(imp + tok * 128 + j, 2.f * (v[0] + v[1] + v[2]) + v[3]); if (j + 1 < 128) lds_fadd(imp + tok * 128 + j + 1, v[3]); } }
#pragma unroll
        for (int r = 0; r < 16; ++r) S[r] *= gc;
        pack_p(S, pp0, pp1); pidx = idx;
    }
    { bf16x8 va[4], vb[4]; v_load4(va, AT_VL(pidx)); v_load4(vb, AT_VL(pidx) + 4096); pv_mma(O, pp0, pp1, va, vb); }
    {
        LDS_WAIT(); asm volatile("" ::: "memory");
        int l5 = lane; asm volatile("" : "+v"(l5));
        const int tk = l5 >> 3, sub = l5 & 7; const LAS float* pb = imp + tk * 128 + sub * 16;
        unsigned key[16];
#pragma unroll
        for (int i4 = 0; i4 < 4; ++i4) { const f32x4 q = *(const LAS f32x4*)(pb + 4 * i4);
#pragma unroll
            for (int e = 0; e < 4; ++e) { const int i = 4 * i4 + e, j = sub * 16 + i; const float iv = (e == 0) ? q.x : (e == 1) ? q.y : (e == 2) ? q.z : q.w;
                const bool valid = j <= cur, forced = (j == 0) || (j == cur) || (j == cur - 1);
                const unsigned ib = ((__builtin_bit_cast(unsigned, iv) & 0x7fffff00u) | (unsigned)(255 - j));
                key[i] = !valid ? 0u : (forced ? (0x7f000000u | (unsigned)(255 - j)) : ib); } }
        const int R = (cur + 1 < 16) ? cur + 1 : 16; unsigned sel = 0u;
        for (int rd = 0; rd < R; ++rd) {
            unsigned mx = key[0];
#pragma unroll
            for (int i = 1; i < 16; ++i) mx = mx > key[i] ? mx : key[i];
            { unsigned ot = (unsigned)__builtin_amdgcn_update_dpp(0, (int)mx, 0xB1, 0xF, 0xF, true); mx = mx > ot ? mx : ot;
              ot = (unsigned)__builtin_amdgcn_update_dpp(0, (int)mx, 0x4E, 0xF, 0xF, true); mx = mx > ot ? mx : ot;
              ot = (unsigned)__builtin_amdgcn_update_dpp(0, (int)mx, 0x141, 0xF, 0xF, true); mx = mx > ot ? mx : ot; }
#pragma unroll
            for (int i = 0; i < 16; ++i) { const bool hit = (key[i] == mx); sel |= hit ? (1u << i) : 0u; key[i] = hit ? 0u : key[i]; }
        }
        selw[tk * 8 + sub] = (unsigned short)sel;
        LDS_WAIT(); asm volatile("" ::: "memory");
        const LAS u32x4* sw = (const LAS u32x4*)selw;
        u32x4 uu = sw[0];
#pragma unroll
        for (int k = 1; k < 8; ++k) { const u32x4 o = sw[k]; uu.x |= o.x; uu.y |= o.y; uu.z |= o.z; uu.w |= o.w; }
        un[0] = __builtin_amdgcn_readfirstlane(uu.x); un[1] = __builtin_amdgcn_readfirstlane(uu.y); un[2] = __builtin_amdgcn_readfirstlane(uu.z); un[3] = __builtin_amdgcn_readfirstlane(uu.w);
        if (lane == 0) *(LAS u32x4*)(wun + 4 * wave) = (u32x4){un[0], un[1], un[2], un[3]};
        AT_OST();
#pragma unroll
        for (int i = 0; i < 4; ++i) *(LAS f32x4*)(imp + (i * 64 + lane) * 4) = (f32x4){0.f, 0.f, 0.f, 0.f};
#pragma unroll
        for (int q = 0; q < 16; ++q) { u32x2 w_; w_.x = pk2(O[q >> 2][4 * (q & 3)], O[q >> 2][4 * (q & 3) + 1]); w_.y = pk2(O[q >> 2][4 * (q & 3) + 2], O[q >> 2][4 * (q & 3) + 3]); ost[q * 64] = w_;
            if ((q & 3) == 3) asm volatile("" ::: "memory"); }
    }
    o_zero(O); m = NEG; l = 0.f;
    pidx = idx; pp0 = (u32x4){0u, 0u, 0u, 0u}; pp1 = pp0;
#define AT_D_HEAD() \
        AT_SYNC(); AT_PREFETCH(); \
        const LAS unsigned char* kl = AT_KL(); \
        const int k0 = X.wlast - 32 * (idx - 2 * nt); \
        const int rel0 = k0 + 8 * hi - t; const bool edge = (k0 + 31 > t0) || (k0 + 511 < t0 + 7)
    if (wave < 4) {
#pragma unroll 1
        for (; idx < S1; ++idx) {
            AT_D_HEAD();
            bf16x8 va[4], vb[4]; v_load4(va, AT_VL(pidx));
            qk_tile<1>(S, qf, kl, sl2, sl2 * (float)rel0 - ((m < -1e29f) ? 0.f : m));
            v_load4(vb, AT_VL(pidx) + 4096);
            pv_mma(O, pp0, pp1, va, vb);
            if (edge) edge_mask<1>(S, rel0, -511);
            soft_fixed(S, m, l); pack_p(S, pp0, pp1); pidx = idx;
        }
    } else {
#pragma unroll
        for (int r = 0; r < 16; ++r) S[r] = NEG;
        int prel0 = 0; bool pedge = false;
#pragma unroll 1
        for (; idx < S1; ++idx) {
            AT_D_HEAD();
            if (pedge) edge_mask<1>(S, prel0, -511);
            soft_fixed(S, m, l); pack_p(S, pp0, pp1);
            { bf16x8 va[4], vb[4]; v_load4(va, AT_VL(pidx)); v_load4(vb, AT_VL(pidx) + 4096); pv_mma(O, pp0, pp1, va, vb); }
            qk_tile<1>(S, qf, kl, sl2, sl2 * (float)rel0 - ((m < -1e29f) ? 0.f : m));
            pidx = idx; prel0 = rel0; pedge = edge;
        }
        if (pedge) edge_mask<1>(S, prel0, -511);
        soft_fixed(S, m, l); pack_p(S, pp0, pp1);
    }
#undef AT_D_HEAD
    { bf16x8 va[4], vb[4]; v_load4(va, AT_VL(pidx)); v_load4(vb, AT_VL(pidx) + 4096); pv_mma(O, pp0, pp1, va, vb); }
    {
        AT_OST();
        const float lt = l + shx(l, 32), cw = AT_GATE(2) / lt;
        asm volatile("s_waitcnt vmcnt(0)" ::: "memory");
#pragma unroll
        for (int q = 0; q < 16; ++q) { const u32x2 sw_ = ost[q * 64]; u32x2 w_;
            w_.x = pk2(bflo(sw_.x) + cw * O[q >> 2][4 * (q & 3)], bfhi(sw_.x) + cw * O[q >> 2][4 * (q & 3) + 1]); w_.y = pk2(bflo(sw_.y) + cw * O[q >> 2][4 * (q & 3) + 2], bfhi(sw_.y) + cw * O[q >> 2][4 * (q & 3) + 3]); ost[q * 64] = w_;
            if ((q & 7) == 7) asm volatile("" ::: "memory"); }
    }
    o_zero(O); m = NEG; l = 0.f;
    {
        u32x4 uu = *(const LAS u32x4*)(wun);
#pragma unroll
        for (int k = 1; k < 8; ++k) { const u32x4 o = *(const LAS u32x4*)(wun + 4 * k); uu.x |= o.x; uu.y |= o.y; uu.z |= o.z; uu.w |= o.w; }
        const unsigned u0 = __builtin_amdgcn_readfirstlane(uu.x), u1 = __builtin_amdgcn_readfirstlane(uu.y), u2 = __builtin_amdgcn_readfirstlane(uu.z), u3 = __builtin_amdgcn_readfirstlane(uu.w);
        const int ncu = __builtin_popcount(u0) + __builtin_popcount(u1) + __builtin_popcount(u2) + __builtin_popcount(u3);
        total = S1 + 2 * ncu;
#pragma unroll
        for (int rr = 0; rr < 2; ++rr) { const int b = lane + 64 * rr;
            const unsigned wb = (b < 32) ? u0 : (b < 64) ? u1 : (b < 96) ? u2 : u3;
            if ((wb >> (b & 31)) & 1u) {
                int above = __builtin_popcount(wb >> (b & 31)) - 1;
                if (b < 96) above += __builtin_popcount(u3); if (b < 64) above += __builtin_popcount(u2); if (b < 32) above += __builtin_popcount(u1);
                clist[above] = (unsigned char)b; } }
        LDS_WAIT(); asm volatile("" ::: "memory");
    }
    pend = total;
    pidx = idx; pp0 = (u32x4){0u, 0u, 0u, 0u}; pp1 = pp0;
    {
        const int ncu2 = (total - S1) >> 1;
        int bc = cur;
        unsigned mc = ((const LAS unsigned*)selw)[tok * 4 + (bc >> 5)];
        unsigned bn_raw = (ncu2 > 1) ? (unsigned)clist[1] : (unsigned)cur;
#define AT_C_HEAD() \
            AT_SYNC(); \
            const int j = idx - S1, half = 1 - (j & 1); \
            const int bn = __builtin_amdgcn_readfirstlane((int)bn_raw); \
            if (idx + 2 < pend) { \
                const int k2 = bn * 64 + 32 * half; LAS unsigned char* nb_ = lds + AT_STG + ((idx + 2) & 3) * 16384 + wave * 1024; \
                __builtin_amdgcn_global_load_lds((const unsigned*)(X.ks + (size_t)k2 * 256 + wave * 1024 + koff), (LAS unsigned*)nb_, 16, 0, 0); \
                __builtin_amdgcn_global_load_lds((const unsigned*)(X.vs + (size_t)k2 * 256 + wave * 1024 + koff), (LAS unsigned*)(nb_ + 8192), 16, 0, 0); } \
            const LAS unsigned char* kl = AT_KL(); \
            const int k0 = bc * 64 + 32 * half; const bool rok = (mc >> (bc & 31)) & 1u; \
            const int rel0 = k0 + 8 * hi - t
#define AT_C_TAIL() \
            if (half == 0) { const int jb = j >> 1; bc = bn; mc = ((const LAS unsigned*)selw)[tok * 4 + (bc >> 5)]; bn_raw = (jb + 2 < ncu2) ? (unsigned)clist[jb + 2] : (unsigned)cur; }
        if (wave < 4) {
#pragma unroll 1
            for (; idx < total; ++idx) {
                AT_C_HEAD();
                bf16x8 va[4], vb[4]; v_load4(va, AT_VL(pidx));
                qk_tile<1>(S, qf, kl, sl2, rok ? (sl2 * (float)rel0 - ((m < -1e29f) ? 0.f : m)) : NEG);
                v_load4(vb, AT_VL(pidx) + 4096);
                pv_mma(O, pp0, pp1, va, vb);
                if (bc == cur) edge_mask<1>(S, rel0, -(1 << 30));
                soft_fixed(S, m, l); pack_p(S, pp0, pp1); pidx = idx;
                AT_C_TAIL();
            }
        } else {
#pragma unroll
            for (int r = 0; r < 16; ++r) S[r] = NEG;
            int prel0 = 0; bool pedge = false;
#pragma unroll 1
            for (; idx < total; ++idx) {
                AT_C_HEAD();
                if (pedge) edge_mask<1>(S, prel0, -(1 << 30));
                soft_fixed(S, m, l); pack_p(S, pp0, pp1);
                { bf16x8 va[4], vb[4]; v_load4(va, AT_VL(pidx)); v_load4(vb, AT_VL(pidx) + 4096); pv_mma(O, pp0, pp1, va, vb); }
                qk_tile<1>(S, qf, kl, sl2, rok ? (sl2 * (float)rel0 - ((m < -1e29f) ? 0.f : m)) : NEG);
                pidx = idx; prel0 = rel0; pedge = (bc == cur);
                AT_C_TAIL();
            }
            if (pedge) edge_mask<1>(S, prel0, -(1 << 30));
            soft_fixed(S, m, l); pack_p(S, pp0, pp1);
        }
#undef AT_C_HEAD
#undef AT_C_TAIL
    }
    { bf16x8 va[4], vb[4]; v_load4(va, AT_VL(pidx)); v_load4(vb, AT_VL(pidx) + 4096); pv_mma(O, pp0, pp1, va, vb); }
#undef AT_SYNC
#undef AT_PREFETCH
#undef AT_KL
#undef AT_VL
#undef AT_ISSUE
    {
        AT_OST();
        const float lt = l + shx(l, 32), cs = AT_GATE(1) / lt;
        asm volatile("s_waitcnt vmcnt(0)" ::: "memory");
        LAS unsigned char* tb = (LAS unsigned char*)imp;
        int l4 = lane; asm volatile("" : "+v"(l4)); const int n4 = l4 & 31, hi4 = l4 >> 5;
#pragma unroll
        for (int ph = 0; ph < 2; ++ph) {
#pragma unroll
            for (int q8 = 0; q8 < 8; ++q8) { const int q = 8 * ph + q8; const u32x2 sw_ = ost[q * 64]; const f32x4 sv = (f32x4){bflo(sw_.x), bfhi(sw_.x), bflo(sw_.y), bfhi(sw_.y)};
                const float o0 = sv.x + cs * O[q >> 2][4 * (q & 3)], o1 = sv.y + cs * O[q >> 2][4 * (q & 3) + 1], o2 = sv.z + cs * O[q >> 2][4 * (q & 3) + 2], o3 = sv.w + cs * O[q >> 2][4 * (q & 3) + 3];
                const int byte = (32 * (q8 >> 2) + 8 * (q8 & 3) + 4 * hi4) * 2;
                u32x2 w; w.x = pk2(o0, o1); w.y = pk2(o2, o3);
                *(LAS u32x2*)(tb + n4 * 128 + ((((byte >> 4) ^ (n4 & 7)) << 4) | (byte & 15))) = w;
                if (q8 & 1) asm volatile("" ::: "memory"); }
            LDS_WAIT(); asm volatile("" ::: "memory");
#pragma unroll
            for (int k = 0; k < 4; ++k) { const int p = l4 + 64 * k, row = p >> 3, ch = p & 7;
                const u32x4 ov = *(const LAS u32x4*)(tb + row * 128 + ((ch ^ (row & 7)) << 4));
                const size_t go = (size_t)(t0 + (row >> 2)) * NSAW + (h * 4 + (row & 3)) * 128 + 64 * ph + 8 * ch;
                const u32x4 zv = gld(P.ZN + go); float of[8], zf[8]; unpack8(ov, of); unpack8(zv, zf);
#pragma unroll
                for (int e = 0; e < 8; ++e) of[e] *= zf[e];
                gst(P.NO + go, pack8(of));
                if (k & 1) asm volatile("" ::: "memory"); }
            LDS_WAIT(); asm volatile("" ::: "memory");
        }
#pragma unroll
        for (int i = 0; i < 4; ++i) *(LAS f32x4*)(imp + (i * 64 + lane) * 4) = (f32x4){0.f, 0.f, 0.f, 0.f};
    }
}
#undef AT_GATE
DI void p4_attention(const AttP& P, LAS unsigned char* lds, int G, int wave, int lane) {
    for (int w = blockIdx.x; w < 256; w += G) {
        const int h = w & 3, p = w >> 2;
#pragma unroll 1
        for (int k = 0; k < 2; ++k) attn_wg_unit(P, lds, wave, lane, k ? p : 127 - p, h);
    }
    asm volatile("s_waitcnt vmcnt(0) lgkmcnt(0)\n\ts_barrier" ::: "memory");
}

__global__ void __launch_bounds__(NTHR, 2) mega_fwd(Args args) {
    extern __shared__ __attribute__((aligned(16))) unsigned char lds_raw[];
    LAS unsigned char* lds = (LAS unsigned char*)lds_raw;
    const int tid0 = threadIdx.x;
    const int wave0 = __builtin_amdgcn_readfirstlane(tid0 >> 6);
    const int G = gridDim.x, bx = blockIdx.x;
    const int vcu = (G % 8 == 0) ? (bx % 8) * (G / 8) + bx / 8 : bx;
    const int NGW = G * NWAVES;
    unsigned char* const ws0 = args.ws;
    gu32* ctl = (gu32*)(ws0 + WS_CTL);
    for (int u = tid0; u < (LDS_BYTES - LDSCTL_OFF) / 4; u += NTHR) ((LAS unsigned*)(lds + LDSCTL_OFF))[u] = 0u;
    __syncthreads();
    volatile LAS unsigned* MISC = (volatile LAS unsigned*)(lds + MISC_OFF);
    XcdBarrier bar; bar.bar = (unsigned*)(ctl + CW_BAR); bar.x = 0; bar.st = nullptr;
    if (!MK_MULTI) bar = xcd_barrier_post((unsigned*)(ctl + CW_BAR), MISC + 8);
    const int lo = args.st_lo, hi = args.st_hi;
#define IN(k) (lo <= (k) && (k) < hi)
#ifdef PROBE_PH
    unsigned long long pr_acc = 0ull, pr_t0 = 0ull;
#define PR_B(p) do { if ((p) == PROBE_PH) pr_t0 = __builtin_amdgcn_s_memrealtime(); } while (0)
#define PR_E(p) do { if ((p) == PROBE_PH) pr_acc += __builtin_amdgcn_s_memrealtime() - pr_t0; } while (0)
#else
#define PR_B(p) do {} while (0)
#define PR_E(p) do {} while (0)
#endif
#ifndef REP_PH
#define REP_PH -1
#endif
#define REPS(p) for (int rep_ = 0; rep_ < ((p) == REP_PH ? 2 : 1); ++rep_)
#define LAUNDER_WS() unsigned char* ws = ws0; asm volatile("" : "+s"(ws)); int wave = wave0; asm volatile("" : "+s"(wave)); int lane; asm volatile("v_mbcnt_lo_u32_b32 %0, -1, 0\n\tv_mbcnt_hi_u32_b32 %0, -1, %0" : "=v"(lane)); const int tid = wave * 64 + lane, gw = vcu * NWAVES + wave; (void)tid; (void)gw
#ifndef PH_MASK
#define PH_MASK 0x7f
#endif
#define PH_ON(p) ((PH_MASK >> (p)) & 1)
#define SEAM(k) do { if ((k) + 1 < hi) xcd_barrier(bar); } while (0)

    if (PH_ON(0) && IN(0)) REPS(0) { PR_B(0); LAUNDER_WS(); prologue(args, lds, gw, NGW, wave, lane, G == 256);
        if (IN(1)) p1_xb(args.in[0], (bf16*)(ws + WS_H), (float*)(ws + WS_SS), gw, NGW, lane);
        SEAM(0); PR_E(0); }

    for (int l = 0; l < DEPTH; ++l) {
        const int s0 = 1 + 6 * l;
        if (s0 + 6 <= lo || s0 >= hi) continue;
        if (PH_ON(1) && IN(s0) && l == 0 && !IN(0)) REPS(1) { PR_B(1); LAUNDER_WS(); p1_xb(args.in[0], (bf16*)(ws + WS_H), (float*)(ws + WS_SS), gw, NGW, lane); SEAM(s0); PR_E(1); }
        if (PH_ON(2) && IN(s0 + 1)) REPS(2) {
            PR_B(2);
            LAUNDER_WS(); bf16* Hb = (bf16*)(ws + WS_H);
            pg8::Gemm g{DM, DM, DM};
            pg8::SchedPlain S{(const char*)Hb, (const char*)(ws + WS_WIN + l * SZ_WIN), 32, NINT, G, bx, (size_t)256 * DM * 2, (size_t)256 * DM * 2, WGM_IN};
            { pg8::Unit u0; if (S.next(0, u0)) {
                const f32x4* sp = (const f32x4*)((const float*)(ws + WS_SS) + ((size_t)u0.pm * 256 + (tid >> 1)) * 64 + (tid & 1) * 32); float sq = 0.f;
#pragma unroll
                for (int j = 0; j < 8; ++j) { const f32x4 q4 = sp[j]; sq += (q4.x + q4.y) + (q4.z + q4.w); }
                sq += shx(sq, 1);
                if (!(tid & 1)) ((LAS float*)(lds + RS_OFF))[tid >> 1] = 1.f / sqrtf(sq * (1.f / DM) + EPS); }
              __syncthreads(); }
            pg8::EpiIn E{(bf16*)(ws + WS_U), (bf16*)(ws + WS_ZP), (bf16*)(ws + WS_QR), (bf16*)(ws + WS_ZN), (bf16*)(ws + WS_KV6), (bf16*)(ws + WS_GM), (bf16*)(ws + WS_NG), args.in[3] + (size_t)l * 2 * DM, (const LAS float*)(lds + RS_OFF)};
            pg8::gemm_phase<pg8::EpiIn, pg8::SchedPlain, true>(lds, g, S, E, tid);
            if (G == 256 && bx >= OFF_FIRST && l + 1 < DEPTH && rep_ == 0) slack_convert(args, lds, l + 1, bx, wave, lane);
            SEAM(s0 + 1);
            PR_E(2);
        }
        if (PH_ON(3) && IN(s0 + 2)) REPS(3) {
            PR_B(3);
            LAUNDER_WS();
            CmpP C{(const bf16*)(ws + WS_KV6), args.in[8] + (size_t)l * 2 * 4096, (const bf16*)(ws + WS_W1 + l * SZ_W1), args.in[10] + (size_t)l * 2 * 128, (const bf16*)(ws + WS_W2 + l * SZ_W2),
                   args.in[7] + (size_t)l * 3 * 128, (bf16*)(ws + WS_KCN), (bf16*)(ws + WS_VCT)};
            p3_compress(C, lds, G, tid, wave, lane);
            MidP M{(const bf16*)(ws + WS_U), (const bf16*)(ws + WS_QR), (const bf16*)(ws + WS_KV6), (bf16*)(ws + WS_MP), (bf16*)(ws + WS_QN), (bf16*)(ws + WS_KSN), (bf16*)(ws + WS_KWN),
                   (bf16*)(ws + WS_VST), (bf16*)(ws + WS_VWT), args.in[6] + (size_t)l * 128, args.in[7] + (size_t)l * 3 * 128};
            p3_mid(M, lds, gw, NGW, wave, lane);
            SEAM(s0 + 2);
            PR_E(3);
        }
        if (PH_ON(4) && IN(s0 + 3)) REPS(4) {
            PR_B(4);
            LAUNDER_WS();
            {
                pg8::Gemm g{PW, 512, 512};
                pg8::SchedPool S{(const char*)(ws + WS_MP), (const char*)(ws + WS_POOLW + l * SZ_POOLW), G, bx};
                pg8::EpiPool E{(bf16*)(ws + WS_PO), (const bf16*)(ws + WS_ZP), args.in[5] + (size_t)l * PW};
                pg8::gemm_phase<pg8::EpiPool, pg8::SchedPool, false>(lds, g, S, E, tid);
            }
            __syncthreads();
            AttP A{(const bf16*)(ws + WS_QR), (const bf16*)(ws + WS_KCN), (const bf16*)(ws + WS_VCT), (const bf16*)(ws + WS_KSN), (const bf16*)(ws + WS_VST), (const bf16*)(ws + WS_KWN), (const bf16*)(ws + WS_VWT),
                   (const bf16*)(ws + WS_NG), (const bf16*)(ws + WS_ZN), (bf16*)(ws + WS_NO), (float*)(ws + WS_OST), args.in[6] + (size_t)l * 128};
#ifdef REP_ATT
            { int nra = 2; asm volatile("" : "+s"(nra));
#pragma unroll 1
              for (int ra = 0; ra < nra; ++ra) p4_attention(A, lds, G, wave, lane); }
#else
            p4_attention(A, lds, G, wave, lane);
#endif
            SEAM(s0 + 3);
            PR_E(4);
        }
        if (PH_ON(5) && IN(s0 + 4)) REPS(5) {
            PR_B(5);
            LAUNDER_WS();
            pg8::Gemm g{PW, PW, PW};
            pg8::SchedUp S{(const char*)(ws + WS_PO), (const char*)(ws + WS_NO), (const char*)(ws + WS_WPU + l * SZ_WUP), (const char*)(ws + WS_WNU + l * SZ_WUP), G, bx};
            pg8::EpiUp E{(bf16*)(ws + WS_Y), (const bf16*)(ws + WS_GM), (const bf16*)(ws + WS_GM) + (size_t)T * DM};
            pg8::gemm_phase<pg8::EpiUp, pg8::SchedUp, true>(lds, g, S, E, tid);
            SEAM(s0 + 4);
            PR_E(5);
        }
        if (PH_ON(6) && IN(s0 + 5)) REPS(6) {
            PR_B(6);
            LAUNDER_WS();
            pg8::Gemm g{DM, DM, DM};
            pg8::SchedPlain S{(const char*)(ws + WS_Y), (const char*)(ws + WS_WOUT + l * SZ_WOUT), 32, 16, G, bx, (size_t)256 * DM * 2, (size_t)256 * DM * 2, WGM_OUT};
            const bool dry = (REP_PH == 6 && rep_ == 0);
            pg8::EpiOut E{args.in[0], (const bf16*)(ws + WS_H), (bf16*)(ws + (dry ? WS_GM : WS_H)), (float*)(ws + (dry ? WS_GM + ((size_t)T * DM * 2) : WS_SS)), dry ? (float*)(ws + WS_GM) : args.out, l == 0 ? 0 : (l == DEPTH - 1 ? 2 : 1)};
            pg8::gemm_phase<pg8::EpiOut, pg8::SchedPlain, true>(lds, g, S, E, tid);
            SEAM(s0 + 5);
            PR_E(6);
        }
    }
#ifdef PROBE_PH
    xcd_barrier(bar);
    if (blockIdx.x == 0 && threadIdx.x == 0) args.out[0] = (float)pr_acc * 0.01f;
#endif
#undef IN
#undef SEAM
}

extern "C" void kernel_launch(void* const* d_in, const int* in_sizes, int n_in, void* d_out, int out_size, void* d_ws, size_t ws_size, hipStream_t stream) {
    static int grid = 0;
    if (grid == 0) {
        if (n_in != 15 || out_size != T * DM || ws_size < WS_END) { fprintf(stderr, "kernel_launch: unexpected shapes (n_in %d out %d ws %zu need %zu)\n", n_in, out_size, ws_size, (size_t)WS_END); grid = -1; return; }
        int dev = 0, cus = 0, per_cu = 0;
        if (hipGetDevice(&dev) != hipSuccess || hipDeviceGetAttribute(&cus, hipDeviceAttributeMultiprocessorCount, dev) != hipSuccess) { grid = -1; return; }
        if (hipFuncSetAttribute((const void*)mega_fwd, hipFuncAttributeMaxDynamicSharedMemorySize, LDS_BYTES) != hipSuccess) { fprintf(stderr, "kernel_launch: hipFuncSetAttribute failed\n"); grid = -1; return; }
        if (hipOccupancyMaxActiveBlocksPerMultiprocessor(&per_cu, (const void*)mega_fwd, NTHR, LDS_BYTES) != hipSuccess || per_cu < 1) { fprintf(stderr, "kernel_launch: occupancy query says %d\n", per_cu); }
        (void)hipGetLastError();
        grid = cus;
    }
    if (grid < 0) return;
    (void)hipMemsetAsync((char*)d_ws + WS_CTL, 0, CTL_ZERO_BYTES, stream);
    Args a{};
    for (int i = 0; i < 15; ++i) a.in[i] = (const float*)d_in[i];
    a.out = (float*)d_out; a.ws = (unsigned char*)d_ws;
    constexpr int NSTEP = 1 + 6 * DEPTH;
#if MK_MULTI
    for (int s = 0; s < NSTEP; ++s) { a.st_lo = s; a.st_hi = s + 1; hipLaunchKernelGGL(mega_fwd, dim3(grid), dim3(NTHR), LDS_BYTES, stream, a); }
#else
    a.st_lo = 0; a.st_hi = NSTEP;
    hipLaunchKernelGGL(mega_fwd, dim3(grid), dim3(NTHR), LDS_BYTES, stream, a);
#endif
    const hipError_t le = hipPeekAtLastError();
    if (le != hipSuccess) fprintf(stderr, "kernel_launch: launch failed: %s\n", hipGetErrorName(le));
}
```
